# Optimizing an MI355X kernel written in HIP

```python
import jax, jax.numpy as jnp
from jax import lax
import numpy as np

D_MODEL = 1024
BATCH = 4
SEQ = 8192
DEPTH = 2

ATTN_WIDTH = D_MODEL // 2
HEAD_DIM = 64
N_ATTN_HEADS = ATTN_WIDTH // HEAD_DIM
CONV_WIDTH = D_MODEL - ATTN_WIDTH
CONV_K = 3
DILATED_BRANCHES = ((128, 1), (512, 4), (2048, 16))
BLOCK = 128
D_FF = 2816
N_SUB = 3
N_MOD = 3
IN_COLS = 3 * ATTN_WIDTH + 3 * CONV_WIDTH
EPS = 1e-6
NEG = -1e30

kernel_name = "hymba_dilated_attn_shortconv_macaron"


def _rmsnorm(x, g):
    xf = x.astype(jnp.float32)
    y = xf * lax.rsqrt(jnp.mean(xf * xf, axis=-1, keepdims=True) + EPS)
    return (y * g.astype(jnp.float32)).astype(x.dtype)


def _band_attention(q, k, v, span):
    n, L, h, hd = q.shape
    nb = L // BLOCK
    qb = q.reshape(n, nb, BLOCK, h, hd)
    kb = k.reshape(n, nb, BLOCK, h, hd)
    vb = v.reshape(n, nb, BLOCK, h, hd)
    zk = jnp.zeros_like(kb[:, :1])
    k2 = jnp.concatenate([jnp.concatenate([zk, kb[:, :-1]], axis=1), kb], axis=2)
    v2 = jnp.concatenate([jnp.concatenate([zk, vb[:, :-1]], axis=1), vb], axis=2)
    s = jnp.einsum('nbqhd,nbkhd->nbhqk', qb, k2).astype(jnp.float32) * (hd ** -0.5)
    qi = jnp.arange(BLOCK)[:, None] + BLOCK
    kj = jnp.arange(2 * BLOCK)[None, :]
    dist = qi - kj
    band = (dist >= 0) & (dist <= span)
    blk = jnp.arange(nb)[:, None, None]
    mask = band[None] & ((blk > 0) | (kj[None] >= BLOCK))
    s = jnp.where(mask[None, :, None], s, NEG)
    m = jnp.max(s, axis=-1, keepdims=True)
    p = jnp.exp(s - m)
    l = jnp.sum(p, axis=-1, keepdims=True)
    o = jnp.einsum('nbhqk,nbkhd->nbqhd', (p / l).astype(v.dtype), v2)
    lse = (m + jnp.log(l))[..., 0]
    return o.reshape(n, L, h, hd), lse.transpose(0, 1, 3, 2).reshape(n, L, h)


def _dilated_branch(q, k, v, window, dilation):
    b, s, h, hd = q.shape
    L = s // dilation
    Lp = -(-L // BLOCK) * BLOCK

    def to_res(t):
        t = t.reshape(b, L, dilation, h, hd).transpose(0, 2, 1, 3, 4).reshape(b * dilation, L, h, hd)
        return jnp.pad(t, ((0, 0), (0, Lp - L), (0, 0), (0, 0)))

    o, lse = _band_attention(to_res(q), to_res(k), to_res(v), window // dilation)
    o = o[:, :L].reshape(b, dilation, L, h, hd).transpose(0, 2, 1, 3, 4).reshape(b, s, h, hd)
    lse = lse[:, :L].reshape(b, dilation, L, h).transpose(0, 2, 1, 3).reshape(b, s, h)
    return o, lse


def _dilated_attention(q, k, v):
    outs, lses = [], []
    for window, dilation in DILATED_BRANCHES:
        o, lse = _dilated_branch(q, k, v, window, dilation)
        outs.append(o)
        lses.append(lse)
    wts = jax.nn.softmax(jnp.stack(lses, axis=-1), axis=-1)
    return jnp.einsum('bshr,rbshd->bshd', wts.astype(q.dtype), jnp.stack(outs, axis=0))


def _short_conv(u, w, bias):
    y = lax.conv_general_dilated(
        u, w[:, None, :].astype(u.dtype), window_strides=(1,),
        padding=((CONV_K - 1, 0),), dimension_numbers=('NWC', 'WIO', 'NWC'),
        feature_group_count=u.shape[-1])
    return y + bias


def _swiglu(h, w1, w2):
    g, up = jnp.split(h @ w1, 2, axis=-1)
    return (jax.nn.silu(g) * up) @ w2


def _mixer(h, w_in, q_g, k_g, conv_w, conv_b, w_out):
    b, s, _ = h.shape
    A, C = ATTN_WIDTH, CONV_WIDTH
    proj = h @ w_in
    q, k, v, gb, gc, u = jnp.split(proj, [A, 2 * A, 3 * A, 3 * A + C, 3 * A + 2 * C], axis=-1)
    q = _rmsnorm(q.reshape(b, s, N_ATTN_HEADS, HEAD_DIM), q_g)
    k = _rmsnorm(k.reshape(b, s, N_ATTN_HEADS, HEAD_DIM), k_g)
    v = v.reshape(b, s, N_ATTN_HEADS, HEAD_DIM)
    y_attn = _dilated_attention(q, k, v).reshape(b, s, A)
    y_conv = gb * _short_conv(gc * u, conv_w, conv_b)
    return jnp.concatenate([y_attn, y_conv], axis=-1) @ w_out


def setup_inputs(seed: int = 0) -> dict:
    key = jax.random.key(seed)
    ks = jax.random.split(key, 14)
    D = D_MODEL
    nrm = jax.random.normal
    return {
        "x": nrm(ks[0], (BATCH, SEQ, D), jnp.float32),
        "c": nrm(ks[1], (BATCH, D), jnp.float32),
        "w_ada": nrm(ks[2], (DEPTH, D, N_SUB * N_MOD * D), jnp.float32) * (0.5 * D ** -0.5),
        "b_ada": nrm(ks[3], (DEPTH, N_SUB * N_MOD * D), jnp.float32) * 0.02,
        "norm_g": 1.0 + 0.02 * nrm(ks[4], (DEPTH, N_SUB, D), jnp.float32),
        "w_in": nrm(ks[5], (DEPTH, D, IN_COLS), jnp.float32) * D ** -0.5,
        "q_norm_g": 1.0 + 0.02 * nrm(ks[6], (DEPTH, HEAD_DIM), jnp.float32),
        "k_norm_g": 1.0 + 0.02 * nrm(ks[7], (DEPTH, HEAD_DIM), jnp.float32),
        "conv_w": nrm(ks[8], (DEPTH, CONV_K, CONV_WIDTH), jnp.float32) * CONV_K ** -0.5,
        "conv_b": nrm(ks[9], (DEPTH, CONV_WIDTH), jnp.float32) * 0.02,
        "w_out": nrm(ks[10], (DEPTH, D, D), jnp.float32) * D ** -0.5,
        "ffn_w1": nrm(ks[11], (DEPTH, 2, D, 2 * D_FF), jnp.float32) * D ** -0.5,
        "ffn_w2": nrm(ks[12], (DEPTH, 2, D_FF, D), jnp.float32) * D_FF ** -0.5,
    }


def reference(x, c, w_ada, b_ada, norm_g, w_in, q_norm_g, k_norm_g, conv_w, conv_b,
              w_out, ffn_w1, ffn_w2):
    b = x.shape[0]
    for layer in range(DEPTH):
        mod = (jax.nn.silu(c) @ w_ada[layer] + b_ada[layer]).reshape(b, N_SUB, N_MOD, D_MODEL)
        shift = mod[:, :, 0, None, :]
        scale = mod[:, :, 1, None, :]
        gate = mod[:, :, 2, None, :]

        def ada(z, i):
            return _rmsnorm(z, norm_g[layer, i]) * (1.0 + scale[:, i]) + shift[:, i]

        x = x + 0.5 * gate[:, 0] * _swiglu(ada(x, 0), ffn_w1[layer, 0], ffn_w2[layer, 0])
        x = x + gate[:, 1] * _mixer(ada(x, 1), w_in[layer], q_norm_g[layer], k_norm_g[layer],
                                    conv_w[layer], conv_b[layer], w_out[layer])
        x = x + 0.5 * gate[:, 2] * _swiglu(ada(x, 2), ffn_w1[layer, 1], ffn_w2[layer, 1])
    return x
```

```cpp
#include <hip/hip_runtime.h>
#include <hip/hip_cooperative_groups.h>
#include <cstdio>
#include <cstdint>
namespace cg = cooperative_groups;
namespace pg8 {
#define PG8_LAS __attribute__((address_space(3)))
typedef unsigned short bf16_t;
typedef short bf16x8 __attribute__((ext_vector_type(8)));
typedef float f32x4 __attribute__((ext_vector_type(4)));
typedef unsigned u32x4 __attribute__((ext_vector_type(4)));
constexpr int BM = 256, BK = 64, HALF = 128, HTB = HALF * BK * 2  , STAGE_BYTES = 8 * HTB, NXCD = 8, WGM = 8;

__host__ __device__ __forceinline__ int lds_byte(int r, int c) { const int st = (r >> 4) * 2 + (c >> 5), rr = r & 15, cc = c & 31, ob = rr * 64 + cc * 2; return st * 1024 + (ob ^ (((ob >> 9) & 1) << 5)); }
__host__ __device__ __forceinline__ void stage_rc(int b, int& R, int& C) { const int st = b / 1024, sb = b % 1024, swz = sb ^ (((sb >> 9) & 1) << 5); R = (st >> 1) * 16 + swz / 64; C = (st & 1) * 32 + (swz % 64) / 2; }
__host__ __device__ __forceinline__ int perm32(int rho) { const int n = rho >> 4, i = rho & 15; return 8 * (i >> 2) + 4 * n + (i & 3); }

struct Unit { int pm, pn; };
struct Gemm { const bf16_t* A; const bf16_t* Bt; int M, N, K; };

struct StaticOrder {
    int nM, nN, nwg, G, c;
    __host__ __device__ void init(int M, int N, int G_, int c_) { nM = M / BM; nN = N / BM; nwg = nM * nN; G = G_; c = c_; }
    __host__ __device__ bool next(int i, Unit& u) const {
        const long L = (long)i * G + c; if (L >= nwg) return false;
        int wgid = (int)L; { const int q = nwg / NXCD, r = nwg % NXCD, xcd = wgid % NXCD, off = wgid / NXCD; wgid = (xcd < r ? xcd * (q + 1) : r * (q + 1) + (xcd - r) * q) + off; }
        const int nig = WGM * nN, gid = wgid / nig, fm = gid * WGM, gsz = (nM - fm) < WGM ? (nM - fm) : WGM;
        u.pm = fm + ((wgid % nig) % gsz); u.pn = (wgid % nig) / gsz; return true;
    }
    __device__ __forceinline__ void a_ready(const Unit&) const {}
    __device__ __forceinline__ void done(const Unit&) const {}
};

typedef unsigned u32x2 __attribute__((ext_vector_type(2)));
__device__ __forceinline__ unsigned cvt_pk_bf16(float lo, float hi) { typedef float f2 __attribute__((ext_vector_type(2))); typedef __bf16 b2 __attribute__((ext_vector_type(2)));
    f2 v = {lo, hi}; b2 b = __builtin_convertvector(v, b2); return __builtin_bit_cast(unsigned, b); }
__device__ __forceinline__ float silu_f(float g) { return g * __builtin_amdgcn_rcpf(1.0f + __builtin_amdgcn_exp2f(-1.4426950408889634f * g)); }

struct EpiSwiglu {
    static constexpr bool PERM = true, AFTER_DRAIN = false;
    bf16_t* O; int ldc;
    __device__ __forceinline__ void operator()(const f32x4 (&acc)[2][2][4][2], const Unit& u, int wr, int wc, int fr, int fq) const {
        const int row0 = u.pm * BM + wr * 64 + fr, col0 = u.pn * HALF + wc * 32 + 8 * fq;
#pragma unroll
        for (int ai = 0; ai < 2; ++ai)
#pragma unroll
            for (int m = 0; m < 4; ++m) {
                const f32x4 g0 = acc[ai][0][m][0], g1 = acc[ai][0][m][1], u0 = acc[ai][1][m][0], u1 = acc[ai][1][m][1];
                u32x4 w;
                w.x = cvt_pk_bf16(silu_f(g0[0]) * u0[0], silu_f(g0[1]) * u0[1]); w.y = cvt_pk_bf16(silu_f(g0[2]) * u0[2], silu_f(g0[3]) * u0[3]);
                w.z = cvt_pk_bf16(silu_f(g1[0]) * u1[0], silu_f(g1[1]) * u1[1]); w.w = cvt_pk_bf16(silu_f(g1[2]) * u1[2], silu_f(g1[3]) * u1[3]);
                *(u32x4*)(O + (size_t)(row0 + ai * HALF + m * 16) * ldc + col0) = w;
            }
    }
};
struct EpiWin {
    static constexpr bool PERM = true, AFTER_DRAIN = false;
    bf16_t* O; int ldc; const float* qg; const float* kg; float qscale;
    __device__ __forceinline__ void operator()(const f32x4 (&acc)[2][2][4][2], const Unit& u, int wr, int wc, int fr, int fq) const {
        const int row0 = u.pm * BM + wr * 64 + fr, col0 = u.pn * BM + wc * 64 + 8 * fq;
        const int kind = u.pn < 2 ? 1 : (u.pn < 4 ? 2 : 0);
        f32x4 gv[2][2];
#pragma unroll
        for (int bj = 0; bj < 2; ++bj)
#pragma unroll
            for (int n = 0; n < 2; ++n) gv[bj][n] = kind ? *(const f32x4*)((kind == 1 ? qg : kg) + 32 * bj + 8 * fq + 4 * n) : (f32x4){1.f, 1.f, 1.f, 1.f};
        const float ks = kind == 1 ? qscale : 1.0f;
#pragma unroll
        for (int ai = 0; ai < 2; ++ai)
#pragma unroll
            for (int m = 0; m < 4; ++m) {
                float rs = 1.0f;
                if (kind) {
                    float ss = 0.f;
#pragma unroll
                    for (int bj = 0; bj < 2; ++bj)
#pragma unroll
                        for (int n = 0; n < 2; ++n) { const f32x4 x = acc[ai][bj][m][n]; ss += (x[0] * x[0] + x[1] * x[1]) + (x[2] * x[2] + x[3] * x[3]); }
                    ss += __shfl_xor(ss, 16); ss += __shfl_xor(ss, 32);
                    rs = ks * __builtin_amdgcn_rsqf(ss * (1.0f / 64.0f) + 1e-6f);
                }
                bf16_t* rowp = O + (size_t)(row0 + ai * HALF + m * 16) * ldc + col0;
#pragma unroll
                for (int bj = 0; bj < 2; ++bj) {
                    const f32x4 v0 = acc[ai][bj][m][0] * (gv[bj][0] * rs), v1 = acc[ai][bj][m][1] * (gv[bj][1] * rs);
                    u32x4 w; w.x = cvt_pk_bf16(v0[0], v0[1]); w.y = cvt_pk_bf16(v0[2], v0[3]); w.z = cvt_pk_bf16(v1[0], v1[1]); w.w = cvt_pk_bf16(v1[2], v1[3]);
                    *(u32x4*)(rowp + 32 * bj) = w;
                }
            }
    }
};
struct EpiResid {
    static constexpr bool PERM = false, AFTER_DRAIN = false;
    const float* xin; float* out; const float* gate; int gate_bstride; int rows_per_batch_shift; float gs;
    __device__ __forceinline__ void operator()(const f32x4 (&acc)[2][2][4][2], const Unit& u, int wr, int wc, int fr, int fq) const {
        const int b = (u.pm * BM) >> rows_per_batch_shift;
        const float* gp = gate + (size_t)b * gate_bstride;
        const int row0 = u.pm * BM + wr * 64 + fr, col0 = u.pn * BM + wc * 32 + 4 * fq;
        f32x4 gv[2][2];
#pragma unroll
        for (int bj = 0; bj < 2; ++bj)
#pragma unroll
            for (int n = 0; n < 2; ++n) gv[bj][n] = *(const f32x4*)(gp + col0 + bj * HALF + n * 16) * gs;
#pragma unroll
        for (int ai = 0; ai < 2; ++ai)
#pragma unroll
            for (int m = 0; m < 4; ++m) { const size_t off = (size_t)(row0 + ai * HALF + m * 16) * 1024 + col0;
#pragma unroll
                for (int bj = 0; bj < 2; ++bj)
#pragma unroll
                    for (int n = 0; n < 2; ++n) { const f32x4 xv = *(const f32x4*)(xin + off + bj * HALF + n * 16); *(f32x4*)(out + off + bj * HALF + n * 16) = xv + gv[bj][n] * acc[ai][bj][m][n]; } }
    }
};
template <class Epi, class Sched, bool ALIGN_EPI = false, bool SP2 = false>
__device__ __forceinline__ void gemm_phase(PG8_LAS unsigned char* lds, const int tid, const Gemm g, const Sched& S, const Epi& E) {
    const int wid = __builtin_amdgcn_readfirstlane(tid >> 6), lane = tid & 63, wr = wid >> 2, wc = wid & 3, fr = lane & 15, fq = lane >> 4;
    const int K = g.K, nt = K / BK;
    unsigned voffA[2], voffB[2];
#pragma unroll
    for (int i = 0; i < 2; ++i) { int R, C; stage_rc(tid * 16 + i * 8192, R, C); const int Rb = Epi::PERM ? ((R & ~31) + perm32(R & 31)) : R;
        voffA[i] = (unsigned)(R * K + C) * 2u; voffB[i] = (unsigned)(Rb * K + C) * 2u; }
    const size_t kstep = (size_t)(BK * 2);
    const size_t hstep = (size_t)HALF * K * 2;
    const size_t tstep = 2 * hstep;
    const unsigned ldsw = (unsigned)wid * 1024u;
    const int aoff = lds_byte(wr * 64 + fr, fq * 8), boff = lds_byte(wc * 32 + fr, fq * 8);
#define PG8_SA(b, h) (((b) * 2 + (h)) * HTB)
#define PG8_SB(b, h) ((4 + (b) * 2 + (h)) * HTB)
#define PG8_STAGE(bufoff, gbase, voff) do { _Pragma("unroll") for (int _i = 0; _i < 2; ++_i) \
        __builtin_amdgcn_global_load_lds((const unsigned*)((const char*)(gbase) + (voff)[_i]), (PG8_LAS unsigned*)(lds + (bufoff) + ldsw + _i * 8192), 16, 0, 0); } while (0)
#define PG8_LDA(dst, b, h) do { _Pragma("unroll") for (int m = 0; m < 4; ++m) _Pragma("unroll") for (int k = 0; k < 2; ++k) dst[m][k] = *(const PG8_LAS bf16x8*)(lds + PG8_SA(b, h) + aoff + m * 2048 + k * 1024); } while (0)
#define PG8_LDB(dst, b, h) do { _Pragma("unroll") for (int n = 0; n < 2; ++n) _Pragma("unroll") for (int k = 0; k < 2; ++k) dst[n][k] = *(const PG8_LAS bf16x8*)(lds + PG8_SB(b, h) + boff + n * 2048 + k * 1024); } while (0)
#define PG8_MMA(ai, bj, At, Bt) do { __builtin_amdgcn_s_setprio(1); _Pragma("unroll") for (int m = 0; m < 4; ++m) _Pragma("unroll") for (int n = 0; n < 2; ++n) _Pragma("unroll") for (int k = 0; k < 2; ++k) \
        acc[ai][bj][m][n] = __builtin_amdgcn_mfma_f32_16x16x32_bf16(Bt[n][k], At[m][k], acc[ai][bj][m][n], 0, 0, 0); __builtin_amdgcn_s_setprio(0); } while (0)
#define PG8_WAIT_V(n) asm volatile("s_waitcnt vmcnt(" #n ")" ::: "memory")
#define PG8_WAIT_L(n) asm volatile("s_waitcnt lgkmcnt(" #n ")" ::: "memory")
#define PG8_BAR __builtin_amdgcn_s_barrier()
#define PG8_SCHED __builtin_amdgcn_sched_barrier(0)
    Unit cur, nxt; int ui = 0;
    if (!S.next(0, cur)) return;
    f32x4 acc[2][2][4][2];
#pragma unroll
    for (int a = 0; a < 2; ++a)
#pragma unroll
        for (int b = 0; b < 2; ++b)
#pragma unroll
            for (int m = 0; m < 4; ++m)
#pragma unroll
                for (int n = 0; n < 2; ++n) acc[a][b][m][n] = (f32x4){0.f, 0.f, 0.f, 0.f};
    bf16x8 At[4][2], B0[2][2], B1[2][2];
    const char* cA = (const char*)g.A + (size_t)cur.pm * tstep; const char* cB = (const char*)g.Bt + (size_t)cur.pn * tstep;
    S.a_ready(cur);
    if constexpr (SP2) {
        PG8_STAGE(PG8_SB(0, 0), cB, voffB); PG8_STAGE(PG8_SB(0, 1), cB + hstep, voffB); PG8_STAGE(PG8_SA(0, 0), cA, voffA); PG8_STAGE(PG8_SA(0, 1), cA + hstep, voffA);
        if (wr == 1) PG8_BAR;
        PG8_WAIT_V(2); PG8_BAR;
        PG8_STAGE(PG8_SB(1, 0), cB + kstep, voffB); PG8_STAGE(PG8_SA(1, 0), cA + kstep, voffA); PG8_STAGE(PG8_SB(1, 1), cB + hstep + kstep, voffB);
        PG8_WAIT_V(6); PG8_BAR;
    } else {
        PG8_STAGE(PG8_SB(0, 0), cB, voffB); PG8_STAGE(PG8_SA(0, 0), cA, voffA); PG8_STAGE(PG8_SB(0, 1), cB + hstep, voffB); PG8_STAGE(PG8_SA(0, 1), cA + hstep, voffA);
        if (wr == 1) PG8_BAR;
        PG8_WAIT_V(4); PG8_BAR;
        PG8_STAGE(PG8_SB(1, 0), cB + kstep, voffB); PG8_STAGE(PG8_SA(1, 0), cA + kstep, voffA); PG8_STAGE(PG8_SB(1, 1), cB + hstep + kstep, voffB);
        PG8_WAIT_V(6); PG8_BAR;
    }
    for (;;) {
        const bool has_next = S.next(ui + 1, nxt);
        const char* nA = has_next ? (const char*)g.A + (size_t)nxt.pm * tstep : cA; const char* nB = has_next ? (const char*)g.Bt + (size_t)nxt.pn * tstep : cB;
        for (int t = 0; t < nt; t += 2) {
            const bool last = (t == nt - 2);
            const char* a1 = cA + (size_t)(t + 1) * kstep;
            const char* a2 = last ? nA : cA + (size_t)(t + 2) * kstep; const char* b2 = last ? nB : cB + (size_t)(t + 2) * kstep;
            const char* a3 = a2 + kstep; const char* b3 = b2 + kstep;
            if (last && has_next) S.a_ready(nxt);
            if constexpr (SP2) {
            PG8_LDB(B0, 0, 0); PG8_LDB(B1, 0, 1); PG8_SCHED; PG8_LDA(At, 0, 0); PG8_STAGE(PG8_SA(1, 1), a1 + hstep, voffA);
            PG8_WAIT_V(8); PG8_WAIT_L(0); PG8_BAR; PG8_MMA(0, 0, At, B0); PG8_MMA(0, 1, At, B1); PG8_BAR; PG8_SCHED;
            PG8_LDA(At, 0, 1); PG8_STAGE(PG8_SB(0, 0), b2, voffB); PG8_STAGE(PG8_SB(0, 1), b2 + hstep, voffB); PG8_STAGE(PG8_SA(0, 0), a2, voffA);
            PG8_WAIT_V(8); PG8_WAIT_L(0); PG8_BAR; PG8_MMA(1, 0, At, B0); PG8_MMA(1, 1, At, B1); PG8_BAR; PG8_SCHED;
            PG8_LDB(B0, 1, 0); PG8_LDB(B1, 1, 1); PG8_SCHED; PG8_LDA(At, 1, 0); PG8_STAGE(PG8_SA(0, 1), a2 + hstep, voffA);
            PG8_WAIT_V(8); PG8_WAIT_L(0); PG8_BAR; PG8_MMA(0, 0, At, B0); PG8_MMA(0, 1, At, B1); PG8_BAR; PG8_SCHED;
            PG8_LDA(At, 1, 1); PG8_STAGE(PG8_SB(1, 0), b3, voffB); PG8_STAGE(PG8_SB(1, 1), b3 + hstep, voffB); PG8_STAGE(PG8_SA(1, 0), a3, voffA);
            PG8_WAIT_V(8); PG8_WAIT_L(0); PG8_BAR; PG8_MMA(1, 0, At, B0); PG8_MMA(1, 1, At, B1); PG8_BAR; PG8_SCHED;
            } else {
            PG8_LDB(B0, 0, 0); PG8_SCHED; PG8_LDA(At, 0, 0); PG8_STAGE(PG8_SA(1, 1), a1 + hstep, voffA);
            PG8_WAIT_L(8); PG8_BAR; PG8_WAIT_L(0); PG8_MMA(0, 0, At, B0); PG8_BAR; PG8_SCHED;
            PG8_LDB(B1, 0, 1); PG8_STAGE(PG8_SB(0, 0), b2, voffB);
            PG8_BAR; PG8_WAIT_L(0); PG8_MMA(0, 1, At, B1); PG8_BAR;
            PG8_LDA(At, 0, 1); PG8_STAGE(PG8_SA(0, 0), a2, voffA);
            PG8_BAR; PG8_WAIT_L(0); PG8_MMA(1, 0, At, B0); PG8_BAR; PG8_SCHED;
            PG8_STAGE(PG8_SB(0, 1), b2 + hstep, voffB);
            PG8_WAIT_V(6); PG8_BAR; PG8_MMA(1, 1, At, B1); PG8_BAR;
            PG8_LDB(B0, 1, 0); PG8_SCHED; PG8_LDA(At, 1, 0); PG8_STAGE(PG8_SA(0, 1), a2 + hstep, voffA);
            PG8_WAIT_L(8); PG8_BAR; PG8_WAIT_L(0); PG8_MMA(0, 0, At, B0); PG8_BAR; PG8_SCHED;
            PG8_LDB(B1, 1, 1); PG8_STAGE(PG8_SB(1, 0), b3, voffB);
            PG8_BAR; PG8_WAIT_L(0); PG8_MMA(0, 1, At, B1); PG8_BAR;
            PG8_LDA(At, 1, 1); PG8_STAGE(PG8_SA(1, 0), a3, voffA);
            PG8_BAR; PG8_WAIT_L(0); PG8_MMA(1, 0, At, B0); PG8_BAR; PG8_SCHED;
            PG8_STAGE(PG8_SB(1, 1), b3 + hstep, voffB);
            PG8_WAIT_V(6); PG8_BAR; PG8_MMA(1, 1, At, B1); PG8_BAR;
            }
        }
        if constexpr (ALIGN_EPI) { if (wr == 0) PG8_BAR; }
        if constexpr (!Epi::AFTER_DRAIN) { E(acc, cur, wr, wc, fr, fq); S.done(cur); }
        if (!has_next) break;
#pragma unroll
        for (int a = 0; a < 2; ++a)
#pragma unroll
            for (int b = 0; b < 2; ++b)
#pragma unroll
                for (int m = 0; m < 4; ++m)
#pragma unroll
                    for (int n = 0; n < 2; ++n) acc[a][b][m][n] = (f32x4){0.f, 0.f, 0.f, 0.f};
        cur = nxt; cA = nA; cB = nB; ++ui;
        if constexpr (ALIGN_EPI) { if (wr == 1) PG8_BAR; }
    }
    PG8_WAIT_V(0);
    if constexpr (!ALIGN_EPI) { if (wr == 0) PG8_BAR; }
    PG8_BAR;
    if constexpr (Epi::AFTER_DRAIN) { E.fused(acc, cur, wr, wc, fr, fq, lds, wid, lane); S.done(cur); }
#undef PG8_SA
#undef PG8_SB
#undef PG8_STAGE
#undef PG8_LDA
#undef PG8_LDB
#undef PG8_MMA
#undef PG8_WAIT_V
#undef PG8_WAIT_L
#undef PG8_BAR
#undef PG8_SCHED
}
}

#define LAS __attribute__((address_space(3)))
typedef unsigned short bf16_t;
typedef short bf16x8 __attribute__((ext_vector_type(8)));
typedef short s16x4 __attribute__((ext_vector_type(4)));
typedef float f32x4 __attribute__((ext_vector_type(4)));
typedef float f32x16 __attribute__((ext_vector_type(16)));
typedef unsigned u32x4 __attribute__((ext_vector_type(4)));
typedef unsigned u32x2 __attribute__((ext_vector_type(2)));
constexpr int DM = 1024, NB = 4, SEQ = 8192, DEPTH = 2, FF = 2816, NH = 8, HD = 64, AW = 512, INC = 3072, MODW = 9216;
constexpr int M = NB * SEQ;
constexpr float EPS = 1e-6f;
constexpr float QSCALE = 0.125f * 1.4426950408889634f;
constexpr float NEGBIG = -1e30f;
constexpr int NWAVES = 8, NTHR = 512;
constexpr size_t MiB = 1u << 20;
constexpr size_t WS_MOD = 0;
constexpr size_t WS_W = 2 * MiB;
constexpr size_t W1_BYTES = (size_t)2 * FF * DM * 2, W2_BYTES = (size_t)DM * FF * 2, WIN_BYTES = (size_t)INC * DM * 2, WOUT_BYTES = (size_t)DM * DM * 2;
constexpr size_t LW_W1 = 0, LW_W2 = 2 * W1_BYTES, LW_WIN = LW_W2 + 2 * W2_BYTES, LW_WOUT = LW_WIN + WIN_BYTES, LW_BYTES = LW_WOUT + WOUT_BYTES;
static_assert(WS_W + DEPTH * LW_BYTES <= 88 * MiB, "weights");
constexpr size_t WS_H = 88 * MiB;
constexpr size_t WS_YC = 152 * MiB;
constexpr size_t WS_ACT = 216 * MiB;
constexpr size_t WS_O23 = 408 * MiB;
constexpr size_t WS_LSE = 472 * MiB;
constexpr size_t WS_END = 474 * MiB;
constexpr int RING_BYTES = 131072, WSCR_OFF = RING_BYTES, LDS_BYTES = RING_BYTES + NWAVES * 512 + 256;

__device__ __forceinline__ float bf_lo(unsigned u) { return __uint_as_float(u << 16); }
__device__ __forceinline__ float bf_hi(unsigned u) { return __uint_as_float(u & 0xffff0000u); }
__device__ __forceinline__ float wave_sum(float v) {
#pragma unroll
    for (int o = 1; o < 64; o <<= 1) v += __shfl_xor(v, o);
    return v;
}
using pg8::cvt_pk_bf16;

__device__ __forceinline__ void transpose_item(const float* W, int K, int N, bf16_t* WT, int k0, int src_n0, int dst_n0, LAS float* scr, int lane) {
#pragma unroll 8
    for (int i = 0; i < 32; ++i) { const int kk = 2 * i + (lane >> 5); scr[kk * 33 + (lane & 31)] = W[(size_t)(k0 + kk) * N + src_n0 + (lane & 31)]; }
    asm volatile("s_waitcnt lgkmcnt(0)" ::: "memory");
    const int c = lane & 7;
#pragma unroll
    for (int j = 0; j < 4; ++j) { const int n = (lane >> 3) + 8 * j; const LAS float* s = scr + (8 * c) * 33 + n;
        u32x4 o; o.x = cvt_pk_bf16(s[0 * 33], s[1 * 33]); o.y = cvt_pk_bf16(s[2 * 33], s[3 * 33]); o.z = cvt_pk_bf16(s[4 * 33], s[5 * 33]); o.w = cvt_pk_bf16(s[6 * 33], s[7 * 33]);
        *(u32x4*)(WT + (size_t)(dst_n0 + n) * K + k0 + 8 * c) = o; }
    asm volatile("s_waitcnt lgkmcnt(0)" ::: "memory");
}
struct In { const float *x, *c, *w_ada, *b_ada, *norm_g, *w_in, *q_g, *k_g, *conv_w, *conv_b, *w_out, *w1, *w2; };

__device__ __forceinline__ void prologue(const In& I, unsigned char* ws, LAS unsigned char* lds, int tid, int lane, int wave) {
    LAS float* sc = (LAS float*)(lds + 69632);
    LAS float* red = (LAS float*)(lds + 69632 + 16384);
    float* mod = (float*)(ws + WS_MOD);
    for (int i = tid; i < NB * DM; i += NTHR) { const float v = I.c[i]; sc[i] = v / (1.0f + __expf(-v)); }
    __syncthreads();
    for (int it = blockIdx.x; it < DEPTH * (MODW / 64); it += gridDim.x) {
        const int l = it / (MODW / 64), j0 = (it % (MODW / 64)) * 64;
        const float* wp = I.w_ada + (size_t)l * DM * MODW + j0 + lane;
        float a0 = 0.f, a1 = 0.f, a2 = 0.f, a3 = 0.f; const int k0 = wave * 128;
#pragma unroll 8
        for (int k = k0; k < k0 + 128; ++k) { const float w = wp[(size_t)k * MODW]; a0 += sc[k] * w; a1 += sc[DM + k] * w; a2 += sc[2 * DM + k] * w; a3 += sc[3 * DM + k] * w; }
        red[(wave * 4 + 0) * 64 + lane] = a0; red[(wave * 4 + 1) * 64 + lane] = a1; red[(wave * 4 + 2) * 64 + lane] = a2; red[(wave * 4 + 3) * 64 + lane] = a3;
        __syncthreads();
        if (tid < 256) { const int b = tid >> 6, cl = tid & 63; float s = 0.f;
#pragma unroll
            for (int w = 0; w < 8; ++w) s += red[(w * 4 + b) * 64 + cl];
            mod[(size_t)(l * NB + b) * MODW + j0 + cl] = s + I.b_ada[(size_t)l * MODW + j0 + cl]; }
        __syncthreads();
    }
    LAS float* scr = (LAS float*)(lds + wave * 8448);
    const int gw = blockIdx.x * NWAVES + wave, NGW = gridDim.x * NWAVES;
    constexpr int I_W1 = (DM / 64) * (2 * FF / 32), I_W2 = (FF / 64) * (DM / 32), I_WIN = (DM / 64) * (INC / 32), I_WOUT = (DM / 64) * (DM / 32);
    constexpr int I_LAYER = 2 * I_W1 + 2 * I_W2 + I_WIN + I_WOUT;
    for (int it = gw; it < DEPTH * I_LAYER; it += NGW) {
        const int l = it / I_LAYER; int r = it % I_LAYER;
        unsigned char* lw = ws + WS_W + (size_t)l * LW_BYTES;
        if (r < 2 * I_W1) { const int f = r / I_W1; r %= I_W1; const int nblk = 2 * FF / 32, kb = r / nblk, nb = r % nblk, n0 = nb * 32;
            const int pn = n0 >> 8, bj = (n0 >> 7) & 1, i = n0 & 127;
            transpose_item(I.w1 + (size_t)(l * 2 + f) * DM * 2 * FF, DM, 2 * FF, (bf16_t*)(lw + LW_W1 + f * W1_BYTES), kb * 64, bj * FF + 128 * pn + i, n0, scr, lane); continue; }
        r -= 2 * I_W1;
        if (r < 2 * I_W2) { const int f = r / I_W2; r %= I_W2; const int nblk = DM / 32, kb = r / nblk, nb = r % nblk;
            transpose_item(I.w2 + (size_t)(l * 2 + f) * FF * DM, FF, DM, (bf16_t*)(lw + LW_W2 + f * W2_BYTES), kb * 64, nb * 32, nb * 32, scr, lane); continue; }
        r -= 2 * I_W2;
        if (r < I_WIN) { const int nblk = INC / 32, kb = r / nblk, nb = r % nblk, n0 = nb * 32; const int pn = n0 >> 8, bj = (n0 >> 7) & 1, wc = (n0 >> 5) & 3;
            transpose_item(I.w_in + (size_t)l * DM * INC, DM, INC, (bf16_t*)(lw + LW_WIN), kb * 64, 256 * pn + 64 * wc + 32 * bj, n0, scr, lane); continue; }
        r -= I_WIN;
        { const int nblk = DM / 32, kb = r / nblk, nb = r % nblk;
            transpose_item(I.w_out + (size_t)l * DM * DM, DM, DM, (bf16_t*)(lw + LW_WOUT), kb * 64, nb * 32, nb * 32, scr, lane); }
    }
}

__device__ __forceinline__ void norm_phase(const float* xin, bf16_t* h, const float* g, const float* modp  , int lane, int wave) {
    const int gw = blockIdx.x * NWAVES + wave, NGW = gridDim.x * NWAVES;
    for (int chunk = gw; chunk < M / 16; chunk += NGW) {
        const int row0 = chunk * 16, b = row0 >> 13;
        const float* mp = modp + (size_t)b * MODW;
        f32x4 G[4], S[4];
#pragma unroll
        for (int j = 0; j < 4; ++j) { const int c = 4 * lane + 256 * j; G[j] = *(const f32x4*)(g + c) * (*(const f32x4*)(mp + DM + c) + 1.0f); S[j] = *(const f32x4*)(mp + c); }
        for (int r = 0; r < 16; ++r) {
            const f32x4* xr = (const f32x4*)(xin + (size_t)(row0 + r) * DM) + lane;
            f32x4 v[4]; float s = 0.f;
#pragma unroll
            for (int j = 0; j < 4; ++j) { v[j] = xr[64 * j]; s += (v[j].x * v[j].x + v[j].y * v[j].y) + (v[j].z * v[j].z + v[j].w * v[j].w); }
            const float rstd = 1.0f / sqrtf(wave_sum(s) * (1.0f / DM) + EPS);
            u32x2* o8 = (u32x2*)(h + (size_t)(row0 + r) * DM) + lane;
#pragma unroll
            for (int j = 0; j < 4; ++j) { const f32x4 o = v[j] * rstd * G[j] + S[j]; u32x2 w; w.x = cvt_pk_bf16(o.x, o.y); w.y = cvt_pk_bf16(o.z, o.w); o8[64 * j] = w; }
        }
    }
}

__device__ __forceinline__ int crow(int i, int hi) { return (i & 3) + 8 * (i >> 2) + 4 * hi; }
typedef short v4i16_t __attribute__((ext_vector_type(4)));
__device__ __forceinline__ s16x4 vtr(LAS const unsigned char* p) { return __builtin_bit_cast(s16x4, __builtin_amdgcn_ds_read_tr16_b64_v4i16((LAS v4i16_t*)p)); }

template <bool FINAL>
__device__ __forceinline__ void attn_item(LAS unsigned char* lds, const bf16_t* proj, int dil, int b, int h, int r, int nb, int br,
                                          bf16_t* o23, float* lse23, bf16_t* ycat, int tid, int lane, int wid) {
    const int half = wid >> 2, w = wid & 3, th = tid & 255, r32 = lane & 31, hi = lane >> 5;
    LAS unsigned char* Kl = lds + half * 65536; LAS unsigned char* Vl = Kl + 32768;
    LAS float* wsf = (LAS float*)(lds + WSCR_OFF + wid * 512);
    const size_t rowbase = (size_t)b * SEQ;
    {
        u32x4 kv[8], vv[8];
#pragma unroll
        for (int c = 0; c < 8; ++c) { const int idx = th + 256 * c, j = idx >> 3, ch = idx & 7; const int sidx = (nb - 1) * 128 + j;
            if (sidx >= 0) { const bf16_t* p = proj + (rowbase + (size_t)sidx * dil + r) * INC + h * HD + ch * 8; kv[c] = *(const u32x4*)(p + AW); vv[c] = *(const u32x4*)(p + 2 * AW); }
            else { kv[c] = (u32x4){0u, 0u, 0u, 0u}; vv[c] = (u32x4){0u, 0u, 0u, 0u}; } }
#pragma unroll
        for (int c = 0; c < 8; ++c) { const int idx = th + 256 * c, j = idx >> 3, ch = idx & 7;
            *(LAS u32x4*)(Kl + j * 128 + ((ch ^ ((j >> 1) & 7)) * 16)) = kv[c];
            *(LAS u32x4*)(Vl + j * 128 + (((ch >> 2) ^ ((j >> 1) & 1)) * 64) + (ch & 3) * 16) = vv[c]; }
    }
    const int qs = nb * 128 + 32 * w + r32;
    const size_t qrow = rowbase + (size_t)qs * dil + r;
    bf16x8 qf[4];
#pragma unroll
    for (int ks = 0; ks < 4; ++ks) qf[ks] = *(const bf16x8*)(proj + qrow * INC + h * HD + 16 * ks + 8 * hi);
    __syncthreads();
    f32x16 s[5];
#pragma unroll
    for (int tt = 0; tt < 5; ++tt) {
        const int kvrow = 32 * (w + tt) + r32;
        f32x16 a = {0.f, 0.f, 0.f, 0.f, 0.f, 0.f, 0.f, 0.f, 0.f, 0.f, 0.f, 0.f, 0.f, 0.f, 0.f, 0.f};
#pragma unroll
        for (int ks = 0; ks < 4; ++ks) { const bf16x8 kf = *(LAS const bf16x8*)(Kl + kvrow * 128 + (((2 * ks + hi) ^ ((kvrow >> 1) & 7)) * 16)); a = __builtin_amdgcn_mfma_f32_32x32x16_bf16(kf, qf[ks], a, 0, 0, 0); }
        s[tt] = a;
    }
#pragma unroll
    for (int i = 0; i < 16; ++i) { const int cr = crow(i, hi); if (cr < r32) s[0][i] = NEGBIG; if (cr > r32) s[4][i] = NEGBIG; }
    if (nb == 0) {
#pragma unroll
        for (int tt = 0; tt < 4; ++tt) if (w + tt < 4) {
#pragma unroll
            for (int i = 0; i < 16; ++i) s[tt][i] = NEGBIG; }
    }
    float mx = NEGBIG;
#pragma unroll
    for (int tt = 0; tt < 5; ++tt)
#pragma unroll
        for (int i = 0; i < 16; ++i) mx = fmaxf(mx, s[tt][i]);
    mx = fmaxf(mx, __shfl_xor(mx, 32));
    float l = 0.f;
#pragma unroll
    for (int tt = 0; tt < 5; ++tt)
#pragma unroll
        for (int i = 0; i < 16; ++i) { const float p = __builtin_amdgcn_exp2f(s[tt][i] - mx); s[tt][i] = p; l += p; }
    l += __shfl_xor(l, 32);
    f32x16 o[2];
#pragma unroll
    for (int d = 0; d < 2; ++d) o[d] = (f32x16){0.f, 0.f, 0.f, 0.f, 0.f, 0.f, 0.f, 0.f, 0.f, 0.f, 0.f, 0.f, 0.f, 0.f, 0.f, 0.f};
    const int i16 = lane & 15, q4 = i16 >> 2, p4 = i16 & 3, blk = (lane >> 4) & 1;
#pragma unroll
    for (int tt = 0; tt < 5; ++tt)
#pragma unroll
        for (int s2 = 0; s2 < 2; ++s2) {
            u32x4 pw; pw.x = cvt_pk_bf16(s[tt][8 * s2 + 0], s[tt][8 * s2 + 1]); pw.y = cvt_pk_bf16(s[tt][8 * s2 + 2], s[tt][8 * s2 + 3]);
            pw.z = cvt_pk_bf16(s[tt][8 * s2 + 4], s[tt][8 * s2 + 5]); pw.w = cvt_pk_bf16(s[tt][8 * s2 + 6], s[tt][8 * s2 + 7]);
            const bf16x8 pf = __builtin_bit_cast(bf16x8, pw);
            const int kvr = 32 * (w + tt) + 16 * s2 + 4 * hi + q4;
#pragma unroll
            for (int d = 0; d < 2; ++d) {
                LAS const unsigned char* vp = Vl + kvr * 128 + ((d ^ ((q4 >> 1) & 1)) * 64) + 32 * blk + 8 * p4;
                const s16x4 lo = vtr(vp), hi4 = vtr(vp + 8 * 128);
                const bf16x8 vf = (bf16x8){lo[0], lo[1], lo[2], lo[3], hi4[0], hi4[1], hi4[2], hi4[3]};
                o[d] = __builtin_amdgcn_mfma_f32_32x32x16_bf16(pf, vf, o[d], 0, 0, 0);
            }
        }
    const float lse = mx + __builtin_amdgcn_logf(l);
    if (!FINAL) {
        if (hi == 0) { wsf[r32] = 1.0f / l; lse23[((size_t)br * M + qrow) * NH + h] = lse; }
        bf16_t* ob = o23 + (size_t)br * M * AW;
#pragma unroll
        for (int i = 0; i < 16; ++i) { const int ql = crow(i, hi); const float c1 = wsf[ql];
            const size_t orow = rowbase + (size_t)(nb * 128 + 32 * w + ql) * dil + r;
#pragma unroll
            for (int d = 0; d < 2; ++d) ob[orow * AW + h * HD + 32 * d + r32] = (bf16_t)(cvt_pk_bf16(o[d][i] * c1, 0.f) & 0xffffu); }
    } else {
        const float l2 = lse23[(qrow) * NH + h], l3 = lse23[((size_t)M + qrow) * NH + h];
        const float mm = fmaxf(lse, fmaxf(l2, l3));
        const float e1 = __builtin_amdgcn_exp2f(lse - mm), e2 = __builtin_amdgcn_exp2f(l2 - mm), e3 = __builtin_amdgcn_exp2f(l3 - mm);
        const float inv = 1.0f / (e1 + e2 + e3);
        if (hi == 0) { wsf[r32] = e1 * inv / l; wsf[32 + r32] = e2 * inv; wsf[64 + r32] = e3 * inv; }
        const bf16_t* o2 = o23; const bf16_t* o3 = o23 + (size_t)M * AW;
#pragma unroll
        for (int i = 0; i < 16; ++i) { const int ql = crow(i, hi); const float c1 = wsf[ql], c2 = wsf[32 + ql], c3 = wsf[64 + ql];
            const size_t orow = rowbase + (size_t)(nb * 128 + 32 * w + ql);
#pragma unroll
            for (int d = 0; d < 2; ++d) { const size_t oi = orow * AW + h * HD + 32 * d + r32;
                const float v = c1 * o[d][i] + c2 * bf_lo((unsigned)o2[oi]) + c3 * bf_lo((unsigned)o3[oi]);
                ycat[orow * DM + h * HD + 32 * d + r32] = (bf16_t)(cvt_pk_bf16(v, 0.f) & 0xffffu); } }
    }
    __syncthreads();
}

__device__ __forceinline__ void attn_phase_a(LAS unsigned char* lds, const bf16_t* proj, bf16_t* o23, float* lse23, int tid, int lane, int wid) {
    for (int R = blockIdx.x; R < 2048; R += gridDim.x) {
        const int it = 2 * R + (wid >> 2);
        const int br = it >> 11, rem = it & 2047, bh = rem >> 6, rn = rem & 63;
        const int dil = br ? 16 : 4, nbc = 64 / dil, r = rn / nbc, nb = rn % nbc;
        attn_item<false>(lds, proj, dil, bh >> 3, bh & 7, r, nb, br, o23, lse23, nullptr, tid, lane, wid);
    }
}
__device__ __forceinline__ void attn_phase_b(LAS unsigned char* lds, const bf16_t* proj, bf16_t* o23, float* lse23, bf16_t* ycat, int tid, int lane, int wid) {
    for (int R = blockIdx.x; R < 1024; R += gridDim.x) {
        const int it = 2 * R + (wid >> 2);
        const int bh = it >> 6, nb = it & 63;
        attn_item<true>(lds, proj, 1, bh >> 3, bh & 7, 0, nb, 0, o23, lse23, ycat, tid, lane, wid);
    }
}
__device__ __forceinline__ void conv_phase(const bf16_t* proj, bf16_t* ycat, const float* cw, const float* cb, int tid) {
    for (int idx = blockIdx.x * NTHR + tid; idx < M * 64; idx += gridDim.x * NTHR) {
        const int row = idx >> 6, c0 = (idx & 63) * 8, t = row & (SEQ - 1);
        const bf16_t* p = proj + (size_t)row * INC + c0;
        const u32x4 gb = *(const u32x4*)(p + 1536), gc0 = *(const u32x4*)(p + 2048), u0 = *(const u32x4*)(p + 2560);
        u32x4 gc1 = {0u, 0u, 0u, 0u}, u1 = gc1, gc2 = gc1, u2 = gc1;
        if (t >= 1) { gc1 = *(const u32x4*)(p - INC + 2048); u1 = *(const u32x4*)(p - INC + 2560); }
        if (t >= 2) { gc2 = *(const u32x4*)(p - 2 * INC + 2048); u2 = *(const u32x4*)(p - 2 * INC + 2560); }
        u32x4 o;
#pragma unroll
        for (int e = 0; e < 4; ++e) {
            const int c = c0 + 2 * e;
            const float w0a = cw[c], w0b = cw[c + 1], w1a = cw[AW + c], w1b = cw[AW + c + 1], w2a = cw[2 * AW + c], w2b = cw[2 * AW + c + 1];
            const float ya = bf_lo(gb[e]) * (w2a * bf_lo(gc0[e]) * bf_lo(u0[e]) + w1a * bf_lo(gc1[e]) * bf_lo(u1[e]) + w0a * bf_lo(gc2[e]) * bf_lo(u2[e]) + cb[c]);
            const float yb = bf_hi(gb[e]) * (w2b * bf_hi(gc0[e]) * bf_hi(u0[e]) + w1b * bf_hi(gc1[e]) * bf_hi(u1[e]) + w0b * bf_hi(gc2[e]) * bf_hi(u2[e]) + cb[c + 1]);
            o[e] = cvt_pk_bf16(ya, yb);
        }
        *(u32x4*)(ycat + (size_t)row * DM + AW + c0) = o;
    }
}

#ifndef MK_MULTI
#define MK_MULTI 1
#endif
constexpr int N_PHASES = 1 + 11 * DEPTH;
struct Args { In in; float* out; unsigned char* ws; int ph_lo, ph_hi; };
static_assert(sizeof(Args) == 15 * 8 + 8, "Args has no padding");

__global__ void __launch_bounds__(NTHR, 2) fwd_megakernel(Args a) {
    extern __shared__ __attribute__((aligned(16))) unsigned char lds_raw[];
    LAS unsigned char* lds = (LAS unsigned char*)lds_raw;
    cg::grid_group grid = cg::this_grid();
    unsigned char* ws = a.ws;
    float* mod = (float*)(ws + WS_MOD);
    bf16_t* Hb = (bf16_t*)(ws + WS_H); bf16_t* YC = (bf16_t*)(ws + WS_YC); bf16_t* ACT = (bf16_t*)(ws + WS_ACT);
    bf16_t* O23 = (bf16_t*)(ws + WS_O23); float* LSE = (float*)(ws + WS_LSE);
    for (int ph_ = a.ph_lo; ph_ < a.ph_hi; ++ph_) {
        int ph = ph_; asm volatile("" : "+s"(ph));
        int tid = threadIdx.x; asm volatile("" : "+v"(tid));
        const int lane = tid & 63, wave = __builtin_amdgcn_readfirstlane(tid >> 6);
        if (ph == 0) { prologue(a.in, ws, lds, tid, lane, wave); }
        else {
            const int q = ph - 1, L = q / 11, k = q % 11;
            unsigned char* lw = ws + WS_W + (size_t)L * LW_BYTES;
            const float* lmod = mod + (size_t)L * NB * MODW;
            const float* xcur = (L == 0 && k <= 2) ? a.in.x : a.out;
            if (k == 0 || k == 3 || k == 8) {
                const int sub = k == 0 ? 0 : (k == 3 ? 1 : 2);
                norm_phase(xcur, Hb, a.in.norm_g + (size_t)(L * 3 + sub) * DM, lmod + sub * 3 * DM, lane, wave);
            } else if (k == 1 || k == 9) {
                const int f = k == 9;
                pg8::Gemm g{Hb, (const bf16_t*)(lw + LW_W1 + f * W1_BYTES), M, 2 * FF, DM}; pg8::StaticOrder S; S.init(M, 2 * FF, gridDim.x, blockIdx.x);
                pg8::EpiSwiglu E{ACT, FF};
                pg8::gemm_phase<pg8::EpiSwiglu, pg8::StaticOrder, true, true>(lds, tid, g, S, E);
            } else if (k == 2 || k == 10 || k == 7) {
                const int f = k == 10, sub = k == 2 ? 0 : (k == 7 ? 1 : 2);
                const bf16_t* A = k == 7 ? YC : ACT; const bf16_t* Bt = k == 7 ? (const bf16_t*)(lw + LW_WOUT) : (const bf16_t*)(lw + LW_W2 + f * W2_BYTES);
                pg8::Gemm g{A, Bt, M, DM, k == 7 ? DM : FF}; pg8::StaticOrder S; S.init(M, DM, gridDim.x, blockIdx.x);
                pg8::EpiResid E{xcur, a.out, lmod + sub * 3 * DM + 2 * DM, MODW, 13, k == 7 ? 1.0f : 0.5f};
                pg8::gemm_phase<pg8::EpiResid, pg8::StaticOrder, true, true>(lds, tid, g, S, E);
            } else if (k == 4) {
                pg8::Gemm g{Hb, (const bf16_t*)(lw + LW_WIN), M, INC, DM}; pg8::StaticOrder S; S.init(M, INC, gridDim.x, blockIdx.x);
                pg8::EpiWin E{ACT, INC, a.in.q_g + L * HD, a.in.k_g + L * HD, QSCALE};
                pg8::gemm_phase<pg8::EpiWin, pg8::StaticOrder, true, true>(lds, tid, g, S, E);
            } else if (k == 5) {
                attn_phase_a(lds, ACT, O23, LSE, tid, lane, wave);
            } else {
                attn_phase_b(lds, ACT, O23, LSE, YC, tid, lane, wave);
                conv_phase(ACT, YC, a.in.conv_w + (size_t)L * 3 * AW, a.in.conv_b + (size_t)L * AW, tid);
            }
        }
        if (ph_ + 1 < a.ph_hi) grid.sync();
    }
}

extern "C" void kernel_launch(void* const* d_in, const int* in_sizes, int n_in, void* d_out, int out_size, void* d_ws, size_t ws_size, hipStream_t stream) {
    static int grid_blocks = 0;
    if (grid_blocks == 0) {
        if (n_in != 13 || in_sizes[0] != M * DM || out_size != M * DM || ws_size < WS_END) { fprintf(stderr, "kernel_launch: unexpected shapes (n_in %d, in0 %d, out %d, ws %zu)\n", n_in, n_in > 0 ? in_sizes[0] : -1, out_size, ws_size); grid_blocks = -1; return; }
        int dev = 0, cus = 0, per_cu = 0;
        hipGetDevice(&dev);
        hipDeviceGetAttribute(&cus, hipDeviceAttributeMultiprocessorCount, dev);
        if (hipFuncSetAttribute((const void*)fwd_megakernel, hipFuncAttributeMaxDynamicSharedMemorySize, LDS_BYTES) != hipSuccess) fprintf(stderr, "kernel_launch: hipFuncSetAttribute failed\n");
        if (hipOccupancyMaxActiveBlocksPerMultiprocessor(&per_cu, (const void*)fwd_megakernel, NTHR, LDS_BYTES) != hipSuccess || per_cu < 1) { fprintf(stderr, "kernel_launch: occupancy query says %d\n", per_cu); per_cu = 1; }
        (void)hipGetLastError();
        grid_blocks = cus * per_cu;
    }
    if (grid_blocks < 0) return;
    Args a{};
    const float** ip = (const float**)&a.in;
    for (int i = 0; i < 13; ++i) ip[i] = (const float*)d_in[i];
    a.out = (float*)d_out; a.ws = (unsigned char*)d_ws;
#if MK_MULTI
    for (int ph = 0; ph < N_PHASES; ++ph) { a.ph_lo = ph; a.ph_hi = ph + 1; hipLaunchKernelGGL(fwd_megakernel, dim3(grid_blocks), dim3(NTHR), LDS_BYTES, stream, a); }
#else
    a.ph_lo = 0; a.ph_hi = N_PHASES;
    void* args[] = {&a};
    hipError_t e = hipLaunchCooperativeKernel((const void*)fwd_megakernel, dim3(grid_blocks), dim3(NTHR), args, LDS_BYTES, stream);
    if (e != hipSuccess) fprintf(stderr, "cooperative launch failed: %s (grid %d)\n", hipGetErrorString(e), grid_blocks);
#endif
}
```

```cpp
#include <hip/hip_runtime.h>
#include <hip/hip_cooperative_groups.h>
#include <cstdio>
#include <cstdint>
namespace cg = cooperative_groups;
namespace pg8 {
#define PG8_LAS __attribute__((address_space(3)))
typedef unsigned short bf16_t;
typedef short bf16x8 __attribute__((ext_vector_type(8)));
typedef float f32x4 __attribute__((ext_vector_type(4)));
typedef unsigned u32x4 __attribute__((ext_vector_type(4)));
constexpr int BM = 256, BK = 64, HALF = 128, HTB = HALF * BK * 2  , STAGE_BYTES = 8 * HTB, NXCD = 8, WGM = 8;

__host__ __device__ __forceinline__ int lds_byte(int r, int c) { const int st = (r >> 4) * 2 + (c >> 5), rr = r & 15, cc = c & 31, ob = rr * 64 + cc * 2; return st * 1024 + (ob ^ (((ob >> 9) & 1) << 5)); }
__host__ __device__ __forceinline__ void stage_rc(int b, int& R, int& C) { const int st = b / 1024, sb = b % 1024, swz = sb ^ (((sb >> 9) & 1) << 5); R = (st >> 1) * 16 + swz / 64; C = (st & 1) * 32 + (swz % 64) / 2; }
__host__ __device__ __forceinline__ int perm32(int rho) { const int n = rho >> 4, i = rho & 15; return 8 * (i >> 2) + 4 * n + (i & 3); }

struct Unit { int pm, pn; };
struct Gemm { const bf16_t* A; const bf16_t* Bt; int M, N, K; };

struct StaticOrder {
    int nM, nN, nwg, G, c;
    __host__ __device__ void init(int M, int N, int G_, int c_) { nM = M / BM; nN = N / BM; nwg = nM * nN; G = G_; c = c_; }
    __host__ __device__ bool next(int i, Unit& u) const {
        const long L = (long)i * G + c; if (L >= nwg) return false;
        int wgid = (int)L; { const int q = nwg / NXCD, r = nwg % NXCD, xcd = wgid % NXCD, off = wgid / NXCD; wgid = (xcd < r ? xcd * (q + 1) : r * (q + 1) + (xcd - r) * q) + off; }
        const int nig = WGM * nN, gid = wgid / nig, fm = gid * WGM, gsz = (nM - fm) < WGM ? (nM - fm) : WGM;
        u.pm = fm + ((wgid % nig) % gsz); u.pn = (wgid % nig) / gsz; return true;
    }
    __device__ __forceinline__ void a_ready(const Unit&) const {}
    __device__ __forceinline__ void done(const Unit&) const {}
};

typedef unsigned u32x2 __attribute__((ext_vector_type(2)));
__device__ __forceinline__ unsigned cvt_pk_bf16(float lo, float hi) { typedef float f2 __attribute__((ext_vector_type(2))); typedef __bf16 b2 __attribute__((ext_vector_type(2)));
    f2 v = {lo, hi}; b2 b = __builtin_convertvector(v, b2); return __builtin_bit_cast(unsigned, b); }
__device__ __forceinline__ float silu_f(float g) { return g * __builtin_amdgcn_rcpf(1.0f + __builtin_amdgcn_exp2f(-1.4426950408889634f * g)); }

struct EpiSwiglu {
    static constexpr bool PERM = true, AFTER_DRAIN = false;
    bf16_t* O; int ldc;
    __device__ __forceinline__ void operator()(const f32x4 (&acc)[2][2][4][2], const Unit& u, int wr, int wc, int fr, int fq) const {
        const int row0 = u.pm * BM + wr * 64 + fr, col0 = u.pn * HALF + wc * 32 + 8 * fq;
#pragma unroll
        for (int ai = 0; ai < 2; ++ai)
#pragma unroll
            for (int m = 0; m < 4; ++m) {
                const f32x4 g0 = acc[ai][0][m][0], g1 = acc[ai][0][m][1], u0 = acc[ai][1][m][0], u1 = acc[ai][1][m][1];
                u32x4 w;
                w.x = cvt_pk_bf16(silu_f(g0[0]) * u0[0], silu_f(g0[1]) * u0[1]); w.y = cvt_pk_bf16(silu_f(g0[2]) * u0[2], silu_f(g0[3]) * u0[3]);
                w.z = cvt_pk_bf16(silu_f(g1[0]) * u1[0], silu_f(g1[1]) * u1[1]); w.w = cvt_pk_bf16(silu_f(g1[2]) * u1[2], silu_f(g1[3]) * u1[3]);
                *(u32x4*)(O + (size_t)(row0 + ai * HALF + m * 16) * ldc + col0) = w;
            }
    }
};
struct EpiWin {
    static constexpr bool PERM = true, AFTER_DRAIN = false;
    bf16_t* O; int ldc; const float* qg; const float* kg; float qscale;
    __device__ __forceinline__ void operator()(const f32x4 (&acc)[2][2][4][2], const Unit& u, int wr, int wc, int fr, int fq) const {
        const int row0 = u.pm * BM + wr * 64 + fr, col0 = u.pn * BM + wc * 64 + 8 * fq;
        const int kind = u.pn < 2 ? 1 : (u.pn < 4 ? 2 : 0);
        f32x4 gv[2][2];
#pragma unroll
        for (int bj = 0; bj < 2; ++bj)
#pragma unroll
            for (int n = 0; n < 2; ++n) gv[bj][n] = kind ? *(const f32x4*)((kind == 1 ? qg : kg) + 32 * bj + 8 * fq + 4 * n) : (f32x4){1.f, 1.f, 1.f, 1.f};
        const float ks = kind == 1 ? qscale : 1.0f;
#pragma unroll
        for (int ai = 0; ai < 2; ++ai)
#pragma unroll
            for (int m = 0; m < 4; ++m) {
                float rs = 1.0f;
                if (kind) {
                    float ss = 0.f;
#pragma unroll
                    for (int bj = 0; bj < 2; ++bj)
#pragma unroll
                        for (int n = 0; n < 2; ++n) { const f32x4 x = acc[ai][bj][m][n]; ss += (x[0] * x[0] + x[1] * x[1]) + (x[2] * x[2] + x[3] * x[3]); }
                    ss += __shfl_xor(ss, 16); ss += __shfl_xor(ss, 32);
                    rs = ks * __builtin_amdgcn_rsqf(ss * (1.0f / 64.0f) + 1e-6f);
                }
                bf16_t* rowp = O + (size_t)(row0 + ai * HALF + m * 16) * ldc + col0;
#pragma unroll
                for (int bj = 0; bj < 2; ++bj) {
                    const f32x4 v0 = acc[ai][bj][m][0] * (gv[bj][0] * rs), v1 = acc[ai][bj][m][1] * (gv[bj][1] * rs);
                    u32x4 w; w.x = cvt_pk_bf16(v0[0], v0[1]); w.y = cvt_pk_bf16(v0[2], v0[3]); w.z = cvt_pk_bf16(v1[0], v1[1]); w.w = cvt_pk_bf16(v1[2], v1[3]);
                    *(u32x4*)(rowp + 32 * bj) = w;
                }
            }
    }
};
struct EpiResid {
    static constexpr bool PERM = false, AFTER_DRAIN = false;
    const float* xin; float* out; const float* gate; int gate_bstride; int rows_per_batch_shift; float gs;
    __device__ __forceinline__ void operator()(const f32x4 (&acc)[2][2][4][2], const Unit& u, int wr, int wc, int fr, int fq) const {
        const int b = (u.pm * BM) >> rows_per_batch_shift;
        const float* gp = gate + (size_t)b * gate_bstride;
        const int row0 = u.pm * BM + wr * 64 + fr, col0 = u.pn * BM + wc * 32 + 4 * fq;
        f32x4 gv[2][2];
#pragma unroll
        for (int bj = 0; bj < 2; ++bj)
#pragma unroll
            for (int n = 0; n < 2; ++n) gv[bj][n] = *(const f32x4*)(gp + col0 + bj * HALF + n * 16) * gs;
#pragma unroll
        for (int ai = 0; ai < 2; ++ai)
#pragma unroll
            for (int m = 0; m < 4; ++m) { const size_t off = (size_t)(row0 + ai * HALF + m * 16) * 1024 + col0;
#pragma unroll
                for (int bj = 0; bj < 2; ++bj)
#pragma unroll
                    for (int n = 0; n < 2; ++n) { const f32x4 xv = *(const f32x4*)(xin + off + bj * HALF + n * 16); *(f32x4*)(out + off + bj * HALF + n * 16) = xv + gv[bj][n] * acc[ai][bj][m][n]; } }
    }
};
template <class Epi, class Sched, bool ALIGN_EPI = false, bool SP2 = false>
__device__ __forceinline__ void gemm_phase(PG8_LAS unsigned char* lds, const int tid, const Gemm g, const Sched& S, const Epi& E) {
    const int wid = __builtin_amdgcn_readfirstlane(tid >> 6), lane = tid & 63, wr = wid >> 2, wc = wid & 3, fr = lane & 15, fq = lane >> 4;
    const int K = g.K, nt = K / BK;
    unsigned voffA[2], voffB[2];
#pragma unroll
    for (int i = 0; i < 2; ++i) { int R, C; stage_rc(tid * 16 + i * 8192, R, C); const int Rb = Epi::PERM ? ((R & ~31) + perm32(R & 31)) : R;
        voffA[i] = (unsigned)(R * K + C) * 2u; voffB[i] = (unsigned)(Rb * K + C) * 2u; }
    const size_t kstep = (size_t)(BK * 2);
    const size_t hstep = (size_t)HALF * K * 2;
    const size_t tstep = 2 * hstep;
    const unsigned ldsw = (unsigned)wid * 1024u;
    const int aoff = lds_byte(wr * 64 + fr, fq * 8), boff = lds_byte(wc * 32 + fr, fq * 8);
#define PG8_SA(b, h) (((b) * 2 + (h)) * HTB)
#define PG8_SB(b, h) ((4 + (b) * 2 + (h)) * HTB)
#define PG8_STAGE(bufoff, gbase, voff) do { _Pragma("unroll") for (int _i = 0; _i < 2; ++_i) \
        __builtin_amdgcn_global_load_lds((const unsigned*)((const char*)(gbase) + (voff)[_i]), (PG8_LAS unsigned*)(lds + (bufoff) + ldsw + _i * 8192), 16, 0, 0); } while (0)
#define PG8_LDA(dst, b, h) do { _Pragma("unroll") for (int m = 0; m < 4; ++m) _Pragma("unroll") for (int k = 0; k < 2; ++k) dst[m][k] = *(const PG8_LAS bf16x8*)(lds + PG8_SA(b, h) + aoff + m * 2048 + k * 1024); } while (0)
#define PG8_LDB(dst, b, h) do { _Pragma("unroll") for (int n = 0; n < 2; ++n) _Pragma("unroll") for (int k = 0; k < 2; ++k) dst[n][k] = *(const PG8_LAS bf16x8*)(lds + PG8_SB(b, h) + boff + n * 2048 + k * 1024); } while (0)
#define PG8_MMA(ai, bj, At, Bt) do { __builtin_amdgcn_s_setprio(1); _Pragma("unroll") for (int m = 0; m < 4; ++m) _Pragma("unroll") for (int n = 0; n < 2; ++n) _Pragma("unroll") for (int k = 0; k < 2; ++k) \
        acc[ai][bj][m][n] = __builtin_amdgcn_mfma_f32_16x16x32_bf16(Bt[n][k], At[m][k], acc[ai][bj][m][n], 0, 0, 0); __builtin_amdgcn_s_setprio(0); } while (0)
#define PG8_WAIT_V(n) asm volatile("s_waitcnt vmcnt(" #n ")" ::: "memory")
#define PG8_WAIT_L(n) asm volatile("s_waitcnt lgkmcnt(" #n ")" ::: "memory")
#define PG8_BAR __builtin_amdgcn_s_barrier()
#define PG8_SCHED __builtin_amdgcn_sched_barrier(0)
    Unit cur, nxt; int ui = 0;
    if (!S.next(0, cur)) return;
    f32x4 acc[2][2][4][2];
#pragma unroll
    for (int a = 0; a < 2; ++a)
#pragma unroll
        for (int b = 0; b < 2; ++b)
#pragma unroll
            for (int m = 0; m < 4; ++m)
#pragma unroll
                for (int n = 0; n < 2; ++n) acc[a][b][m][n] = (f32x4){0.f, 0.f, 0.f, 0.f};
    bf16x8 At[4][2], B0[2][2], B1[2][2];
    const char* cA = (const char*)g.A + (size_t)cur.pm * tstep; const char* cB = (const char*)g.Bt + (size_t)cur.pn * tstep;
    S.a_ready(cur);
    if constexpr (SP2) {
        PG8_STAGE(PG8_SB(0, 0), cB, voffB); PG8_STAGE(PG8_SB(0, 1), cB + hstep, voffB); PG8_STAGE(PG8_SA(0, 0), cA, voffA); PG8_STAGE(PG8_SA(0, 1), cA + hstep, voffA);
        if (wr == 1) PG8_BAR;
        PG8_WAIT_V(2); PG8_BAR;
        PG8_STAGE(PG8_SB(1, 0), cB + kstep, voffB); PG8_STAGE(PG8_SA(1, 0), cA + kstep, voffA); PG8_STAGE(PG8_SB(1, 1), cB + hstep + kstep, voffB);
        PG8_WAIT_V(6); PG8_BAR;
    } else {
        PG8_STAGE(PG8_SB(0, 0), cB, voffB); PG8_STAGE(PG8_SA(0, 0), cA, voffA); PG8_STAGE(PG8_SB(0, 1), cB + hstep, voffB); PG8_STAGE(PG8_SA(0, 1), cA + hstep, voffA);
        if (wr == 1) PG8_BAR;
        PG8_WAIT_V(4); PG8_BAR;
        PG8_STAGE(PG8_SB(1, 0), cB + kstep, voffB); PG8_STAGE(PG8_SA(1, 0), cA + kstep, voffA); PG8_STAGE(PG8_SB(1, 1), cB + hstep + kstep, voffB);
        PG8_WAIT_V(6); PG8_BAR;
    }
    for (;;) {
        const bool has_next = S.next(ui + 1, nxt);
        const char* nA = has_next ? (const char*)g.A + (size_t)nxt.pm * tstep : cA; const char* nB = has_next ? (const char*)g.Bt + (size_t)nxt.pn * tstep : cB;
        for (int t = 0; t < nt; t += 2) {
            const bool last = (t == nt - 2);
            const char* a1 = cA + (size_t)(t + 1) * kstep;
            const char* a2 = last ? nA : cA + (size_t)(t + 2) * kstep; const char* b2 = last ? nB : cB + (size_t)(t + 2) * kstep;
            const char* a3 = a2 + kstep; const char* b3 = b2 + kstep;
            if (last && has_next) S.a_ready(nxt);
            if constexpr (SP2) {
            PG8_LDB(B0, 0, 0); PG8_LDB(B1, 0, 1); PG8_SCHED; PG8_LDA(At, 0, 0); PG8_STAGE(PG8_SA(1, 1), a1 + hstep, voffA);
            PG8_WAIT_V(8); PG8_WAIT_L(0); PG8_BAR; PG8_MMA(0, 0, At, B0); PG8_MMA(0, 1, At, B1); PG8_BAR; PG8_SCHED;
            PG8_LDA(At, 0, 1); PG8_STAGE(PG8_SB(0, 0), b2, voffB); PG8_STAGE(PG8_SB(0, 1), b2 + hstep, voffB); PG8_STAGE(PG8_SA(0, 0), a2, voffA);
            PG8_WAIT_V(8); PG8_WAIT_L(0); PG8_BAR; PG8_MMA(1, 0, At, B0); PG8_MMA(1, 1, At, B1); PG8_BAR; PG8_SCHED;
            PG8_LDB(B0, 1, 0); PG8_LDB(B1, 1, 1); PG8_SCHED; PG8_LDA(At, 1, 0); PG8_STAGE(PG8_SA(0, 1), a2 + hstep, voffA);
            PG8_WAIT_V(8); PG8_WAIT_L(0); PG8_BAR; PG8_MMA(0, 0, At, B0); PG8_MMA(0, 1, At, B1); PG8_BAR; PG8_SCHED;
            PG8_LDA(At, 1, 1); PG8_STAGE(PG8_SB(1, 0), b3, voffB); PG8_STAGE(PG8_SB(1, 1), b3 + hstep, voffB); PG8_STAGE(PG8_SA(1, 0), a3, voffA);
            PG8_WAIT_V(8); PG8_WAIT_L(0); PG8_BAR; PG8_MMA(1, 0, At, B0); PG8_MMA(1, 1, At, B1); PG8_BAR; PG8_SCHED;
            } else {
            PG8_LDB(B0, 0, 0); PG8_SCHED; PG8_LDA(At, 0, 0); PG8_STAGE(PG8_SA(1, 1), a1 + hstep, voffA);
            PG8_WAIT_L(8); PG8_BAR; PG8_WAIT_L(0); PG8_MMA(0, 0, At, B0); PG8_BAR; PG8_SCHED;
            PG8_LDB(B1, 0, 1); PG8_STAGE(PG8_SB(0, 0), b2, voffB);
            PG8_BAR; PG8_WAIT_L(0); PG8_MMA(0, 1, At, B1); PG8_BAR;
            PG8_LDA(At, 0, 1); PG8_STAGE(PG8_SA(0, 0), a2, voffA);
            PG8_BAR; PG8_WAIT_L(0); PG8_MMA(1, 0, At, B0); PG8_BAR; PG8_SCHED;
            PG8_STAGE(PG8_SB(0, 1), b2 + hstep, voffB);
            PG8_WAIT_V(6); PG8_BAR; PG8_MMA(1, 1, At, B1); PG8_BAR;
            PG8_LDB(B0, 1, 0); PG8_SCHED; PG8_LDA(At, 1, 0); PG8_STAGE(PG8_SA(0, 1), a2 + hstep, voffA);
            PG8_WAIT_L(8); PG8_BAR; PG8_WAIT_L(0); PG8_MMA(0, 0, At, B0); PG8_BAR; PG8_SCHED;
            PG8_LDB(B1, 1, 1); PG8_STAGE(PG8_SB(1, 0), b3, voffB);
            PG8_BAR; PG8_WAIT_L(0); PG8_MMA(0, 1, At, B1); PG8_BAR;
            PG8_LDA(At, 1, 1); PG8_STAGE(PG8_SA(1, 0), a3, voffA);
            PG8_BAR; PG8_WAIT_L(0); PG8_MMA(1, 0, At, B0); PG8_BAR; PG8_SCHED;
            PG8_STAGE(PG8_SB(1, 1), b3 + hstep, voffB);
            PG8_WAIT_V(6); PG8_BAR; PG8_MMA(1, 1, At, B1); PG8_BAR;
            }
        }
        if constexpr (ALIGN_EPI) { if (wr == 0) PG8_BAR; }
        if constexpr (!Epi::AFTER_DRAIN) { E(acc, cur, wr, wc, fr, fq); S.done(cur); }
        if (!has_next) break;
#pragma unroll
        for (int a = 0; a < 2; ++a)
#pragma unroll
            for (int b = 0; b < 2; ++b)
#pragma unroll
                for (int m = 0; m < 4; ++m)
#pragma unroll
                    for (int n = 0; n < 2; ++n) acc[a][b][m][n] = (f32x4){0.f, 0.f, 0.f, 0.f};
        cur = nxt; cA = nA; cB = nB; ++ui;
        if constexpr (ALIGN_EPI) { if (wr == 1) PG8_BAR; }
    }
    PG8_WAIT_V(0);
    if constexpr (!ALIGN_EPI) { if (wr == 0) PG8_BAR; }
    PG8_BAR;
    if constexpr (Epi::AFTER_DRAIN) { E.fused(acc, cur, wr, wc, fr, fq, lds, wid, lane); S.done(cur); }
#undef PG8_SA
#undef PG8_SB
#undef PG8_STAGE
#undef PG8_LDA
#undef PG8_LDB
#undef PG8_MMA
#undef PG8_WAIT_V
#undef PG8_WAIT_L
#undef PG8_BAR
#undef PG8_SCHED
}
}

#define LAS __attribute__((address_space(3)))
typedef unsigned short bf16_t;
typedef short bf16x8 __attribute__((ext_vector_type(8)));
typedef short s16x4 __attribute__((ext_vector_type(4)));
typedef float f32x4 __attribute__((ext_vector_type(4)));
typedef float f32x16 __attribute__((ext_vector_type(16)));
typedef unsigned u32x4 __attribute__((ext_vector_type(4)));
typedef unsigned u32x2 __attribute__((ext_vector_type(2)));
constexpr int DM = 1024, NB = 4, SEQ = 8192, DEPTH = 2, FF = 2816, NH = 8, HD = 64, AW = 512, INC = 3072, MODW = 9216;
constexpr int M = NB * SEQ;
constexpr float EPS = 1e-6f;
constexpr float QSCALE = 0.125f * 1.4426950408889634f;
constexpr float NEGBIG = -1e30f;
constexpr int NWAVES = 8, NTHR = 512;
constexpr size_t MiB = 1u << 20;
constexpr size_t WS_MOD = 0;
constexpr size_t WS_W = 2 * MiB;
constexpr size_t W1_BYTES = (size_t)2 * FF * DM * 2, W2_BYTES = (size_t)DM * FF * 2, WIN_BYTES = (size_t)INC * DM * 2, WOUT_BYTES = (size_t)DM * DM * 2;
constexpr size_t LW_W1 = 0, LW_W2 = 2 * W1_BYTES, LW_WIN = LW_W2 + 2 * W2_BYTES, LW_WOUT = LW_WIN + WIN_BYTES, LW_BYTES = LW_WOUT + WOUT_BYTES;
static_assert(WS_W + DEPTH * LW_BYTES <= 88 * MiB, "weights");
constexpr size_t WS_H = 88 * MiB;
constexpr size_t WS_YC = 152 * MiB;
constexpr size_t WS_ACT = 216 * MiB;
constexpr size_t WS_O23 = 408 * MiB;
constexpr size_t WS_LSE = 472 * MiB;
constexpr size_t WS_END = 474 * MiB;
constexpr int RING_BYTES = 131072, WSCR_OFF = RING_BYTES, LDS_BYTES = RING_BYTES + NWAVES * 512 + 256;

__device__ __forceinline__ float bf_lo(unsigned u) { return __uint_as_float(u << 16); }
__device__ __forceinline__ float bf_hi(unsigned u) { return __uint_as_float(u & 0xffff0000u); }
__device__ __forceinline__ float wave_sum(float v) {
#pragma unroll
    for (int o = 1; o < 64; o <<= 1) v += __shfl_xor(v, o);
    return v;
}
using pg8::cvt_pk_bf16;

__device__ __forceinline__ void transpose_item(const float* W, int K, int N, bf16_t* WT, int k0, int src_n0, int dst_n0, LAS float* scr, int lane) {
#pragma unroll 8
    for (int i = 0; i < 32; ++i) { const int kk = 2 * i + (lane >> 5); scr[kk * 33 + (lane & 31)] = W[(size_t)(k0 + kk) * N + src_n0 + (lane & 31)]; }
    asm volatile("s_waitcnt lgkmcnt(0)" ::: "memory");
    const int c = lane & 7;
#pragma unroll
    for (int j = 0; j < 4; ++j) { const int n = (lane >> 3) + 8 * j; const LAS float* s = scr + (8 * c) * 33 + n;
        u32x4 o; o.x = cvt_pk_bf16(s[0 * 33], s[1 * 33]); o.y = cvt_pk_bf16(s[2 * 33], s[3 * 33]); o.z = cvt_pk_bf16(s[4 * 33], s[5 * 33]); o.w = cvt_pk_bf16(s[6 * 33], s[7 * 33]);
        *(u32x4*)(WT + (size_t)(dst_n0 + n) * K + k0 + 8 * c) = o; }
    asm volatile("s_waitcnt lgkmcnt(0)" ::: "memory");
}
struct In { const float *x, *c, *w_ada, *b_ada, *norm_g, *w_in, *q_g, *k_g, *conv_w, *conv_b, *w_out, *w1, *w2; };

__device__ __forceinline__ void prologue(const In& I, unsigned char* ws, LAS unsigned char* lds, int tid, int lane, int wave) {
    LAS float* sc = (LAS float*)(lds + 69632);
    LAS float* red = (LAS float*)(lds + 69632 + 16384);
    float* mod = (float*)(ws + WS_MOD);
    for (int i = tid; i < NB * DM; i += NTHR) { const float v = I.c[i]; sc[i] = v / (1.0f + __expf(-v)); }
    __syncthreads();
    for (int it = blockIdx.x; it < DEPTH * (MODW / 64); it += gridDim.x) {
        const int l = it / (MODW / 64), j0 = (it % (MODW / 64)) * 64;
        const float* wp = I.w_ada + (size_t)l * DM * MODW + j0 + lane;
        float a0 = 0.f, a1 = 0.f, a2 = 0.f, a3 = 0.f; const int k0 = wave * 128;
#pragma unroll 8
        for (int k = k0; k < k0 + 128; ++k) { const float w = wp[(size_t)k * MODW]; a0 += sc[k] * w; a1 += sc[DM + k] * w; a2 += sc[2 * DM + k] * w; a3 += sc[3 * DM + k] * w; }
        red[(wave * 4 + 0) * 64 + lane] = a0; red[(wave * 4 + 1) * 64 + lane] = a1; red[(wave * 4 + 2) * 64 + lane] = a2; red[(wave * 4 + 3) * 64 + lane] = a3;
        __syncthreads();
        if (tid < 256) { const int b = tid >> 6, cl = tid & 63; float s = 0.f;
#pragma unroll
            for (int w = 0; w < 8; ++w) s += red[(w * 4 + b) * 64 + cl];
            mod[(size_t)(l * NB + b) * MODW + j0 + cl] = s + I.b_ada[(size_t)l * MODW + j0 + cl]; }
        __syncthreads();
    }
    LAS float* scr = (LAS float*)(lds + wave * 8448);
    const int gw = blockIdx.x * NWAVES + wave, NGW = gridDim.x * NWAVES;
    constexpr int I_W1 = (DM / 64) * (2 * FF / 32), I_W2 = (FF / 64) * (DM / 32), I_WIN = (DM / 64) * (INC / 32), I_WOUT = (DM / 64) * (DM / 32);
    constexpr int I_LAYER = 2 * I_W1 + 2 * I_W2 + I_WIN + I_WOUT;
    for (int it = gw; it < DEPTH * I_LAYER; it += NGW) {
        const int l = it / I_LAYER; int r = it % I_LAYER;
        unsigned char* lw = ws + WS_W + (size_t)l * LW_BYTES;
        if (r < 2 * I_W1) { const int f = r / I_W1; r %= I_W1; const int nblk = 2 * FF / 32, kb = r / nblk, nb = r % nblk, n0 = nb * 32;
            const int pn = n0 >> 8, bj = (n0 >> 7) & 1, i = n0 & 127;
            transpose_item(I.w1 + (size_t)(l * 2 + f) * DM * 2 * FF, DM, 2 * FF, (bf16_t*)(lw + LW_W1 + f * W1_BYTES), kb * 64, bj * FF + 128 * pn + i, n0, scr, lane); continue; }
        r -= 2 * I_W1;
        if (r < 2 * I_W2) { const int f = r / I_W2; r %= I_W2; const int nblk = DM / 32, kb = r / nblk, nb = r % nblk;
            transpose_item(I.w2 + (size_t)(l * 2 + f) * FF * DM, FF, DM, (bf16_t*)(lw + LW_W2 + f * W2_BYTES), kb * 64, nb * 32, nb * 32, scr, lane); continue; }
        r -= 2 * I_W2;
        if (r < I_WIN) { const int nblk = INC / 32, kb = r / nblk, nb = r % nblk, n0 = nb * 32; const int pn = n0 >> 8, bj = (n0 >> 7) & 1, wc = (n0 >> 5) & 3;
            transpose_item(I.w_in + (size_t)l * DM * INC, DM, INC, (bf16_t*)(lw + LW_WIN), kb * 64, 256 * pn + 64 * wc + 32 * bj, n0, scr, lane); continue; }
        r -= I_WIN;
        { const int nblk = DM / 32, kb = r / nblk, nb = r % nblk;
            transpose_item(I.w_out + (size_t)l * DM * DM, DM, DM, (bf16_t*)(lw + LW_WOUT), kb * 64, nb * 32, nb * 32, scr, lane); }
    }
}

__device__ __forceinline__ void norm_phase(const float* xin, bf16_t* h, const float* g, const float* modp  , int lane, int wave) {
    const int gw = blockIdx.x * NWAVES + wave, NGW = gridDim.x * NWAVES;
    for (int chunk = gw; chunk < M / 16; chunk += NGW) {
        const int row0 = chunk * 16, b = row0 >> 13;
        const float* mp = modp + (size_t)b * MODW;
        f32x4 G[4], S[4];
#pragma unroll
        for (int j = 0; j < 4; ++j) { const int c = 4 * lane + 256 * j; G[j] = *(const f32x4*)(g + c) * (*(const f32x4*)(mp + DM + c) + 1.0f); S[j] = *(const f32x4*)(mp + c); }
        for (int r = 0; r < 16; ++r) {
            const f32x4* xr = (const f32x4*)(xin + (size_t)(row0 + r) * DM) + lane;
            f32x4 v[4]; float s = 0.f;
#pragma unroll
            for (int j = 0; j < 4; ++j) { v[j] = xr[64 * j]; s += (v[j].x * v[j].x + v[j].y * v[j].y) + (v[j].z * v[j].z + v[j].w * v[j].w); }
            const float rstd = 1.0f / sqrtf(wave_sum(s) * (1.0f / DM) + EPS);
            u32x2* o8 = (u32x2*)(h + (size_t)(row0 + r) * DM) + lane;
#pragma unroll
            for (int j = 0; j < 4; ++j) { const f32x4 o = v[j] * rstd * G[j] + S[j]; u32x2 w; w.x = cvt_pk_bf16(o.x, o.y); w.y = cvt_pk_bf16(o.z, o.w); o8[64 * j] = w; }
        }
    }
}

__device__ __forceinline__ int crow(int i, int hi) { return (i & 3) + 8 * (i >> 2) + 4 * hi; }
typedef short v4i16_t __attribute__((ext_vector_type(4)));
__device__ __forceinline__ s16x4 vtr(LAS const unsigned char* p) { return __builtin_bit_cast(s16x4, __builtin_amdgcn_ds_read_tr16_b64_v4i16((LAS v4i16_t*)p)); }

template <bool FINAL>
__device__ __forceinline__ void attn_item(LAS unsigned char* lds, const bf16_t* proj, int dil, int b, int h, int r, int nb, int br,
                                          bf16_t* o23, float* lse23, bf16_t* ycat, int tid, int lane, int wid) {
    const int half = wid >> 2, w = wid & 3, th = tid & 255, r32 = lane & 31, hi = lane >> 5;
    LAS unsigned char* Kl = lds + half * 65536; LAS unsigned char* Vl = Kl + 32768;
    LAS float* wsf = (LAS float*)(lds + WSCR_OFF + wid * 512);
    const size_t rowbase = (size_t)b * SEQ;
    {
        u32x4 kv[8], vv[8];
#pragma unroll
        for (int c = 0; c < 8; ++c) { const int idx = th + 256 * c, j = idx >> 3, ch = idx & 7; const int sidx = (nb - 1) * 128 + j;
            if (sidx >= 0) { const bf16_t* p = proj + (rowbase + (size_t)sidx * dil + r) * INC + h * HD + ch * 8; kv[c] = *(const u32x4*)(p + AW); vv[c] = *(const u32x4*)(p + 2 * AW); }
            else { kv[c] = (u32x4){0u, 0u, 0u, 0u}; vv[c] = (u32x4){0u, 0u, 0u, 0u}; } }
#pragma unroll
        for (int c = 0; c < 8; ++c) { const int idx = th + 256 * c, j = idx >> 3, ch = idx & 7;
            *(LAS u32x4*)(Kl + j * 128 + ((ch ^ ((j >> 1) & 7)) * 16)) = kv[c];
            *(LAS u32x4*)(Vl + j * 128 + (((ch >> 2) ^ ((j >> 1) & 1)) * 64) + (ch & 3) * 16) = vv[c]; }
    }
    const int qs = nb * 128 + 32 * w + r32;
    const size_t qrow = rowbase + (size_t)qs * dil + r;
    bf16x8 qf[4];
#pragma unroll
    for (int ks = 0; ks < 4; ++ks) qf[ks] = *(const bf16x8*)(proj + qrow * INC + h * HD + 16 * ks + 8 * hi);
    __syncthreads();
    f32x16 s[5];
#pragma unroll
    for (int tt = 0; tt < 5; ++tt) {
        const int kvrow = 32 * (w + tt) + r32;
        f32x16 a = {0.f, 0.f, 0.f, 0.f, 0.f, 0.f, 0.f, 0.f, 0.f, 0.f, 0.f, 0.f, 0.f, 0.f, 0.f, 0.f};
#pragma unroll
        for (int ks = 0; ks < 4; ++ks) { const bf16x8 kf = *(LAS const bf16x8*)(Kl + kvrow * 128 + (((2 * ks + hi) ^ ((kvrow >> 1) & 7)) * 16)); a = __builtin_amdgcn_mfma_f32_32x32x16_bf16(kf, qf[ks], a, 0, 0, 0); }
        s[tt] = a;
    }
#pragma unroll
    for (int i = 0; i < 16; ++i) { const int cr = crow(i, hi); if (cr < r32) s[0][i] = NEGBIG; if (cr > r32) s[4][i] = NEGBIG; }
    if (nb == 0) {
#pragma unroll
        for (int tt = 0; tt < 4; ++tt) if (w + tt < 4) {
#pragma unroll
            for (int i = 0; i < 16; ++i) s[tt][i] = NEGBIG; }
    }
    float mx = NEGBIG;
#pragma unroll
    for (int tt = 0; tt < 5; ++tt)
#pragma unroll
        for (int i = 0; i < 16; ++i) mx = fmaxf(mx, s[tt][i]);
    mx = fmaxf(mx, __shfl_xor(mx, 32));
    float l = 0.f;
#pragma unroll
    for (int tt = 0; tt < 5; ++tt)
#pragma unroll
        for (int i = 0; i < 16; ++i) { const float p = __builtin_amdgcn_exp2f(s[tt][i] - mx); s[tt][i] = p; l += p; }
    l += __shfl_xor(l, 32);
    f32x16 o[2];
#pragma unroll
    for (int d = 0; d < 2; ++d) o[d] = (f32x16){0.f, 0.f, 0.f, 0.f, 0.f, 0.f, 0.f, 0.f, 0.f, 0.f, 0.f, 0.f, 0.f, 0.f, 0.f, 0.f};
    const int i16 = lane & 15, q4 = i16 >> 2, p4 = i16 & 3, blk = (lane >> 4) & 1;
#pragma unroll
    for (int tt = 0; tt < 5; ++tt)
#pragma unroll
        for (int s2 = 0; s2 < 2; ++s2) {
            u32x4 pw; pw.x = cvt_pk_bf16(s[tt][8 * s2 + 0], s[tt][8 * s2 + 1]); pw.y = cvt_pk_bf16(s[tt][8 * s2 + 2], s[tt][8 * s2 + 3]);
            pw.z = cvt_pk_bf16(s[tt][8 * s2 + 4], s[tt][8 * s2 + 5]); pw.w = cvt_pk_bf16(s[tt][8 * s2 + 6], s[tt][8 * s2 + 7]);
            const bf16x8 pf = __builtin_bit_cast(bf16x8, pw);
            const int kvr = 32 * (w + tt) + 16 * s2 + 4 * hi + q4;
#pragma unroll
            for (int d = 0; d < 2; ++d) {
                LAS const unsigned char* vp = Vl + kvr * 128 + ((d ^ ((q4 >> 1) & 1)) * 64) + 32 * blk + 8 * p4;
                const s16x4 lo = vtr(vp), hi4 = vtr(vp + 8 * 128);
                const bf16x8 vf = (bf16x8){lo[0], lo[1], lo[2], lo[3], hi4[0], hi4[1], hi4[2], hi4[3]};
                o[d] = __builtin_amdgcn_mfma_f32_32x32x16_bf16(pf, vf, o[d], 0, 0, 0);
            }
        }
    const float lse = mx + __builtin_amdgcn_logf(l);
    if (!FINAL) {
        if (hi == 0) { wsf[r32] = 1.0f / l; lse23[((size_t)br * M + qrow) * NH + h] = lse; }
        bf16_t* ob = o23 + (size_t)br * M * AW;
#pragma unroll
        for (int i = 0; i < 16; ++i) { const int ql = crow(i, hi); const float c1 = wsf[ql];
            const size_t orow = rowbase + (size_t)(nb * 128 + 32 * w + ql) * dil + r;
#pragma unroll
            for (int d = 0; d < 2; ++d) ob[orow * AW + h * HD + 32 * d + r32] = (bf16_t)(cvt_pk_bf16(o[d][i] * c1, 0.f) & 0xffffu); }
    } else {
        const float l2 = lse23[(qrow) * NH + h], l3 = lse23[((size_t)M + qrow) * NH + h];
        const float mm = fmaxf(lse, fmaxf(l2, l3));
        const float e1 = __builtin_amdgcn_exp2f(lse - mm), e2 = __builtin_amdgcn_exp2f(l2 - mm), e3 = __builtin_amdgcn_exp2f(l3 - mm);
        const float inv = 1.0f / (e1 + e2 + e3);
        if (hi == 0) { wsf[r32] = e1 * inv / l; wsf[32 + r32] = e2 * inv; wsf[64 + r32] = e3 * inv; }
        const bf16_t* o2 = o23; const bf16_t* o3 = o23 + (size_t)M * AW;
#pragma unroll
        for (int i = 0; i < 16; ++i) { const int ql = crow(i, hi); const float c1 = wsf[ql], c2 = wsf[32 + ql], c3 = wsf[64 + ql];
            const size_t orow = rowbase + (size_t)(nb * 128 + 32 * w + ql);
#pragma unroll
            for (int d = 0; d < 2; ++d) { const size_t oi = orow * AW + h * HD + 32 * d + r32;
                const float v = c1 * o[d][i] + c2 * bf_lo((unsigned)o2[oi]) + c3 * bf_lo((unsigned)o3[oi]);
                ycat[orow * DM + h * HD + 32 * d + r32] = (bf16_t)(cvt_pk_bf16(v, 0.f) & 0xffffu); } }
    }
    __syncthreads();
}

__device__ __forceinline__ void attn_phase_a(LAS unsigned char* lds, const bf16_t* proj, bf16_t* o23, float* lse23, int tid, int lane, int wid) {
    for (int R = blockIdx.x; R < 2048; R += gridDim.x) {
        const int it = 2 * R + (wid >> 2);
        const int br = it >> 11, rem = it & 2047, bh = rem >> 6, rn = rem & 63;
        const int dil = br ? 16 : 4, nbc = 64 / dil, r = rn / nbc, nb = rn % nbc;
        attn_item<false>(lds, proj, dil, bh >> 3, bh & 7, r, nb, br, o23, lse23, nullptr, tid, lane, wid);
    }
}
__device__ __forceinline__ void attn_phase_b(LAS unsigned char* lds, const bf16_t* proj, bf16_t* o23, float* lse23, bf16_t* ycat, int tid, int lane, int wid) {
    for (int R = blockIdx.x; R < 1024; R += gridDim.x) {
        const int it = 2 * R + (wid >> 2);
        const int bh = it >> 6, nb = it & 63;
        attn_item<true>(lds, proj, 1, bh >> 3, bh & 7, 0, nb, 0, o23, lse23, ycat, tid, lane, wid);
    }
}
__device__ __forceinline__ void conv_phase(const bf16_t* proj, bf16_t* ycat, const float* cw, const float* cb, int tid) {
    for (int idx = blockIdx.x * NTHR + tid; idx < M * 64; idx += gridDim.x * NTHR) {
        const int row = idx >> 6, c0 = (idx & 63) * 8, t = row & (SEQ - 1);
        const bf16_t* p = proj + (size_t)row * INC + c0;
        const u32x4 gb = *(const u32x4*)(p + 1536), gc0 = *(const u32x4*)(p + 2048), u0 = *(const u32x4*)(p + 2560);
        u32x4 gc1 = {0u, 0u, 0u, 0u}, u1 = gc1, gc2 = gc1, u2 = gc1;
        if (t >= 1) { gc1 = *(const u32x4*)(p - INC + 2048); u1 = *(const u32x4*)(p - INC + 2560); }
        if (t >= 2) { gc2 = *(const u32x4*)(p - 2 * INC + 2048); u2 = *(const u32x4*)(p - 2 * INC + 2560); }
        u32x4 o;
#pragma unroll
        for (int e = 0; e < 4; ++e) {
            const int c = c0 + 2 * e;
            const float w0a = cw[c], w0b = cw[c + 1], w1a = cw[AW + c], w1b = cw[AW + c + 1], w2a = cw[2 * AW + c], w2b = cw[2 * AW + c + 1];
            const float ya = bf_lo(gb[e]) * (w2a * bf_lo(gc0[e]) * bf_lo(u0[e]) + w1a * bf_lo(gc1[e]) * bf_lo(u1[e]) + w0a * bf_lo(gc2[e]) * bf_lo(u2[e]) + cb[c]);
            const float yb = bf_hi(gb[e]) * (w2b * bf_hi(gc0[e]) * bf_hi(u0[e]) + w1b * bf_hi(gc1[e]) * bf_hi(u1[e]) + w0b * bf_hi(gc2[e]) * bf_hi(u2[e]) + cb[c + 1]);
            o[e] = cvt_pk_bf16(ya, yb);
        }
        *(u32x4*)(ycat + (size_t)row * DM + AW + c0) = o;
    }
}

#ifndef MK_MULTI
#define MK_MULTI 0
#endif
constexpr int N_PHASES = 1 + 11 * DEPTH;
struct Args { In in; float* out; unsigned char* ws; int ph_lo, ph_hi; };
static_assert(sizeof(Args) == 15 * 8 + 8, "Args has no padding");

__global__ void __launch_bounds__(NTHR, 2) fwd_megakernel(Args a) {
    extern __shared__ __attribute__((aligned(16))) unsigned char lds_raw[];
    LAS unsigned char* lds = (LAS unsigned char*)lds_raw;
    cg::grid_group grid = cg::this_grid();
    unsigned char* ws = a.ws;
    float* mod = (float*)(ws + WS_MOD);
    bf16_t* Hb = (bf16_t*)(ws + WS_H); bf16_t* YC = (bf16_t*)(ws + WS_YC); bf16_t* ACT = (bf16_t*)(ws + WS_ACT);
    bf16_t* O23 = (bf16_t*)(ws + WS_O23); float* LSE = (float*)(ws + WS_LSE);
    for (int ph_ = a.ph_lo; ph_ < a.ph_hi; ++ph_) {
        int ph = ph_; asm volatile("" : "+s"(ph));
        int tid = threadIdx.x; asm volatile("" : "+v"(tid));
        const int lane = tid & 63, wave = __builtin_amdgcn_readfirstlane(tid >> 6);
        if (ph == 0) { prologue(a.in, ws, lds, tid, lane, wave); }
        else {
            const int q = ph - 1, L = q / 11, k = q % 11;
            unsigned char* lw = ws + WS_W + (size_t)L * LW_BYTES;
            const float* lmod = mod + (size_t)L * NB * MODW;
            const float* xcur = (L == 0 && k <= 2) ? a.in.x : a.out;
            if (k == 0 || k == 3 || k == 8) {
                const int sub = k == 0 ? 0 : (k == 3 ? 1 : 2);
                norm_phase(xcur, Hb, a.in.norm_g + (size_t)(L * 3 + sub) * DM, lmod + sub * 3 * DM, lane, wave);
            } else if (k == 1 || k == 9) {
                const int f = k == 9;
                pg8::Gemm g{Hb, (const bf16_t*)(lw + LW_W1 + f * W1_BYTES), M, 2 * FF, DM}; pg8::StaticOrder S; S.init(M, 2 * FF, gridDim.x, blockIdx.x);
                pg8::EpiSwiglu E{ACT, FF};
                pg8::gemm_phase<pg8::EpiSwiglu, pg8::StaticOrder, true, true>(lds, tid, g, S, E);
            } else if (k == 2 || k == 10 || k == 7) {
                const int f = k == 10, sub = k == 2 ? 0 : (k == 7 ? 1 : 2);
                const bf16_t* A = k == 7 ? YC : ACT; const bf16_t* Bt = k == 7 ? (const bf16_t*)(lw + LW_WOUT) : (const bf16_t*)(lw + LW_W2 + f * W2_BYTES);
                pg8::Gemm g{A, Bt, M, DM, k == 7 ? DM : FF}; pg8::StaticOrder S; S.init(M, DM, gridDim.x, blockIdx.x);
                pg8::EpiResid E{xcur, a.out, lmod + sub * 3 * DM + 2 * DM, MODW, 13, k == 7 ? 1.0f : 0.5f};
                pg8::gemm_phase<pg8::EpiResid, pg8::StaticOrder, true, true>(lds, tid, g, S, E);
            } else if (k == 4) {
                pg8::Gemm g{Hb, (const bf16_t*)(lw + LW_WIN), M, INC, DM}; pg8::StaticOrder S; S.init(M, INC, gridDim.x, blockIdx.x);
                pg8::EpiWin E{ACT, INC, a.in.q_g + L * HD, a.in.k_g + L * HD, QSCALE};
                pg8::gemm_phase<pg8::EpiWin, pg8::StaticOrder, true, true>(lds, tid, g, S, E);
            } else if (k == 5) {
                attn_phase_a(lds, ACT, O23, LSE, tid, lane, wave);
            } else {
                attn_phase_b(lds, ACT, O23, LSE, YC, tid, lane, wave);
                conv_phase(ACT, YC, a.in.conv_w + (size_t)L * 3 * AW, a.in.conv_b + (size_t)L * AW, tid);
            }
        }
        if (ph_ + 1 < a.ph_hi) grid.sync();
    }
}

extern "C" void kernel_launch(void* const* d_in, const int* in_sizes, int n_in, void* d_out, int out_size, void* d_ws, size_t ws_size, hipStream_t stream) {
    static int grid_blocks = 0;
    if (grid_blocks == 0) {
        if (n_in != 13 || in_sizes[0] != M * DM || out_size != M * DM || ws_size < WS_END) { fprintf(stderr, "kernel_launch: unexpected shapes (n_in %d, in0 %d, out %d, ws %zu)\n", n_in, n_in > 0 ? in_sizes[0] : -1, out_size, ws_size); grid_blocks = -1; return; }
        int dev = 0, cus = 0, per_cu = 0;
        hipGetDevice(&dev);
        hipDeviceGetAttribute(&cus, hipDeviceAttributeMultiprocessorCount, dev);
        if (hipFuncSetAttribute((const void*)fwd_megakernel, hipFuncAttributeMaxDynamicSharedMemorySize, LDS_BYTES) != hipSuccess) fprintf(stderr, "kernel_launch: hipFuncSetAttribute failed\n");
        if (hipOccupancyMaxActiveBlocksPerMultiprocessor(&per_cu, (const void*)fwd_megakernel, NTHR, LDS_BYTES) != hipSuccess || per_cu < 1) { fprintf(stderr, "kernel_launch: occupancy query says %d\n", per_cu); per_cu = 1; }
        (void)hipGetLastError();
        grid_blocks = cus * per_cu;
    }
    if (grid_blocks < 0) return;
    Args a{};
    const float** ip = (const float**)&a.in;
    for (int i = 0; i < 13; ++i) ip[i] = (const float*)d_in[i];
    a.out = (float*)d_out; a.ws = (unsigned char*)d_ws;
#if MK_MULTI
    for (int ph = 0; ph < N_PHASES; ++ph) { a.ph_lo = ph; a.ph_hi = ph + 1; hipLaunchKernelGGL(fwd_megakernel, dim3(grid_blocks), dim3(NTHR), LDS_BYTES, stream, a); }
#else
    a.ph_lo = 0; a.ph_hi = N_PHASES;
    void* args[] = {&a};
    hipError_t e = hipLaunchCooperativeKernel((const void*)fwd_megakernel, dim3(grid_blocks), dim3(NTHR), args, LDS_BYTES, stream);
    if (e != hipSuccess) fprintf(stderr, "cooperative launch failed: %s (grid %d)\n", hipGetErrorString(e), grid_blocks);
#endif
}
```

```cpp
#include <hip/hip_runtime.h>
#include <hip/hip_cooperative_groups.h>
#include <cstdio>
#include <cstdint>
namespace cg = cooperative_groups;
namespace pg8 {
#define PG8_LAS __attribute__((address_space(3)))
typedef unsigned short bf16_t;
typedef short bf16x8 __attribute__((ext_vector_type(8)));
typedef float f32x4 __attribute__((ext_vector_type(4)));
typedef unsigned u32x4 __attribute__((ext_vector_type(4)));
constexpr int BM = 256, BK = 64, HALF = 128, HTB = HALF * BK * 2  , STAGE_BYTES = 8 * HTB, NXCD = 8, WGM = 8;

__host__ __device__ __forceinline__ int lds_byte(int r, int c) { const int st = (r >> 4) * 2 + (c >> 5), rr = r & 15, cc = c & 31, ob = rr * 64 + cc * 2; return st * 1024 + (ob ^ (((ob >> 9) & 1) << 5)); }
__host__ __device__ __forceinline__ void stage_rc(int b, int& R, int& C) { const int st = b / 1024, sb = b % 1024, swz = sb ^ (((sb >> 9) & 1) << 5); R = (st >> 1) * 16 + swz / 64; C = (st & 1) * 32 + (swz % 64) / 2; }
__host__ __device__ __forceinline__ int perm32(int rho) { const int n = rho >> 4, i = rho & 15; return 8 * (i >> 2) + 4 * n + (i & 3); }

struct Unit { int pm, pn; };
struct Gemm { const bf16_t* A; const bf16_t* Bt; int M, N, K; };

struct StaticOrder {
    int nM, nN, nwg, G, c;
    __host__ __device__ void init(int M, int N, int G_, int c_) { nM = M / BM; nN = N / BM; nwg = nM * nN; G = G_; c = c_; }
    __host__ __device__ bool next(int i, Unit& u) const {
        const long L = (long)i * G + c; if (L >= nwg) return false;
        int wgid = (int)L; { const int q = nwg / NXCD, r = nwg % NXCD, xcd = wgid % NXCD, off = wgid / NXCD; wgid = (xcd < r ? xcd * (q + 1) : r * (q + 1) + (xcd - r) * q) + off; }
        const int nig = WGM * nN, gid = wgid / nig, fm = gid * WGM, gsz = (nM - fm) < WGM ? (nM - fm) : WGM;
        u.pm = fm + ((wgid % nig) % gsz); u.pn = (wgid % nig) / gsz; return true;
    }
    __device__ __forceinline__ void a_ready(const Unit&) const {}
    __device__ __forceinline__ void done(const Unit&) const {}
};

typedef unsigned u32x2 __attribute__((ext_vector_type(2)));
__device__ __forceinline__ unsigned cvt_pk_bf16(float lo, float hi) { typedef float f2 __attribute__((ext_vector_type(2))); typedef __bf16 b2 __attribute__((ext_vector_type(2)));
    f2 v = {lo, hi}; b2 b = __builtin_convertvector(v, b2); return __builtin_bit_cast(unsigned, b); }
__device__ __forceinline__ float silu_f(float g) { return g * __builtin_amdgcn_rcpf(1.0f + __builtin_amdgcn_exp2f(-1.4426950408889634f * g)); }

struct EpiSwiglu {
    static constexpr bool PERM = true, AFTER_DRAIN = false;
    bf16_t* O; int ldc;
    __device__ __forceinline__ void operator()(const f32x4 (&acc)[2][2][4][2], const Unit& u, int wr, int wc, int fr, int fq) const {
        const int row0 = u.pm * BM + wr * 64 + fr, col0 = u.pn * HALF + wc * 32 + 8 * fq;
#pragma unroll
        for (int ai = 0; ai < 2; ++ai)
#pragma unroll
            for (int m = 0; m < 4; ++m) {
                const f32x4 g0 = acc[ai][0][m][0], g1 = acc[ai][0][m][1], u0 = acc[ai][1][m][0], u1 = acc[ai][1][m][1];
                u32x4 w;
                w.x = cvt_pk_bf16(silu_f(g0[0]) * u0[0], silu_f(g0[1]) * u0[1]); w.y = cvt_pk_bf16(silu_f(g0[2]) * u0[2], silu_f(g0[3]) * u0[3]);
                w.z = cvt_pk_bf16(silu_f(g1[0]) * u1[0], silu_f(g1[1]) * u1[1]); w.w = cvt_pk_bf16(silu_f(g1[2]) * u1[2], silu_f(g1[3]) * u1[3]);
                *(u32x4*)(O + (size_t)(row0 + ai * HALF + m * 16) * ldc + col0) = w;
            }
    }
};
struct EpiWin {
    static constexpr bool PERM = true, AFTER_DRAIN = false;
    bf16_t* O; int ldc; const float* qg; const float* kg; float qscale;
    __device__ __forceinline__ void operator()(const f32x4 (&acc)[2][2][4][2], const Unit& u, int wr, int wc, int fr, int fq) const {
        const int row0 = u.pm * BM + wr * 64 + fr, col0 = u.pn * BM + wc * 64 + 8 * fq;
        const int kind = u.pn < 2 ? 1 : (u.pn < 4 ? 2 : 0);
        f32x4 gv[2][2];
#pragma unroll
        for (int bj = 0; bj < 2; ++bj)
#pragma unroll
            for (int n = 0; n < 2; ++n) gv[bj][n] = kind ? *(const f32x4*)((kind == 1 ? qg : kg) + 32 * bj + 8 * fq + 4 * n) : (f32x4){1.f, 1.f, 1.f, 1.f};
        const float ks = kind == 1 ? qscale : 1.0f;
#pragma unroll
        for (int ai = 0; ai < 2; ++ai)
#pragma unroll
            for (int m = 0; m < 4; ++m) {
                float rs = 1.0f;
                if (kind) {
                    float ss = 0.f;
#pragma unroll
                    for (int bj = 0; bj < 2; ++bj)
#pragma unroll
                        for (int n = 0; n < 2; ++n) { const f32x4 x = acc[ai][bj][m][n]; ss += (x[0] * x[0] + x[1] * x[1]) + (x[2] * x[2] + x[3] * x[3]); }
                    ss += __shfl_xor(ss, 16); ss += __shfl_xor(ss, 32);
                    rs = ks * __builtin_amdgcn_rsqf(ss * (1.0f / 64.0f) + 1e-6f);
                }
                bf16_t* rowp = O + (size_t)(row0 + ai * HALF + m * 16) * ldc + col0;
#pragma unroll
                for (int bj = 0; bj < 2; ++bj) {
                    const f32x4 v0 = acc[ai][bj][m][0] * (gv[bj][0] * rs), v1 = acc[ai][bj][m][1] * (gv[bj][1] * rs);
                    u32x4 w; w.x = cvt_pk_bf16(v0[0], v0[1]); w.y = cvt_pk_bf16(v0[2], v0[3]); w.z = cvt_pk_bf16(v1[0], v1[1]); w.w = cvt_pk_bf16(v1[2], v1[3]);
                    *(u32x4*)(rowp + 32 * bj) = w;
                }
            }
    }
};
struct EpiResid {
    static constexpr bool PERM = false, AFTER_DRAIN = false;
    const float* xin; float* out; const float* gate; int gate_bstride; int rows_per_batch_shift; float gs;
    __device__ __forceinline__ void operator()(const f32x4 (&acc)[2][2][4][2], const Unit& u, int wr, int wc, int fr, int fq) const {
        const int b = (u.pm * BM) >> rows_per_batch_shift;
        const float* gp = gate + (size_t)b * gate_bstride;
        const int row0 = u.pm * BM + wr * 64 + fr, col0 = u.pn * BM + wc * 32 + 4 * fq;
        f32x4 gv[2][2];
#pragma unroll
        for (int bj = 0; bj < 2; ++bj)
#pragma unroll
            for (int n = 0; n < 2; ++n) gv[bj][n] = *(const f32x4*)(gp + col0 + bj * HALF + n * 16) * gs;
#pragma unroll
        for (int ai = 0; ai < 2; ++ai)
#pragma unroll
            for (int m = 0; m < 4; ++m) { const size_t off = (size_t)(row0 + ai * HALF + m * 16) * 1024 + col0;
#pragma unroll
                for (int bj = 0; bj < 2; ++bj)
#pragma unroll
                    for (int n = 0; n < 2; ++n) { const f32x4 xv = *(const f32x4*)(xin + off + bj * HALF + n * 16); *(f32x4*)(out + off + bj * HALF + n * 16) = xv + gv[bj][n] * acc[ai][bj][m][n]; } }
    }
};
template <class Epi, class Sched, bool ALIGN_EPI = false, bool SP2 = false>
__device__ __forceinline__ void gemm_phase(PG8_LAS unsigned char* lds, const int tid, const Gemm g, const Sched& S, const Epi& E) {
    const int wid = __builtin_amdgcn_readfirstlane(tid >> 6), lane = tid & 63, wr = wid >> 2, wc = wid & 3, fr = lane & 15, fq = lane >> 4;
    const int K = g.K, nt = K / BK;
    unsigned voffA[2], voffB[2];
#pragma unroll
    for (int i = 0; i < 2; ++i) { int R, C; stage_rc(tid * 16 + i * 8192, R, C); const int Rb = Epi::PERM ? ((R & ~31) + perm32(R & 31)) : R;
        voffA[i] = (unsigned)(R * K + C) * 2u; voffB[i] = (unsigned)(Rb * K + C) * 2u; }
    const size_t kstep = (size_t)(BK * 2);
    const size_t hstep = (size_t)HALF * K * 2;
    const size_t tstep = 2 * hstep;
    const unsigned ldsw = (unsigned)wid * 1024u;
    const int aoff = lds_byte(wr * 64 + fr, fq * 8), boff = lds_byte(wc * 32 + fr, fq * 8);
#define PG8_SA(b, h) (((b) * 2 + (h)) * HTB)
#define PG8_SB(b, h) ((4 + (b) * 2 + (h)) * HTB)
#define PG8_STAGE(bufoff, gbase, voff) do { _Pragma("unroll") for (int _i = 0; _i < 2; ++_i) \
        __builtin_amdgcn_global_load_lds((const unsigned*)((const char*)(gbase) + (voff)[_i]), (PG8_LAS unsigned*)(lds + (bufoff) + ldsw + _i * 8192), 16, 0, 0); } while (0)
#define PG8_LDA(dst, b, h) do { _Pragma("unroll") for (int m = 0; m < 4; ++m) _Pragma("unroll") for (int k = 0; k < 2; ++k) dst[m][k] = *(const PG8_LAS bf16x8*)(lds + PG8_SA(b, h) + aoff + m * 2048 + k * 1024); } while (0)
#define PG8_LDB(dst, b, h) do { _Pragma("unroll") for (int n = 0; n < 2; ++n) _Pragma("unroll") for (int k = 0; k < 2; ++k) dst[n][k] = *(const PG8_LAS bf16x8*)(lds + PG8_SB(b, h) + boff + n * 2048 + k * 1024); } while (0)
#define PG8_MMA(ai, bj, At, Bt) do { __builtin_amdgcn_s_setprio(1); _Pragma("unroll") for (int m = 0; m < 4; ++m) _Pragma("unroll") for (int n = 0; n < 2; ++n) _Pragma("unroll") for (int k = 0; k < 2; ++k) \
        acc[ai][bj][m][n] = __builtin_amdgcn_mfma_f32_16x16x32_bf16(Bt[n][k], At[m][k], acc[ai][bj][m][n], 0, 0, 0); __builtin_amdgcn_s_setprio(0); } while (0)
#define PG8_WAIT_V(n) asm volatile("s_waitcnt vmcnt(" #n ")" ::: "memory")
#define PG8_WAIT_L(n) asm volatile("s_waitcnt lgkmcnt(" #n ")" ::: "memory")
#define PG8_BAR __builtin_amdgcn_s_barrier()
#define PG8_SCHED __builtin_amdgcn_sched_barrier(0)
    Unit cur, nxt; int ui = 0;
    if (!S.next(0, cur)) return;
    f32x4 acc[2][2][4][2];
#pragma unroll
    for (int a = 0; a < 2; ++a)
#pragma unroll
        for (int b = 0; b < 2; ++b)
#pragma unroll
            for (int m = 0; m < 4; ++m)
#pragma unroll
                for (int n = 0; n < 2; ++n) acc[a][b][m][n] = (f32x4){0.f, 0.f, 0.f, 0.f};
    bf16x8 At[4][2], B0[2][2], B1[2][2];
    const char* cA = (const char*)g.A + (size_t)cur.pm * tstep; const char* cB = (const char*)g.Bt + (size_t)cur.pn * tstep;
    S.a_ready(cur);
    if constexpr (SP2) {
        PG8_STAGE(PG8_SB(0, 0), cB, voffB); PG8_STAGE(PG8_SB(0, 1), cB + hstep, voffB); PG8_STAGE(PG8_SA(0, 0), cA, voffA); PG8_STAGE(PG8_SA(0, 1), cA + hstep, voffA);
        if (wr == 1) PG8_BAR;
        PG8_WAIT_V(2); PG8_BAR;
        PG8_STAGE(PG8_SB(1, 0), cB + kstep, voffB); PG8_STAGE(PG8_SA(1, 0), cA + kstep, voffA); PG8_STAGE(PG8_SB(1, 1), cB + hstep + kstep, voffB);
        PG8_WAIT_V(6); PG8_BAR;
    } else {
        PG8_STAGE(PG8_SB(0, 0), cB, voffB); PG8_STAGE(PG8_SA(0, 0), cA, voffA); PG8_STAGE(PG8_SB(0, 1), cB + hstep, voffB); PG8_STAGE(PG8_SA(0, 1), cA + hstep, voffA);
        if (wr == 1) PG8_BAR;
        PG8_WAIT_V(4); PG8_BAR;
        PG8_STAGE(PG8_SB(1, 0), cB + kstep, voffB); PG8_STAGE(PG8_SA(1, 0), cA + kstep, voffA); PG8_STAGE(PG8_SB(1, 1), cB + hstep + kstep, voffB);
        PG8_WAIT_V(6); PG8_BAR;
    }
    for (;;) {
        const bool has_next = S.next(ui + 1, nxt);
        const char* nA = has_next ? (const char*)g.A + (size_t)nxt.pm * tstep : cA; const char* nB = has_next ? (const char*)g.Bt + (size_t)nxt.pn * tstep : cB;
        for (int t = 0; t < nt; t += 2) {
            const bool last = (t == nt - 2);
            const char* a1 = cA + (size_t)(t + 1) * kstep;
            const char* a2 = last ? nA : cA + (size_t)(t + 2) * kstep; const char* b2 = last ? nB : cB + (size_t)(t + 2) * kstep;
            const char* a3 = a2 + kstep; const char* b3 = b2 + kstep;
            if (last && has_next) S.a_ready(nxt);
            if constexpr (SP2) {
            PG8_LDB(B0, 0, 0); PG8_LDB(B1, 0, 1); PG8_SCHED; PG8_LDA(At, 0, 0); PG8_STAGE(PG8_SA(1, 1), a1 + hstep, voffA);
            PG8_WAIT_V(8); PG8_WAIT_L(0); PG8_BAR; PG8_MMA(0, 0, At, B0); PG8_MMA(0, 1, At, B1); PG8_BAR; PG8_SCHED;
            PG8_LDA(At, 0, 1); PG8_STAGE(PG8_SB(0, 0), b2, voffB); PG8_STAGE(PG8_SB(0, 1), b2 + hstep, voffB); PG8_STAGE(PG8_SA(0, 0), a2, voffA);
            PG8_WAIT_V(8); PG8_WAIT_L(0); PG8_BAR; PG8_MMA(1, 0, At, B0); PG8_MMA(1, 1, At, B1); PG8_BAR; PG8_SCHED;
            PG8_LDB(B0, 1, 0); PG8_LDB(B1, 1, 1); PG8_SCHED; PG8_LDA(At, 1, 0); PG8_STAGE(PG8_SA(0, 1), a2 + hstep, voffA);
            PG8_WAIT_V(8); PG8_WAIT_L(0); PG8_BAR; PG8_MMA(0, 0, At, B0); PG8_MMA(0, 1, At, B1); PG8_BAR; PG8_SCHED;
            PG8_LDA(At, 1, 1); PG8_STAGE(PG8_SB(1, 0), b3, voffB); PG8_STAGE(PG8_SB(1, 1), b3 + hstep, voffB); PG8_STAGE(PG8_SA(1, 0), a3, voffA);
            PG8_WAIT_V(8); PG8_WAIT_L(0); PG8_BAR; PG8_MMA(1, 0, At, B0); PG8_MMA(1, 1, At, B1); PG8_BAR; PG8_SCHED;
            } else {
            PG8_LDB(B0, 0, 0); PG8_SCHED; PG8_LDA(At, 0, 0); PG8_STAGE(PG8_SA(1, 1), a1 + hstep, voffA);
            PG8_WAIT_L(8); PG8_BAR; PG8_WAIT_L(0); PG8_MMA(0, 0, At, B0); PG8_BAR; PG8_SCHED;
            PG8_LDB(B1, 0, 1); PG8_STAGE(PG8_SB(0, 0), b2, voffB);
            PG8_BAR; PG8_WAIT_L(0); PG8_MMA(0, 1, At, B1); PG8_BAR;
            PG8_LDA(At, 0, 1); PG8_STAGE(PG8_SA(0, 0), a2, voffA);
            PG8_BAR; PG8_WAIT_L(0); PG8_MMA(1, 0, At, B0); PG8_BAR; PG8_SCHED;
            PG8_STAGE(PG8_SB(0, 1), b2 + hstep, voffB);
            PG8_WAIT_V(6); PG8_BAR; PG8_MMA(1, 1, At, B1); PG8_BAR;
            PG8_LDB(B0, 1, 0); PG8_SCHED; PG8_LDA(At, 1, 0); PG8_STAGE(PG8_SA(0, 1), a2 + hstep, voffA);
            PG8_WAIT_L(8); PG8_BAR; PG8_WAIT_L(0); PG8_MMA(0, 0, At, B0); PG8_BAR; PG8_SCHED;
            PG8_LDB(B1, 1, 1); PG8_STAGE(PG8_SB(1, 0), b3, voffB);
            PG8_BAR; PG8_WAIT_L(0); PG8_MMA(0, 1, At, B1); PG8_BAR;
            PG8_LDA(At, 1, 1); PG8_STAGE(PG8_SA(1, 0), a3, voffA);
            PG8_BAR; PG8_WAIT_L(0); PG8_MMA(1, 0, At, B0); PG8_BAR; PG8_SCHED;
            PG8_STAGE(PG8_SB(1, 1), b3 + hstep, voffB);
            PG8_WAIT_V(6); PG8_BAR; PG8_MMA(1, 1, At, B1); PG8_BAR;
            }
        }
        if constexpr (ALIGN_EPI) { if (wr == 0) PG8_BAR; }
        if constexpr (!Epi::AFTER_DRAIN) { E(acc, cur, wr, wc, fr, fq); S.done(cur); }
        if (!has_next) break;
#pragma unroll
        for (int a = 0; a < 2; ++a)
#pragma unroll
            for (int b = 0; b < 2; ++b)
#pragma unroll
                for (int m = 0; m < 4; ++m)
#pragma unroll
                    for (int n = 0; n < 2; ++n) acc[a][b][m][n] = (f32x4){0.f, 0.f, 0.f, 0.f};
        cur = nxt; cA = nA; cB = nB; ++ui;
        if constexpr (ALIGN_EPI) { if (wr == 1) PG8_BAR; }
    }
    PG8_WAIT_V(0);
    if constexpr (!ALIGN_EPI) { if (wr == 0) PG8_BAR; }
    PG8_BAR;
    if constexpr (Epi::AFTER_DRAIN) { E.fused(acc, cur, wr, wc, fr, fq, lds, wid, lane); S.done(cur); }
#undef PG8_SA
#undef PG8_SB
#undef PG8_STAGE
#undef PG8_LDA
#undef PG8_LDB
#undef PG8_MMA
#undef PG8_WAIT_V
#undef PG8_WAIT_L
#undef PG8_BAR
#undef PG8_SCHED
}
}

#define LAS __attribute__((address_space(3)))
typedef unsigned short bf16_t;
typedef short bf16x8 __attribute__((ext_vector_type(8)));
typedef short s16x4 __attribute__((ext_vector_type(4)));
typedef float f32x4 __attribute__((ext_vector_type(4)));
typedef float f32x16 __attribute__((ext_vector_type(16)));
typedef unsigned u32x4 __attribute__((ext_vector_type(4)));
typedef unsigned u32x2 __attribute__((ext_vector_type(2)));
constexpr int DM = 1024, NB = 4, SEQ = 8192, DEPTH = 2, FF = 2816, NH = 8, HD = 64, AW = 512, INC = 3072, MODW = 9216;
constexpr int M = NB * SEQ;
constexpr float EPS = 1e-6f;
constexpr float QSCALE = 0.125f * 1.4426950408889634f;
constexpr float NEGBIG = -1e30f;
constexpr int NWAVES = 8, NTHR = 512;
constexpr size_t MiB = 1u << 20;
constexpr size_t WS_MOD = 0;
constexpr size_t WS_W = 2 * MiB;
constexpr size_t W1_BYTES = (size_t)2 * FF * DM * 2, W2_BYTES = (size_t)DM * FF * 2, WIN_BYTES = (size_t)INC * DM * 2, WOUT_BYTES = (size_t)DM * DM * 2;
constexpr size_t LW_W1 = 0, LW_W2 = 2 * W1_BYTES, LW_WIN = LW_W2 + 2 * W2_BYTES, LW_WOUT = LW_WIN + WIN_BYTES, LW_BYTES = LW_WOUT + WOUT_BYTES;
static_assert(WS_W + DEPTH * LW_BYTES <= 88 * MiB, "weights");
constexpr size_t WS_H = 88 * MiB;
constexpr size_t WS_YC = 152 * MiB;
constexpr size_t WS_ACT = 216 * MiB;
constexpr size_t WS_O23 = 408 * MiB;
constexpr size_t WS_LSE = 472 * MiB;
constexpr size_t WS_CTL = 474 * MiB, CTL_BYTES = 16384;
constexpr size_t WS_END = 475 * MiB;
constexpr int RING_BYTES = 131072, WSCR_OFF = RING_BYTES, MISC_OFF = RING_BYTES + NWAVES * 512, LDS_BYTES = MISC_OFF + 256;

__device__ __forceinline__ float bf_lo(unsigned u) { return __uint_as_float(u << 16); }
__device__ __forceinline__ float bf_hi(unsigned u) { return __uint_as_float(u & 0xffff0000u); }
__device__ __forceinline__ float wave_sum(float v) {
#pragma unroll
    for (int o = 1; o < 64; o <<= 1) v += __shfl_xor(v, o);
    return v;
}
using pg8::cvt_pk_bf16;

__device__ __forceinline__ void transpose_item(const float* W, int K, int N, bf16_t* WT, int k0, int src_n0, int dst_n0, LAS float* scr, int lane) {
#pragma unroll 8
    for (int i = 0; i < 32; ++i) { const int kk = 2 * i + (lane >> 5); scr[kk * 33 + (lane & 31)] = W[(size_t)(k0 + kk) * N + src_n0 + (lane & 31)]; }
    asm volatile("s_waitcnt lgkmcnt(0)" ::: "memory");
    const int c = lane & 7;
#pragma unroll
    for (int j = 0; j < 4; ++j) { const int n = (lane >> 3) + 8 * j; const LAS float* s = scr + (8 * c) * 33 + n;
        u32x4 o; o.x = cvt_pk_bf16(s[0 * 33], s[1 * 33]); o.y = cvt_pk_bf16(s[2 * 33], s[3 * 33]); o.z = cvt_pk_bf16(s[4 * 33], s[5 * 33]); o.w = cvt_pk_bf16(s[6 * 33], s[7 * 33]);
        *(u32x4*)(WT + (size_t)(dst_n0 + n) * K + k0 + 8 * c) = o; }
    asm volatile("s_waitcnt lgkmcnt(0)" ::: "memory");
}
struct In { const float *x, *c, *w_ada, *b_ada, *norm_g, *w_in, *q_g, *k_g, *conv_w, *conv_b, *w_out, *w1, *w2; };

__device__ __forceinline__ void prologue(const In& I, unsigned char* ws, LAS unsigned char* lds, int tid, int lane, int wave) {
    LAS float* sc = (LAS float*)(lds + 69632);
    LAS float* red = (LAS float*)(lds + 69632 + 16384);
    float* mod = (float*)(ws + WS_MOD);
    for (int i = tid; i < NB * DM; i += NTHR) { const float v = I.c[i]; sc[i] = v / (1.0f + __expf(-v)); }
    __syncthreads();
    for (int it = blockIdx.x; it < DEPTH * (MODW / 64); it += gridDim.x) {
        const int l = it / (MODW / 64), j0 = (it % (MODW / 64)) * 64;
        const float* wp = I.w_ada + (size_t)l * DM * MODW + j0 + lane;
        float a0 = 0.f, a1 = 0.f, a2 = 0.f, a3 = 0.f; const int k0 = wave * 128;
#pragma unroll 8
        for (int k = k0; k < k0 + 128; ++k) { const float w = wp[(size_t)k * MODW]; a0 += sc[k] * w; a1 += sc[DM + k] * w; a2 += sc[2 * DM + k] * w; a3 += sc[3 * DM + k] * w; }
        red[(wave * 4 + 0) * 64 + lane] = a0; red[(wave * 4 + 1) * 64 + lane] = a1; red[(wave * 4 + 2) * 64 + lane] = a2; red[(wave * 4 + 3) * 64 + lane] = a3;
        __syncthreads();
        if (tid < 256) { const int b = tid >> 6, cl = tid & 63; float s = 0.f;
#pragma unroll
            for (int w = 0; w < 8; ++w) s += red[(w * 4 + b) * 64 + cl];
            mod[(size_t)(l * NB + b) * MODW + j0 + cl] = s + I.b_ada[(size_t)l * MODW + j0 + cl]; }
        __syncthreads();
    }
    LAS float* scr = (LAS float*)(lds + wave * 8448);
    const int gw = blockIdx.x * NWAVES + wave, NGW = gridDim.x * NWAVES;
    constexpr int I_W1 = (DM / 64) * (2 * FF / 32), I_W2 = (FF / 64) * (DM / 32), I_WIN = (DM / 64) * (INC / 32), I_WOUT = (DM / 64) * (DM / 32);
    constexpr int I_LAYER = 2 * I_W1 + 2 * I_W2 + I_WIN + I_WOUT;
    for (int it = gw; it < DEPTH * I_LAYER; it += NGW) {
        const int l = it / I_LAYER; int r = it % I_LAYER;
        unsigned char* lw = ws + WS_W + (size_t)l * LW_BYTES;
        if (r < 2 * I_W1) { const int f = r / I_W1; r %= I_W1; const int nblk = 2 * FF / 32, kb = r / nblk, nb = r % nblk, n0 = nb * 32;
            const int pn = n0 >> 8, bj = (n0 >> 7) & 1, i = n0 & 127;
            transpose_item(I.w1 + (size_t)(l * 2 + f) * DM * 2 * FF, DM, 2 * FF, (bf16_t*)(lw + LW_W1 + f * W1_BYTES), kb * 64, bj * FF + 128 * pn + i, n0, scr, lane); continue; }
        r -= 2 * I_W1;
        if (r < 2 * I_W2) { const int f = r / I_W2; r %= I_W2; const int nblk = DM / 32, kb = r / nblk, nb = r % nblk;
            transpose_item(I.w2 + (size_t)(l * 2 + f) * FF * DM, FF, DM, (bf16_t*)(lw + LW_W2 + f * W2_BYTES), kb * 64, nb * 32, nb * 32, scr, lane); continue; }
        r -= 2 * I_W2;
        if (r < I_WIN) { const int nblk = INC / 32, kb = r / nblk, nb = r % nblk, n0 = nb * 32; const int pn = n0 >> 8, bj = (n0 >> 7) & 1, wc = (n0 >> 5) & 3;
            transpose_item(I.w_in + (size_t)l * DM * INC, DM, INC, (bf16_t*)(lw + LW_WIN), kb * 64, 256 * pn + 64 * wc + 32 * bj, n0, scr, lane); continue; }
        r -= I_WIN;
        { const int nblk = DM / 32, kb = r / nblk, nb = r % nblk;
            transpose_item(I.w_out + (size_t)l * DM * DM, DM, DM, (bf16_t*)(lw + LW_WOUT), kb * 64, nb * 32, nb * 32, scr, lane); }
    }
}

__device__ __forceinline__ void norm_phase(const float* xin, bf16_t* h, const float* g, const float* modp  , int lane, int wave) {
    const int gw = blockIdx.x * NWAVES + wave, NGW = gridDim.x * NWAVES;
    for (int chunk = gw; chunk < M / 16; chunk += NGW) {
        const int row0 = chunk * 16, b = row0 >> 13;
        const float* mp = modp + (size_t)b * MODW;
        f32x4 G[4], S[4];
#pragma unroll
        for (int j = 0; j < 4; ++j) { const int c = 4 * lane + 256 * j; G[j] = *(const f32x4*)(g + c) * (*(const f32x4*)(mp + DM + c) + 1.0f); S[j] = *(const f32x4*)(mp + c); }
        for (int r = 0; r < 16; ++r) {
            const f32x4* xr = (const f32x4*)(xin + (size_t)(row0 + r) * DM) + lane;
            f32x4 v[4]; float s = 0.f;
#pragma unroll
            for (int j = 0; j < 4; ++j) { v[j] = xr[64 * j]; s += (v[j].x * v[j].x + v[j].y * v[j].y) + (v[j].z * v[j].z + v[j].w * v[j].w); }
            const float rstd = 1.0f / sqrtf(wave_sum(s) * (1.0f / DM) + EPS);
            u32x2* o8 = (u32x2*)(h + (size_t)(row0 + r) * DM) + lane;
#pragma unroll
            for (int j = 0; j < 4; ++j) { const f32x4 o = v[j] * rstd * G[j] + S[j]; u32x2 w; w.x = cvt_pk_bf16(o.x, o.y); w.y = cvt_pk_bf16(o.z, o.w); o8[64 * j] = w; }
        }
    }
}

__device__ __forceinline__ int crow(int i, int hi) { return (i & 3) + 8 * (i >> 2) + 4 * hi; }
typedef short v4i16_t __attribute__((ext_vector_type(4)));
__device__ __forceinline__ s16x4 vtr(LAS const unsigned char* p) { return __builtin_bit_cast(s16x4, __builtin_amdgcn_ds_read_tr16_b64_v4i16((LAS v4i16_t*)p)); }

template <bool FINAL>
__device__ __forceinline__ void attn_item(LAS unsigned char* lds, const bf16_t* proj, int dil, int b, int h, int r, int nb, int br,
                                          bf16_t* o23, float* lse23, bf16_t* ycat, int tid, int lane, int wid) {
    const int half = wid >> 2, w = wid & 3, th = tid & 255, r32 = lane & 31, hi = lane >> 5;
    LAS unsigned char* Kl = lds + half * 65536; LAS unsigned char* Vl = Kl + 32768;
    LAS float* wsf = (LAS float*)(lds + WSCR_OFF + wid * 512);
    const size_t rowbase = (size_t)b * SEQ;
    {
        u32x4 kv[8], vv[8];
#pragma unroll
        for (int c = 0; c < 8; ++c) { const int idx = th + 256 * c, j = idx >> 3, ch = idx & 7; const int sidx = (nb - 1) * 128 + j;
            if (sidx >= 0) { const bf16_t* p = proj + (rowbase + (size_t)sidx * dil + r) * INC + h * HD + ch * 8; kv[c] = *(const u32x4*)(p + AW); vv[c] = *(const u32x4*)(p + 2 * AW); }
            else { kv[c] = (u32x4){0u, 0u, 0u, 0u}; vv[c] = (u32x4){0u, 0u, 0u, 0u}; } }
#pragma unroll
        for (int c = 0; c < 8; ++c) { const int idx = th + 256 * c, j = idx >> 3, ch = idx & 7;
            *(LAS u32x4*)(Kl + j * 128 + ((ch ^ ((j >> 1) & 7)) * 16)) = kv[c];
            *(LAS u32x4*)(Vl + j * 128 + (((ch >> 2) ^ ((j >> 1) & 1)) * 64) + (ch & 3) * 16) = vv[c]; }
    }
    const int qs = nb * 128 + 32 * w + r32;
    const size_t qrow = rowbase + (size_t)qs * dil + r;
    bf16x8 qf[4];
#pragma unroll
    for (int ks = 0; ks < 4; ++ks) qf[ks] = *(const bf16x8*)(proj + qrow * INC + h * HD + 16 * ks + 8 * hi);
    __syncthreads();
    f32x16 s[5];
#pragma unroll
    for (int tt = 0; tt < 5; ++tt) {
        const int kvrow = 32 * (w + tt) + r32;
        f32x16 a = {0.f, 0.f, 0.f, 0.f, 0.f, 0.f, 0.f, 0.f, 0.f, 0.f, 0.f, 0.f, 0.f, 0.f, 0.f, 0.f};
#pragma unroll
        for (int ks = 0; ks < 4; ++ks) { const bf16x8 kf = *(LAS const bf16x8*)(Kl + kvrow * 128 + (((2 * ks + hi) ^ ((kvrow >> 1) & 7)) * 16)); a = __builtin_amdgcn_mfma_f32_32x32x16_bf16(kf, qf[ks], a, 0, 0, 0); }
        s[tt] = a;
    }
#pragma unroll
    for (int i = 0; i < 16; ++i) { const int cr = crow(i, hi); if (cr < r32) s[0][i] = NEGBIG; if (cr > r32) s[4][i] = NEGBIG; }
    if (nb == 0) {
#pragma unroll
        for (int tt = 0; tt < 4; ++tt) if (w + tt < 4) {
#pragma unroll
            for (int i = 0; i < 16; ++i) s[tt][i] = NEGBIG; }
    }
    float mx = NEGBIG;
#pragma unroll
    for (int tt = 0; tt < 5; ++tt)
#pragma unroll
        for (int i = 0; i < 16; ++i) mx = fmaxf(mx, s[tt][i]);
    mx = fmaxf(mx, __shfl_xor(mx, 32));
    float l = 0.f;
#pragma unroll
    for (int tt = 0; tt < 5; ++tt)
#pragma unroll
        for (int i = 0; i < 16; ++i) { const float p = __builtin_amdgcn_exp2f(s[tt][i] - mx); s[tt][i] = p; l += p; }
    l += __shfl_xor(l, 32);
    f32x16 o[2];
#pragma unroll
    for (int d = 0; d < 2; ++d) o[d] = (f32x16){0.f, 0.f, 0.f, 0.f, 0.f, 0.f, 0.f, 0.f, 0.f, 0.f, 0.f, 0.f, 0.f, 0.f, 0.f, 0.f};
    const int i16 = lane & 15, q4 = i16 >> 2, p4 = i16 & 3, blk = (lane >> 4) & 1;
#pragma unroll
    for (int tt = 0; tt < 5; ++tt)
#pragma unroll
        for (int s2 = 0; s2 < 2; ++s2) {
            u32x4 pw; pw.x = cvt_pk_bf16(s[tt][8 * s2 + 0], s[tt][8 * s2 + 1]); pw.y = cvt_pk_bf16(s[tt][8 * s2 + 2], s[tt][8 * s2 + 3]);
            pw.z = cvt_pk_bf16(s[tt][8 * s2 + 4], s[tt][8 * s2 + 5]); pw.w = cvt_pk_bf16(s[tt][8 * s2 + 6], s[tt][8 * s2 + 7]);
            const bf16x8 pf = __builtin_bit_cast(bf16x8, pw);
            const int kvr = 32 * (w + tt) + 16 * s2 + 4 * hi + q4;
#pragma unroll
            for (int d = 0; d < 2; ++d) {
                LAS const unsigned char* vp = Vl + kvr * 128 + ((d ^ ((q4 >> 1) & 1)) * 64) + 32 * blk + 8 * p4;
                const s16x4 lo = vtr(vp), hi4 = vtr(vp + 8 * 128);
                const bf16x8 vf = (bf16x8){lo[0], lo[1], lo[2], lo[3], hi4[0], hi4[1], hi4[2], hi4[3]};
                o[d] = __builtin_amdgcn_mfma_f32_32x32x16_bf16(pf, vf, o[d], 0, 0, 0);
            }
        }
    const float lse = mx + __builtin_amdgcn_logf(l);
    if (!FINAL) {
        if (hi == 0) { wsf[r32] = 1.0f / l; lse23[((size_t)br * M + qrow) * NH + h] = lse; }
        bf16_t* ob = o23 + (size_t)br * M * AW;
#pragma unroll
        for (int i = 0; i < 16; ++i) { const int ql = crow(i, hi); const float c1 = wsf[ql];
            const size_t orow = rowbase + (size_t)(nb * 128 + 32 * w + ql) * dil + r;
#pragma unroll
            for (int d = 0; d < 2; ++d) ob[orow * AW + h * HD + 32 * d + r32] = (bf16_t)(cvt_pk_bf16(o[d][i] * c1, 0.f) & 0xffffu); }
    } else {
        const float l2 = lse23[(qrow) * NH + h], l3 = lse23[((size_t)M + qrow) * NH + h];
        const float mm = fmaxf(lse, fmaxf(l2, l3));
        const float e1 = __builtin_amdgcn_exp2f(lse - mm), e2 = __builtin_amdgcn_exp2f(l2 - mm), e3 = __builtin_amdgcn_exp2f(l3 - mm);
        const float inv = 1.0f / (e1 + e2 + e3);
        if (hi == 0) { wsf[r32] = e1 * inv / l; wsf[32 + r32] = e2 * inv; wsf[64 + r32] = e3 * inv; }
        const bf16_t* o2 = o23; const bf16_t* o3 = o23 + (size_t)M * AW;
#pragma unroll
        for (int i = 0; i < 16; ++i) { const int ql = crow(i, hi); const float c1 = wsf[ql], c2 = wsf[32 + ql], c3 = wsf[64 + ql];
            const size_t orow = rowbase + (size_t)(nb * 128 + 32 * w + ql);
#pragma unroll
            for (int d = 0; d < 2; ++d) { const size_t oi = orow * AW + h * HD + 32 * d + r32;
                const float v = c1 * o[d][i] + c2 * bf_lo((unsigned)o2[oi]) + c3 * bf_lo((unsigned)o3[oi]);
                ycat[orow * DM + h * HD + 32 * d + r32] = (bf16_t)(cvt_pk_bf16(v, 0.f) & 0xffffu); } }
    }
    __syncthreads();
}

__device__ __forceinline__ void attn_phase_a(LAS unsigned char* lds, const bf16_t* proj, bf16_t* o23, float* lse23, int tid, int lane, int wid) {
    for (int R = blockIdx.x; R < 2048; R += gridDim.x) {
        const int it = 2 * R + (wid >> 2);
        const int br = it >> 11, rem = it & 2047, bh = rem >> 6, rn = rem & 63;
        const int dil = br ? 16 : 4, nbc = 64 / dil, r = rn / nbc, nb = rn % nbc;
        attn_item<false>(lds, proj, dil, bh >> 3, bh & 7, r, nb, br, o23, lse23, nullptr, tid, lane, wid);
    }
}
__device__ __forceinline__ void attn_phase_b(LAS unsigned char* lds, const bf16_t* proj, bf16_t* o23, float* lse23, bf16_t* ycat, int tid, int lane, int wid) {
    for (int R = blockIdx.x; R < 1024; R += gridDim.x) {
        const int it = 2 * R + (wid >> 2);
        const int bh = it >> 6, nb = it & 63;
        attn_item<true>(lds, proj, 1, bh >> 3, bh & 7, 0, nb, 0, o23, lse23, ycat, tid, lane, wid);
    }
}
__device__ __forceinline__ void conv_phase(const bf16_t* proj, bf16_t* ycat, const float* cw, const float* cb, int tid) {
    for (int idx = blockIdx.x * NTHR + tid; idx < M * 64; idx += gridDim.x * NTHR) {
        const int row = idx >> 6, c0 = (idx & 63) * 8, t = row & (SEQ - 1);
        const bf16_t* p = proj + (size_t)row * INC + c0;
        const u32x4 gb = *(const u32x4*)(p + 1536), gc0 = *(const u32x4*)(p + 2048), u0 = *(const u32x4*)(p + 2560);
        u32x4 gc1 = {0u, 0u, 0u, 0u}, u1 = gc1, gc2 = gc1, u2 = gc1;
        if (t >= 1) { gc1 = *(const u32x4*)(p - INC + 2048); u1 = *(const u32x4*)(p - INC + 2560); }
        if (t >= 2) { gc2 = *(const u32x4*)(p - 2 * INC + 2048); u2 = *(const u32x4*)(p - 2 * INC + 2560); }
        u32x4 o;
#pragma unroll
        for (int e = 0; e < 4; ++e) {
            const int c = c0 + 2 * e;
            const float w0a = cw[c], w0b = cw[c + 1], w1a = cw[AW + c], w1b = cw[AW + c + 1], w2a = cw[2 * AW + c], w2b = cw[2 * AW + c + 1];
            const float ya = bf_lo(gb[e]) * (w2a * bf_lo(gc0[e]) * bf_lo(u0[e]) + w1a * bf_lo(gc1[e]) * bf_lo(u1[e]) + w0a * bf_lo(gc2[e]) * bf_lo(u2[e]) + cb[c]);
            const float yb = bf_hi(gb[e]) * (w2b * bf_hi(gc0[e]) * bf_hi(u0[e]) + w1b * bf_hi(gc1[e]) * bf_hi(u1[e]) + w0b * bf_hi(gc2[e]) * bf_hi(u2[e]) + cb[c + 1]);
            o[e] = cvt_pk_bf16(ya, yb);
        }
        *(u32x4*)(ycat + (size_t)row * DM + AW + c0) = o;
    }
}

#define XB_TMO      128
#define XB_XCNT(j)  (256  + 64 * (j))
#define XB_XSUB(j)  (1280 + 64 * (j))
#define XB_XGEN(j)  (2304 + 64 * (j))
#define XB_TOP      3328
#define XB_TOPGEN   3392
#define XCD_BAR_WORDS 3456
#define XB_SPIN_CAP (1u << 18)

__device__ __forceinline__ unsigned xb_ld(unsigned* p)              { return __hip_atomic_load(p, __ATOMIC_RELAXED, __HIP_MEMORY_SCOPE_AGENT); }
__device__ __forceinline__ unsigned xb_add(unsigned* p, unsigned v) { return __hip_atomic_fetch_add(p, v, __ATOMIC_RELAXED, __HIP_MEMORY_SCOPE_AGENT); }
__device__ __forceinline__ unsigned xb_xcc_id() { return (unsigned)__builtin_amdgcn_s_getreg((3 << 11) | 20) & 0xFu; }
#define XB_SPIN(cond, bar) do { unsigned _sp = 0; while (cond) { __builtin_amdgcn_s_sleep(1); \
    if ((++_sp & 255u) == 0u) { if (xb_ld(&(bar)[XB_TMO])) break; if (_sp > XB_SPIN_CAP) { atomicAdd(&(bar)[XB_TMO], 1u); break; } } } } while (0)

struct XcdBarrier {
    unsigned* bar; unsigned x;
    volatile LAS unsigned* st;
};

__device__ __forceinline__ XcdBarrier xcd_barrier_post(unsigned* bar, volatile LAS unsigned* st) {
    XcdBarrier b; b.bar = bar; b.x = xb_xcc_id(); b.st = st;
    if (threadIdx.x == 0) (void)xb_add(&bar[XB_XCNT(b.x)], 1u);
    return b;
}
__device__ __forceinline__ void xcd_barrier_complete(unsigned* bar, unsigned x, unsigned& nloc, unsigned& nx) {
    const unsigned G = gridDim.x * gridDim.y * gridDim.z;
    unsigned sum, cnt, mine, sp = 0u;
    for (;;) {
        sum = 0u; cnt = 0u; mine = 0u;
#pragma unroll
        for (unsigned j = 0; j < 16; ++j) { const unsigned c = xb_ld(&bar[XB_XCNT(j)]); sum += c; cnt += (c > 0u) ? 1u : 0u; mine = (j == x) ? c : mine; }
        if (sum == G) break;
        __builtin_amdgcn_s_sleep(1);
        if ((++sp & 255u) == 0u) { if (xb_ld(&bar[XB_TMO])) break; if (sp > XB_SPIN_CAP) { atomicAdd(&bar[XB_TMO], 1u); break; } }
    }
    nloc = mine > 0u ? mine : 1u; nx = cnt > 0u ? cnt : 1u;
}

__device__ __forceinline__ void xcd_barrier(const XcdBarrier& b) {
    asm volatile("s_waitcnt vmcnt(0)" ::: "memory");
    __syncthreads();
    if (threadIdx.x == 0) {
        unsigned* bar = b.bar;
        __builtin_amdgcn_s_waitcnt(0);
        unsigned nloc = b.st[0], nx = b.st[1];
        if (nloc == 0u) { xcd_barrier_complete(bar, b.x, nloc, nx); b.st[0] = nloc; b.st[1] = nx; }
        const unsigned old = xb_add(&bar[XB_XSUB(b.x)], 1u);
        const unsigned gen = old / nloc;
        if (old + 1u == (gen + 1u) * nloc) {
            __builtin_amdgcn_fence(__ATOMIC_RELEASE, "agent");
            asm volatile("s_waitcnt vmcnt(0)" ::: "memory");
            const unsigned og = xb_add(&bar[XB_TOP], 1u);
            const unsigned tg = og / nx;
            if (og + 1u == (tg + 1u) * nx) xb_add(&bar[XB_TOPGEN], 1u);
            else XB_SPIN(xb_ld(&bar[XB_TOPGEN]) == tg, bar);
            __builtin_amdgcn_fence(__ATOMIC_ACQUIRE, "agent");
            xb_add(&bar[XB_XGEN(b.x)], 1u);
            asm volatile("s_waitcnt vmcnt(0)" ::: "memory");
        } else {
            XB_SPIN(xb_ld(&bar[XB_XGEN(b.x)]) == gen, bar);
            __builtin_amdgcn_fence(__ATOMIC_ACQUIRE, "agent");
            asm volatile("s_waitcnt vmcnt(0)" ::: "memory");
        }
    }
    __syncthreads();
}

#ifndef MK_MULTI
#define MK_MULTI 0
#endif
constexpr int N_PHASES = 1 + 11 * DEPTH;
struct Args { In in; float* out; unsigned char* ws; int ph_lo, ph_hi; };
static_assert(sizeof(Args) == 15 * 8 + 8, "Args has no padding");

__global__ void __launch_bounds__(NTHR, 2) fwd_megakernel(Args a) {
    extern __shared__ __attribute__((aligned(16))) unsigned char lds_raw[];
    LAS unsigned char* lds = (LAS unsigned char*)lds_raw;
    cg::grid_group grid = cg::this_grid();
    unsigned char* ws = a.ws;
    volatile LAS unsigned* MISC = (volatile LAS unsigned*)(lds + MISC_OFF);
    if (threadIdx.x < 16) MISC[threadIdx.x] = 0u;
    __syncthreads();
    XcdBarrier bar; bar.bar = (unsigned*)(ws + WS_CTL); bar.x = 0; bar.st = nullptr;
    if (a.ph_hi - a.ph_lo > 1) bar = xcd_barrier_post((unsigned*)(ws + WS_CTL), MISC + 8);
    float* mod = (float*)(ws + WS_MOD);
    bf16_t* Hb = (bf16_t*)(ws + WS_H); bf16_t* YC = (bf16_t*)(ws + WS_YC); bf16_t* ACT = (bf16_t*)(ws + WS_ACT);
    bf16_t* O23 = (bf16_t*)(ws + WS_O23); float* LSE = (float*)(ws + WS_LSE);
    for (int ph_ = a.ph_lo; ph_ < a.ph_hi; ++ph_) {
        int ph = ph_; asm volatile("" : "+s"(ph));
        int tid = threadIdx.x; asm volatile("" : "+v"(tid));
        const int lane = tid & 63, wave = __builtin_amdgcn_readfirstlane(tid >> 6);
        if (ph == 0) { prologue(a.in, ws, lds, tid, lane, wave); }
        else {
            const int q = ph - 1, L = q / 11, k = q % 11;
            unsigned char* lw = ws + WS_W + (size_t)L * LW_BYTES;
            const float* lmod = mod + (size_t)L * NB * MODW;
            const float* xcur = (L == 0 && k <= 2) ? a.in.x : a.out;
            if (k == 0 || k == 3 || k == 8) {
                const int sub = k == 0 ? 0 : (k == 3 ? 1 : 2);
                norm_phase(xcur, Hb, a.in.norm_g + (size_t)(L * 3 + sub) * DM, lmod + sub * 3 * DM, lane, wave);
            } else if (k == 1 || k == 9) {
                const int f = k == 9;
                pg8::Gemm g{Hb, (const bf16_t*)(lw + LW_W1 + f * W1_BYTES), M, 2 * FF, DM}; pg8::StaticOrder S; S.init(M, 2 * FF, gridDim.x, blockIdx.x);
                pg8::EpiSwiglu E{ACT, FF};
                pg8::gemm_phase<pg8::EpiSwiglu, pg8::StaticOrder, true, true>(lds, tid, g, S, E);
            } else if (k == 2 || k == 10 || k == 7) {
                const int f = k == 10, sub = k == 2 ? 0 : (k == 7 ? 1 : 2);
                const bf16_t* A = k == 7 ? YC : ACT; const bf16_t* Bt = k == 7 ? (const bf16_t*)(lw + LW_WOUT) : (const bf16_t*)(lw + LW_W2 + f * W2_BYTES);
                pg8::Gemm g{A, Bt, M, DM, k == 7 ? DM : FF}; pg8::StaticOrder S; S.init(M, DM, gridDim.x, blockIdx.x);
                pg8::EpiResid E{xcur, a.out, lmod + sub * 3 * DM + 2 * DM, MODW, 13, k == 7 ? 1.0f : 0.5f};
                pg8::gemm_phase<pg8::EpiResid, pg8::StaticOrder, true, true>(lds, tid, g, S, E);
            } else if (k == 4) {
                pg8::Gemm g{Hb, (const bf16_t*)(lw + LW_WIN), M, INC, DM}; pg8::StaticOrder S; S.init(M, INC, gridDim.x, blockIdx.x);
                pg8::EpiWin E{ACT, INC, a.in.q_g + L * HD, a.in.k_g + L * HD, QSCALE};
                pg8::gemm_phase<pg8::EpiWin, pg8::StaticOrder, true, true>(lds, tid, g, S, E);
            } else if (k == 5) {
                attn_phase_a(lds, ACT, O23, LSE, tid, lane, wave);
            } else {
                attn_phase_b(lds, ACT, O23, LSE, YC, tid, lane, wave);
                conv_phase(ACT, YC, a.in.conv_w + (size_t)L * 3 * AW, a.in.conv_b + (size_t)L * AW, tid);
            }
        }
        if (ph_ + 1 < a.ph_hi) { if (ph_ == 0) grid.sync(); else xcd_barrier(bar); }
    }
}

extern "C" void kernel_launch(void* const* d_in, const int* in_sizes, int n_in, void* d_out, int out_size, void* d_ws, size_t ws_size, hipStream_t stream) {
    static int grid_blocks = 0;
    if (grid_blocks == 0) {
        if (n_in != 13 || in_sizes[0] != M * DM || out_size != M * DM || ws_size < WS_END) { fprintf(stderr, "kernel_launch: unexpected shapes (n_in %d, in0 %d, out %d, ws %zu)\n", n_in, n_in > 0 ? in_sizes[0] : -1, out_size, ws_size); grid_blocks = -1; return; }
        int dev = 0, cus = 0, per_cu = 0;
        hipGetDevice(&dev);
        hipDeviceGetAttribute(&cus, hipDeviceAttributeMultiprocessorCount, dev);
        if (hipFuncSetAttribute((const void*)fwd_megakernel, hipFuncAttributeMaxDynamicSharedMemorySize, LDS_BYTES) != hipSuccess) fprintf(stderr, "kernel_launch: hipFuncSetAttribute failed\n");
        if (hipOccupancyMaxActiveBlocksPerMultiprocessor(&per_cu, (const void*)fwd_megakernel, NTHR, LDS_BYTES) != hipSuccess || per_cu < 1) { fprintf(stderr, "kernel_launch: occupancy query says %d\n", per_cu); per_cu = 1; }
        (void)hipGetLastError();
        grid_blocks = cus * per_cu;
    }
    if (grid_blocks < 0) return;
    Args a{};
    const float** ip = (const float**)&a.in;
    for (int i = 0; i < 13; ++i) ip[i] = (const float*)d_in[i];
    a.out = (float*)d_out; a.ws = (unsigned char*)d_ws;
    if (hipMemsetAsync((char*)d_ws + WS_CTL, 0, CTL_BYTES, stream) != hipSuccess) { fprintf(stderr, "kernel_launch: memset failed\n"); return; }
#if MK_MULTI
    for (int ph = 0; ph < N_PHASES; ++ph) { a.ph_lo = ph; a.ph_hi = ph + 1; hipLaunchKernelGGL(fwd_megakernel, dim3(grid_blocks), dim3(NTHR), LDS_BYTES, stream, a); }
#else
    a.ph_lo = 0; a.ph_hi = N_PHASES;
    void* args[] = {&a};
    hipError_t e = hipLaunchCooperativeKernel((const void*)fwd_megakernel, dim3(grid_blocks), dim3(NTHR), args, LDS_BYTES, stream);
    if (e != hipSuccess) fprintf(stderr, "cooperative launch failed: %s (grid %d)\n", hipGetErrorString(e), grid_blocks);
#endif
}
```

```cpp
#include <hip/hip_runtime.h>
#include <hip/hip_cooperative_groups.h>
#include <cstdio>
#include <cstdint>
namespace cg = cooperative_groups;
namespace pg8 {
#define PG8_LAS __attribute__((address_space(3)))
typedef unsigned short bf16_t;
typedef short bf16x8 __attribute__((ext_vector_type(8)));
typedef float f32x4 __attribute__((ext_vector_type(4)));
typedef unsigned u32x4 __attribute__((ext_vector_type(4)));
constexpr int BM = 256, BK = 64, HALF = 128, HTB = HALF * BK * 2  , STAGE_BYTES = 8 * HTB, NXCD = 8, WGM = 8;

__host__ __device__ __forceinline__ int lds_byte(int r, int c) { const int st = (r >> 4) * 2 + (c >> 5), rr = r & 15, cc = c & 31, ob = rr * 64 + cc * 2; return st * 1024 + (ob ^ (((ob >> 9) & 1) << 5)); }
__host__ __device__ __forceinline__ void stage_rc(int b, int& R, int& C) { const int st = b / 1024, sb = b % 1024, swz = sb ^ (((sb >> 9) & 1) << 5); R = (st >> 1) * 16 + swz / 64; C = (st & 1) * 32 + (swz % 64) / 2; }
__host__ __device__ __forceinline__ int perm32(int rho) { const int n = rho >> 4, i = rho & 15; return 8 * (i >> 2) + 4 * n + (i & 3); }

struct Unit { int pm, pn; };
struct Gemm { const bf16_t* A; const bf16_t* Bt; int M, N, K; };

struct StaticOrder {
    int nM, nN, nwg, G, c;
    __host__ __device__ void init(int M, int N, int G_, int c_) { nM = M / BM; nN = N / BM; nwg = nM * nN; G = G_; c = c_; }
    __host__ __device__ bool next(int i, Unit& u) const {
        const long L = (long)i * G + c; if (L >= nwg) return false;
        int wgid = (int)L; { const int q = nwg / NXCD, r = nwg % NXCD, xcd = wgid % NXCD, off = wgid / NXCD; wgid = (xcd < r ? xcd * (q + 1) : r * (q + 1) + (xcd - r) * q) + off; }
        const int nig = WGM * nN, gid = wgid / nig, fm = gid * WGM, gsz = (nM - fm) < WGM ? (nM - fm) : WGM;
        u.pm = fm + ((wgid % nig) % gsz); u.pn = (wgid % nig) / gsz; return true;
    }
    __device__ __forceinline__ void a_ready(const Unit&) const {}
    __device__ __forceinline__ void done(const Unit&) const {}
};

typedef unsigned u32x2 __attribute__((ext_vector_type(2)));
__device__ __forceinline__ unsigned cvt_pk_bf16(float lo, float hi) { typedef float f2 __attribute__((ext_vector_type(2))); typedef __bf16 b2 __attribute__((ext_vector_type(2)));
    f2 v = {lo, hi}; b2 b = __builtin_convertvector(v, b2); return __builtin_bit_cast(unsigned, b); }
__device__ __forceinline__ float silu_f(float g) { return g * __builtin_amdgcn_rcpf(1.0f + __builtin_amdgcn_exp2f(-1.4426950408889634f * g)); }

struct EpiSwiglu {
    static constexpr bool PERM = true, AFTER_DRAIN = false;
    bf16_t* O; int ldc;
    __device__ __forceinline__ void operator()(const f32x4 (&acc)[2][2][4][2], const Unit& u, int wr, int wc, int fr, int fq) const {
        const int row0 = u.pm * BM + wr * 64 + fr, col0 = u.pn * HALF + wc * 32 + 8 * fq;
#pragma unroll
        for (int ai = 0; ai < 2; ++ai)
#pragma unroll
            for (int m = 0; m < 4; ++m) {
                const f32x4 g0 = acc[ai][0][m][0], g1 = acc[ai][0][m][1], u0 = acc[ai][1][m][0], u1 = acc[ai][1][m][1];
                u32x4 w;
                w.x = cvt_pk_bf16(silu_f(g0[0]) * u0[0], silu_f(g0[1]) * u0[1]); w.y = cvt_pk_bf16(silu_f(g0[2]) * u0[2], silu_f(g0[3]) * u0[3]);
                w.z = cvt_pk_bf16(silu_f(g1[0]) * u1[0], silu_f(g1[1]) * u1[1]); w.w = cvt_pk_bf16(silu_f(g1[2]) * u1[2], silu_f(g1[3]) * u1[3]);
                *(u32x4*)(O + (size_t)(row0 + ai * HALF + m * 16) * ldc + col0) = w;
            }
    }
};
struct EpiWin {
    static constexpr bool PERM = true, AFTER_DRAIN = false;
    bf16_t* O; int ldc; bf16_t* QKV; const float* qg; const float* kg; float qscale;
    __device__ __forceinline__ void operator()(const f32x4 (&acc)[2][2][4][2], const Unit& u, int wr, int wc, int fr, int fq) const {
        const int row0 = u.pm * BM + wr * 64 + fr, col0 = u.pn * BM + wc * 64 + 8 * fq;
        const int kind = u.pn < 2 ? 1 : (u.pn < 4 ? 2 : 0);
        f32x4 gv[2][2];
#pragma unroll
        for (int bj = 0; bj < 2; ++bj)
#pragma unroll
            for (int n = 0; n < 2; ++n) gv[bj][n] = kind ? *(const f32x4*)((kind == 1 ? qg : kg) + 32 * bj + 8 * fq + 4 * n) : (f32x4){1.f, 1.f, 1.f, 1.f};
        const float ks = kind == 1 ? qscale : 1.0f;
#pragma unroll
        for (int ai = 0; ai < 2; ++ai)
#pragma unroll
            for (int m = 0; m < 4; ++m) {
                float rs = 1.0f;
                if (kind) {
                    float ss = 0.f;
#pragma unroll
                    for (int bj = 0; bj < 2; ++bj)
#pragma unroll
                        for (int n = 0; n < 2; ++n) { const f32x4 x = acc[ai][bj][m][n]; ss += (x[0] * x[0] + x[1] * x[1]) + (x[2] * x[2] + x[3] * x[3]); }
                    ss += __shfl_xor(ss, 16); ss += __shfl_xor(ss, 32);
                    rs = ks * __builtin_amdgcn_rsqf(ss * (1.0f / 64.0f) + 1e-6f);
                }
                const int row = row0 + ai * HALF + m * 16;
                bf16_t* rowp = u.pn < 6 ? QKV + ((size_t)(((u.pn >> 1) * 4 + (row >> 13)) * 8 + (u.pn & 1) * 4 + wc) * 8192 + (row & 8191)) * 64 + 8 * fq
                                        : O + (size_t)row * ldc + (col0 - 1536);
#pragma unroll
                for (int bj = 0; bj < 2; ++bj) {
                    const f32x4 v0 = acc[ai][bj][m][0] * (gv[bj][0] * rs), v1 = acc[ai][bj][m][1] * (gv[bj][1] * rs);
                    u32x4 w; w.x = cvt_pk_bf16(v0[0], v0[1]); w.y = cvt_pk_bf16(v0[2], v0[3]); w.z = cvt_pk_bf16(v1[0], v1[1]); w.w = cvt_pk_bf16(v1[2], v1[3]);
                    *(u32x4*)(rowp + 32 * bj) = w;
                }
            }
    }
};
struct EpiResid {
    static constexpr bool PERM = false, AFTER_DRAIN = false;
    const float* xin; float* out; const float* gate; int gate_bstride; int rows_per_batch_shift; float gs;
    __device__ __forceinline__ void operator()(const f32x4 (&acc)[2][2][4][2], const Unit& u, int wr, int wc, int fr, int fq) const {
        const int b = (u.pm * BM) >> rows_per_batch_shift;
        const float* gp = gate + (size_t)b * gate_bstride;
        const int row0 = u.pm * BM + wr * 64 + fr, col0 = u.pn * BM + wc * 32 + 4 * fq;
        f32x4 gv[2][2];
#pragma unroll
        for (int bj = 0; bj < 2; ++bj)
#pragma unroll
            for (int n = 0; n < 2; ++n) gv[bj][n] = *(const f32x4*)(gp + col0 + bj * HALF + n * 16) * gs;
#pragma unroll
        for (int ai = 0; ai < 2; ++ai)
#pragma unroll
            for (int m = 0; m < 4; ++m) { const size_t off = (size_t)(row0 + ai * HALF + m * 16) * 1024 + col0;
#pragma unroll
                for (int bj = 0; bj < 2; ++bj)
#pragma unroll
                    for (int n = 0; n < 2; ++n) { const f32x4 xv = *(const f32x4*)(xin + off + bj * HALF + n * 16); *(f32x4*)(out + off + bj * HALF + n * 16) = xv + gv[bj][n] * acc[ai][bj][m][n]; } }
    }
};
template <class Epi, class Sched, bool ALIGN_EPI = false, bool SP2 = false>
__device__ __forceinline__ void gemm_phase(PG8_LAS unsigned char* lds, const int tid, const Gemm g, const Sched& S, const Epi& E) {
    const int wid = __builtin_amdgcn_readfirstlane(tid >> 6), lane = tid & 63, wr = wid >> 2, wc = wid & 3, fr = lane & 15, fq = lane >> 4;
    const int K = g.K, nt = K / BK;
    unsigned voffA[2], voffB[2];
#pragma unroll
    for (int i = 0; i < 2; ++i) { int R, C; stage_rc(tid * 16 + i * 8192, R, C); const int Rb = Epi::PERM ? ((R & ~31) + perm32(R & 31)) : R;
        voffA[i] = (unsigned)(R * K + C) * 2u; voffB[i] = (unsigned)(Rb * K + C) * 2u; }
    const size_t kstep = (size_t)(BK * 2);
    const size_t hstep = (size_t)HALF * K * 2;
    const size_t tstep = 2 * hstep;
    const unsigned ldsw = (unsigned)wid * 1024u;
    const int aoff = lds_byte(wr * 64 + fr, fq * 8), boff = lds_byte(wc * 32 + fr, fq * 8);
#define PG8_SA(b, h) (((b) * 2 + (h)) * HTB)
#define PG8_SB(b, h) ((4 + (b) * 2 + (h)) * HTB)
#define PG8_STAGE(bufoff, gbase, voff) do { _Pragma("unroll") for (int _i = 0; _i < 2; ++_i) \
        __builtin_amdgcn_global_load_lds((const unsigned*)((const char*)(gbase) + (voff)[_i]), (PG8_LAS unsigned*)(lds + (bufoff) + ldsw + _i * 8192), 16, 0, 0); } while (0)
#define PG8_LDA(dst, b, h) do { _Pragma("unroll") for (int m = 0; m < 4; ++m) _Pragma("unroll") for (int k = 0; k < 2; ++k) dst[m][k] = *(const PG8_LAS bf16x8*)(lds + PG8_SA(b, h) + aoff + m * 2048 + k * 1024); } while (0)
#define PG8_LDB(dst, b, h) do { _Pragma("unroll") for (int n = 0; n < 2; ++n) _Pragma("unroll") for (int k = 0; k < 2; ++k) dst[n][k] = *(const PG8_LAS bf16x8*)(lds + PG8_SB(b, h) + boff + n * 2048 + k * 1024); } while (0)
#define PG8_MMA(ai, bj, At, Bt) do { __builtin_amdgcn_s_setprio(1); _Pragma("unroll") for (int m = 0; m < 4; ++m) _Pragma("unroll") for (int n = 0; n < 2; ++n) _Pragma("unroll") for (int k = 0; k < 2; ++k) \
        acc[ai][bj][m][n] = __builtin_amdgcn_mfma_f32_16x16x32_bf16(Bt[n][k], At[m][k], acc[ai][bj][m][n], 0, 0, 0); __builtin_amdgcn_s_setprio(0); } while (0)
#define PG8_WAIT_V(n) asm volatile("s_waitcnt vmcnt(" #n ")" ::: "memory")
#define PG8_WAIT_L(n) asm volatile("s_waitcnt lgkmcnt(" #n ")" ::: "memory")
#define PG8_BAR __builtin_amdgcn_s_barrier()
#define PG8_SCHED __builtin_amdgcn_sched_barrier(0)
    Unit cur, nxt; int ui = 0;
    if (!S.next(0, cur)) return;
    f32x4 acc[2][2][4][2];
#pragma unroll
    for (int a = 0; a < 2; ++a)
#pragma unroll
        for (int b = 0; b < 2; ++b)
#pragma unroll
            for (int m = 0; m < 4; ++m)
#pragma unroll
                for (int n = 0; n < 2; ++n) acc[a][b][m][n] = (f32x4){0.f, 0.f, 0.f, 0.f};
    bf16x8 At[4][2], B0[2][2], B1[2][2];
    const char* cA = (const char*)g.A + (size_t)cur.pm * tstep; const char* cB = (const char*)g.Bt + (size_t)cur.pn * tstep;
    S.a_ready(cur);
    if constexpr (SP2) {
        PG8_STAGE(PG8_SB(0, 0), cB, voffB); PG8_STAGE(PG8_SB(0, 1), cB + hstep, voffB); PG8_STAGE(PG8_SA(0, 0), cA, voffA); PG8_STAGE(PG8_SA(0, 1), cA + hstep, voffA);
        if (wr == 1) PG8_BAR;
        PG8_WAIT_V(2); PG8_BAR;
        PG8_STAGE(PG8_SB(1, 0), cB + kstep, voffB); PG8_STAGE(PG8_SA(1, 0), cA + kstep, voffA); PG8_STAGE(PG8_SB(1, 1), cB + hstep + kstep, voffB);
        PG8_WAIT_V(6); PG8_BAR;
    } else {
        PG8_STAGE(PG8_SB(0, 0), cB, voffB); PG8_STAGE(PG8_SA(0, 0), cA, voffA); PG8_STAGE(PG8_SB(0, 1), cB + hstep, voffB); PG8_STAGE(PG8_SA(0, 1), cA + hstep, voffA);
        if (wr == 1) PG8_BAR;
        PG8_WAIT_V(4); PG8_BAR;
        PG8_STAGE(PG8_SB(1, 0), cB + kstep, voffB); PG8_STAGE(PG8_SA(1, 0), cA + kstep, voffA); PG8_STAGE(PG8_SB(1, 1), cB + hstep + kstep, voffB);
        PG8_WAIT_V(6); PG8_BAR;
    }
    for (;;) {
        const bool has_next = S.next(ui + 1, nxt);
        const char* nA = has_next ? (const char*)g.A + (size_t)nxt.pm * tstep : cA; const char* nB = has_next ? (const char*)g.Bt + (size_t)nxt.pn * tstep : cB;
        for (int t = 0; t < nt; t += 2) {
            const bool last = (t == nt - 2);
            const char* a1 = cA + (size_t)(t + 1) * kstep;
            const char* a2 = last ? nA : cA + (size_t)(t + 2) * kstep; const char* b2 = last ? nB : cB + (size_t)(t + 2) * kstep;
            const char* a3 = a2 + kstep; const char* b3 = b2 + kstep;
            if (last && has_next) S.a_ready(nxt);
            if constexpr (SP2) {
            PG8_LDB(B0, 0, 0); PG8_LDB(B1, 0, 1); PG8_SCHED; PG8_LDA(At, 0, 0); PG8_STAGE(PG8_SA(1, 1), a1 + hstep, voffA);
            PG8_WAIT_V(8); PG8_WAIT_L(0); PG8_BAR; PG8_MMA(0, 0, At, B0); PG8_MMA(0, 1, At, B1); PG8_BAR; PG8_SCHED;
            PG8_LDA(At, 0, 1); PG8_STAGE(PG8_SB(0, 0), b2, voffB); PG8_STAGE(PG8_SB(0, 1), b2 + hstep, voffB); PG8_STAGE(PG8_SA(0, 0), a2, voffA);
            PG8_WAIT_V(8); PG8_WAIT_L(0); PG8_BAR; PG8_MMA(1, 0, At, B0); PG8_MMA(1, 1, At, B1); PG8_BAR; PG8_SCHED;
            PG8_LDB(B0, 1, 0); PG8_LDB(B1, 1, 1); PG8_SCHED; PG8_LDA(At, 1, 0); PG8_STAGE(PG8_SA(0, 1), a2 + hstep, voffA);
            PG8_WAIT_V(8); PG8_WAIT_L(0); PG8_BAR; PG8_MMA(0, 0, At, B0); PG8_MMA(0, 1, At, B1); PG8_BAR; PG8_SCHED;
            PG8_LDA(At, 1, 1); PG8_STAGE(PG8_SB(1, 0), b3, voffB); PG8_STAGE(PG8_SB(1, 1), b3 + hstep, voffB); PG8_STAGE(PG8_SA(1, 0), a3, voffA);
            PG8_WAIT_V(8); PG8_WAIT_L(0); PG8_BAR; PG8_MMA(1, 0, At, B0); PG8_MMA(1, 1, At, B1); PG8_BAR; PG8_SCHED;
            } else {
            PG8_LDB(B0, 0, 0); PG8_SCHED; PG8_LDA(At, 0, 0); PG8_STAGE(PG8_SA(1, 1), a1 + hstep, voffA);
            PG8_WAIT_L(8); PG8_BAR; PG8_WAIT_L(0); PG8_MMA(0, 0, At, B0); PG8_BAR; PG8_SCHED;
            PG8_LDB(B1, 0, 1); PG8_STAGE(PG8_SB(0, 0), b2, voffB);
            PG8_BAR; PG8_WAIT_L(0); PG8_MMA(0, 1, At, B1); PG8_BAR;
            PG8_LDA(At, 0, 1); PG8_STAGE(PG8_SA(0, 0), a2, voffA);
            PG8_BAR; PG8_WAIT_L(0); PG8_MMA(1, 0, At, B0); PG8_BAR; PG8_SCHED;
            PG8_STAGE(PG8_SB(0, 1), b2 + hstep, voffB);
            PG8_WAIT_V(6); PG8_BAR; PG8_MMA(1, 1, At, B1); PG8_BAR;
            PG8_LDB(B0, 1, 0); PG8_SCHED; PG8_LDA(At, 1, 0); PG8_STAGE(PG8_SA(0, 1), a2 + hstep, voffA);
            PG8_WAIT_L(8); PG8_BAR; PG8_WAIT_L(0); PG8_MMA(0, 0, At, B0); PG8_BAR; PG8_SCHED;
            PG8_LDB(B1, 1, 1); PG8_STAGE(PG8_SB(1, 0), b3, voffB);
            PG8_BAR; PG8_WAIT_L(0); PG8_MMA(0, 1, At, B1); PG8_BAR;
            PG8_LDA(At, 1, 1); PG8_STAGE(PG8_SA(1, 0), a3, voffA);
            PG8_BAR; PG8_WAIT_L(0); PG8_MMA(1, 0, At, B0); PG8_BAR; PG8_SCHED;
            PG8_STAGE(PG8_SB(1, 1), b3 + hstep, voffB);
            PG8_WAIT_V(6); PG8_BAR; PG8_MMA(1, 1, At, B1); PG8_BAR;
            }
        }
        if constexpr (ALIGN_EPI) { if (wr == 0) PG8_BAR; }
        if constexpr (!Epi::AFTER_DRAIN) { E(acc, cur, wr, wc, fr, fq); S.done(cur); }
        if (!has_next) break;
#pragma unroll
        for (int a = 0; a < 2; ++a)
#pragma unroll
            for (int b = 0; b < 2; ++b)
#pragma unroll
                for (int m = 0; m < 4; ++m)
#pragma unroll
                    for (int n = 0; n < 2; ++n) acc[a][b][m][n] = (f32x4){0.f, 0.f, 0.f, 0.f};
        cur = nxt; cA = nA; cB = nB; ++ui;
        if constexpr (ALIGN_EPI) { if (wr == 1) PG8_BAR; }
    }
    PG8_WAIT_V(0);
    if constexpr (!ALIGN_EPI) { if (wr == 0) PG8_BAR; }
    PG8_BAR;
    if constexpr (Epi::AFTER_DRAIN) { E.fused(acc, cur, wr, wc, fr, fq, lds, wid, lane); S.done(cur); }
#undef PG8_SA
#undef PG8_SB
#undef PG8_STAGE
#undef PG8_LDA
#undef PG8_LDB
#undef PG8_MMA
#undef PG8_WAIT_V
#undef PG8_WAIT_L
#undef PG8_BAR
#undef PG8_SCHED
}
}

#define LAS __attribute__((address_space(3)))
typedef unsigned short bf16_t;
typedef short bf16x8 __attribute__((ext_vector_type(8)));
typedef short s16x4 __attribute__((ext_vector_type(4)));
typedef float f32x4 __attribute__((ext_vector_type(4)));
typedef float f32x16 __attribute__((ext_vector_type(16)));
typedef unsigned u32x4 __attribute__((ext_vector_type(4)));
typedef unsigned u32x2 __attribute__((ext_vector_type(2)));
constexpr int DM = 1024, NB = 4, SEQ = 8192, DEPTH = 2, FF = 2816, NH = 8, HD = 64, AW = 512, INC = 3072, MODW = 9216;
constexpr int M = NB * SEQ;
constexpr float EPS = 1e-6f;
constexpr float QSCALE = 0.125f * 1.4426950408889634f;
constexpr float NEGBIG = -1e30f;
constexpr int NWAVES = 8, NTHR = 512;
constexpr size_t MiB = 1u << 20;
constexpr size_t WS_MOD = 0;
constexpr size_t WS_W = 2 * MiB;
constexpr size_t W1_BYTES = (size_t)2 * FF * DM * 2, W2_BYTES = (size_t)DM * FF * 2, WIN_BYTES = (size_t)INC * DM * 2, WOUT_BYTES = (size_t)DM * DM * 2;
constexpr size_t LW_W1 = 0, LW_W2 = 2 * W1_BYTES, LW_WIN = LW_W2 + 2 * W2_BYTES, LW_WOUT = LW_WIN + WIN_BYTES, LW_BYTES = LW_WOUT + WOUT_BYTES;
static_assert(WS_W + DEPTH * LW_BYTES <= 88 * MiB, "weights");
constexpr size_t WS_H = 88 * MiB;
constexpr size_t WS_YC = 152 * MiB;
constexpr size_t WS_ACT = 216 * MiB;
constexpr size_t WS_QKV = WS_ACT + 96 * MiB;
constexpr size_t WS_O23 = 408 * MiB;
constexpr size_t WS_LSE = 472 * MiB;
constexpr size_t WS_CTL = 474 * MiB, CTL_BYTES = 16384;
constexpr size_t WS_END = 475 * MiB;
constexpr int RING_BYTES = 131072, WSCR_OFF = RING_BYTES, MISC_OFF = RING_BYTES + NWAVES * 512, LDS_BYTES = MISC_OFF + 256;

__device__ __forceinline__ float bf_lo(unsigned u) { return __uint_as_float(u << 16); }
__device__ __forceinline__ float bf_hi(unsigned u) { return __uint_as_float(u & 0xffff0000u); }
__device__ __forceinline__ float wave_sum(float v) {
#pragma unroll
    for (int o = 1; o < 64; o <<= 1) v += __shfl_xor(v, o);
    return v;
}
using pg8::cvt_pk_bf16;

__device__ __forceinline__ void transpose_item(const float* W, int K, int N, bf16_t* WT, int k0, int src_n0, int dst_n0, LAS float* scr, int lane) {
#pragma unroll 8
    for (int i = 0; i < 32; ++i) { const int kk = 2 * i + (lane >> 5); scr[kk * 33 + (lane & 31)] = W[(size_t)(k0 + kk) * N + src_n0 + (lane & 31)]; }
    asm volatile("s_waitcnt lgkmcnt(0)" ::: "memory");
    const int c = lane & 7;
#pragma unroll
    for (int j = 0; j < 4; ++j) { const int n = (lane >> 3) + 8 * j; const LAS float* s = scr + (8 * c) * 33 + n;
        u32x4 o; o.x = cvt_pk_bf16(s[0 * 33], s[1 * 33]); o.y = cvt_pk_bf16(s[2 * 33], s[3 * 33]); o.z = cvt_pk_bf16(s[4 * 33], s[5 * 33]); o.w = cvt_pk_bf16(s[6 * 33], s[7 * 33]);
        *(u32x4*)(WT + (size_t)(dst_n0 + n) * K + k0 + 8 * c) = o; }
    asm volatile("s_waitcnt lgkmcnt(0)" ::: "memory");
}
struct In { const float *x, *c, *w_ada, *b_ada, *norm_g, *w_in, *q_g, *k_g, *conv_w, *conv_b, *w_out, *w1, *w2; };

__device__ __forceinline__ void prologue(const In& I, unsigned char* ws, LAS unsigned char* lds, int tid, int lane, int wave) {
    LAS float* sc = (LAS float*)(lds + 69632);
    LAS float* red = (LAS float*)(lds + 69632 + 16384);
    float* mod = (float*)(ws + WS_MOD);
    for (int i = tid; i < NB * DM; i += NTHR) { const float v = I.c[i]; sc[i] = v / (1.0f + __expf(-v)); }
    __syncthreads();
    for (int it = blockIdx.x; it < DEPTH * (MODW / 64); it += gridDim.x) {
        const int l = it / (MODW / 64), j0 = (it % (MODW / 64)) * 64;
        const float* wp = I.w_ada + (size_t)l * DM * MODW + j0 + lane;
        float a0 = 0.f, a1 = 0.f, a2 = 0.f, a3 = 0.f; const int k0 = wave * 128;
#pragma unroll 8
        for (int k = k0; k < k0 + 128; ++k) { const float w = wp[(size_t)k * MODW]; a0 += sc[k] * w; a1 += sc[DM + k] * w; a2 += sc[2 * DM + k] * w; a3 += sc[3 * DM + k] * w; }
        red[(wave * 4 + 0) * 64 + lane] = a0; red[(wave * 4 + 1) * 64 + lane] = a1; red[(wave * 4 + 2) * 64 + lane] = a2; red[(wave * 4 + 3) * 64 + lane] = a3;
        __syncthreads();
        if (tid < 256) { const int b = tid >> 6, cl = tid & 63; float s = 0.f;
#pragma unroll
            for (int w = 0; w < 8; ++w) s += red[(w * 4 + b) * 64 + cl];
            mod[(size_t)(l * NB + b) * MODW + j0 + cl] = s + I.b_ada[(size_t)l * MODW + j0 + cl]; }
        __syncthreads();
    }
    LAS float* scr = (LAS float*)(lds + wave * 8448);
    const int gw = blockIdx.x * NWAVES + wave, NGW = gridDim.x * NWAVES;
    constexpr int I_W1 = (DM / 64) * (2 * FF / 32), I_W2 = (FF / 64) * (DM / 32), I_WIN = (DM / 64) * (INC / 32), I_WOUT = (DM / 64) * (DM / 32);
    constexpr int I_LAYER = 2 * I_W1 + 2 * I_W2 + I_WIN + I_WOUT;
    for (int it = gw; it < DEPTH * I_LAYER; it += NGW) {
        const int l = it / I_LAYER; int r = it % I_LAYER;
        unsigned char* lw = ws + WS_W + (size_t)l * LW_BYTES;
        if (r < 2 * I_W1) { const int f = r / I_W1; r %= I_W1; const int nblk = 2 * FF / 32, kb = r / nblk, nb = r % nblk, n0 = nb * 32;
            const int pn = n0 >> 8, bj = (n0 >> 7) & 1, i = n0 & 127;
            transpose_item(I.w1 + (size_t)(l * 2 + f) * DM * 2 * FF, DM, 2 * FF, (bf16_t*)(lw + LW_W1 + f * W1_BYTES), kb * 64, bj * FF + 128 * pn + i, n0, scr, lane); continue; }
        r -= 2 * I_W1;
        if (r < 2 * I_W2) { const int f = r / I_W2; r %= I_W2; const int nblk = DM / 32, kb = r / nblk, nb = r % nblk;
            transpose_item(I.w2 + (size_t)(l * 2 + f) * FF * DM, FF, DM, (bf16_t*)(lw + LW_W2 + f * W2_BYTES), kb * 64, nb * 32, nb * 32, scr, lane); continue; }
        r -= 2 * I_W2;
        if (r < I_WIN) { const int nblk = INC / 32, kb = r / nblk, nb = r % nblk, n0 = nb * 32; const int pn = n0 >> 8, bj = (n0 >> 7) & 1, wc = (n0 >> 5) & 3;
            transpose_item(I.w_in + (size_t)l * DM * INC, DM, INC, (bf16_t*)(lw + LW_WIN), kb * 64, 256 * pn + 64 * wc + 32 * bj, n0, scr, lane); continue; }
        r -= I_WIN;
        { const int nblk = DM / 32, kb = r / nblk, nb = r % nblk;
            transpose_item(I.w_out + (size_t)l * DM * DM, DM, DM, (bf16_t*)(lw + LW_WOUT), kb * 64, nb * 32, nb * 32, scr, lane); }
    }
}

__device__ __forceinline__ void norm_phase(const float* xin, bf16_t* h, const float* g, const float* modp  , int lane, int wave) {
    const int gw = blockIdx.x * NWAVES + wave, NGW = gridDim.x * NWAVES;
    for (int chunk = gw; chunk < M / 16; chunk += NGW) {
        const int row0 = chunk * 16, b = row0 >> 13;
        const float* mp = modp + (size_t)b * MODW;
        f32x4 G[4], S[4];
#pragma unroll
        for (int j = 0; j < 4; ++j) { const int c = 4 * lane + 256 * j; G[j] = *(const f32x4*)(g + c) * (*(const f32x4*)(mp + DM + c) + 1.0f); S[j] = *(const f32x4*)(mp + c); }
        for (int r = 0; r < 16; ++r) {
            const f32x4* xr = (const f32x4*)(xin + (size_t)(row0 + r) * DM) + lane;
            f32x4 v[4]; float s = 0.f;
#pragma unroll
            for (int j = 0; j < 4; ++j) { v[j] = xr[64 * j]; s += (v[j].x * v[j].x + v[j].y * v[j].y) + (v[j].z * v[j].z + v[j].w * v[j].w); }
            const float rstd = 1.0f / sqrtf(wave_sum(s) * (1.0f / DM) + EPS);
            u32x2* o8 = (u32x2*)(h + (size_t)(row0 + r) * DM) + lane;
#pragma unroll
            for (int j = 0; j < 4; ++j) { const f32x4 o = v[j] * rstd * G[j] + S[j]; u32x2 w; w.x = cvt_pk_bf16(o.x, o.y); w.y = cvt_pk_bf16(o.z, o.w); o8[64 * j] = w; }
        }
    }
}

__device__ __forceinline__ int crow(int i, int hi) { return (i & 3) + 8 * (i >> 2) + 4 * hi; }
typedef short v4i16_t __attribute__((ext_vector_type(4)));
__device__ __forceinline__ s16x4 vtr(LAS const unsigned char* p) { return __builtin_bit_cast(s16x4, __builtin_amdgcn_ds_read_tr16_b64_v4i16((LAS v4i16_t*)p)); }

struct AttnItem { int dil, b, h, r, nb, br; };
template <bool FINAL> __device__ __forceinline__ AttnItem attn_decode(int R, int wid) {
    AttnItem t; const int it = 2 * R + (wid >> 2);
    if (!FINAL) { const int br = it >> 11, rem = it & 2047, bh = rem >> 6, rn = rem & 63; t.br = br; t.dil = br ? 16 : 4; const int nbc = 64 / t.dil; t.r = rn / nbc; t.nb = rn % nbc; t.b = bh >> 3; t.h = bh & 7; }
    else { const int bh = it >> 6; t.br = 0; t.dil = 1; t.r = 0; t.nb = it & 63; t.b = bh >> 3; t.h = bh & 7; }
    return t;
}
__device__ __forceinline__ void attn_load(const bf16_t* proj, const AttnItem& t, u32x4 (&kv)[8], u32x4 (&vv)[8], int tid) {
    const int th = tid & 255;
    const bf16_t* kb = proj + (size_t)((NB + t.b) * NH + t.h) * SEQ * HD;
#pragma unroll
    for (int c = 0; c < 8; ++c) { const int idx = th + 256 * c, j = idx >> 3, ch = idx & 7; const int sidx = (t.nb - 1) * 128 + j;
        if (sidx >= 0) { const bf16_t* p = kb + ((size_t)sidx * t.dil + t.r) * HD + ch * 8; kv[c] = *(const u32x4*)p; vv[c] = *(const u32x4*)(p + (size_t)NB * NH * SEQ * HD); }
        else { kv[c] = (u32x4){0u, 0u, 0u, 0u}; vv[c] = (u32x4){0u, 0u, 0u, 0u}; } }
}
__device__ __forceinline__ void attn_load_q(const bf16_t* proj, const AttnItem& t, bf16x8 (&qf)[4], int lane, int wid) {
    const int w = wid & 3, r32 = lane & 31, hi = lane >> 5;
    const size_t qrow = (size_t)(t.b * NH + t.h) * SEQ + (size_t)(t.nb * 128 + 32 * w + r32) * t.dil + t.r;
#pragma unroll
    for (int ks = 0; ks < 4; ++ks) qf[ks] = *(const bf16x8*)(proj + qrow * HD + 16 * ks + 8 * hi);
}
__device__ __forceinline__ void attn_stage(LAS unsigned char* lds, const u32x4 (&kv)[8], const u32x4 (&vv)[8], int tid, int wid) {
    const int th = tid & 255; LAS unsigned char* Kl = lds + (wid >> 2) * 65536; LAS unsigned char* Vl = Kl + 32768;
#pragma unroll
    for (int c = 0; c < 8; ++c) { const int idx = th + 256 * c, j = idx >> 3, ch = idx & 7;
        *(LAS u32x4*)(Kl + j * 128 + ((ch ^ ((j >> 1) & 7)) * 16)) = kv[c];
        *(LAS u32x4*)(Vl + j * 128 + (((ch >> 2) ^ ((j >> 1) & 1)) * 64) + (ch & 3) * 16) = vv[c]; }
}
template <bool FINAL>
__device__ __forceinline__ void attn_compute(LAS unsigned char* lds, const bf16_t* proj, const AttnItem& t, const AttnItem& nxt, bool more, bf16x8 (&qf)[4], bf16_t* o23, float* lse23, bf16_t* ycat, int lane, int wid) {
    const int w = wid & 3, r32 = lane & 31, hi = lane >> 5;
    LAS unsigned char* Kl = lds + (wid >> 2) * 65536; LAS unsigned char* Vl = Kl + 32768;
    const int nb = t.nb;
    f32x16 o[2];
#pragma unroll
    for (int d = 0; d < 2; ++d) o[d] = (f32x16){0.f, 0.f, 0.f, 0.f, 0.f, 0.f, 0.f, 0.f, 0.f, 0.f, 0.f, 0.f, 0.f, 0.f, 0.f, 0.f};
    const int i16 = lane & 15, q4 = i16 >> 2, p4 = i16 & 3, blk = (lane >> 4) & 1;
    float mx = NEGBIG, l = 0.f;
#pragma unroll
    for (int tt = 4; tt >= 0; --tt) {
        if (nb == 0 && w + tt < 4) continue;
        const int kvrow = 32 * (w + tt) + r32;
        f32x16 sc = {0.f, 0.f, 0.f, 0.f, 0.f, 0.f, 0.f, 0.f, 0.f, 0.f, 0.f, 0.f, 0.f, 0.f, 0.f, 0.f};
#pragma unroll
        for (int ks = 0; ks < 4; ++ks) { const bf16x8 kf = *(LAS const bf16x8*)(Kl + kvrow * 128 + (((2 * ks + hi) ^ ((kvrow >> 1) & 7)) * 16)); sc = __builtin_amdgcn_mfma_f32_32x32x16_bf16(kf, qf[ks], sc, 0, 0, 0); }
        if (tt == 4) {
#pragma unroll
            for (int i = 0; i < 16; ++i) if (crow(i, hi) > r32) sc[i] = NEGBIG; }
        if (tt == 0) {
#pragma unroll
            for (int i = 0; i < 16; ++i) if (crow(i, hi) < r32) sc[i] = NEGBIG; }
        float tm = sc[0];
#pragma unroll
        for (int i = 1; i < 16; ++i) tm = fmaxf(tm, sc[i]);
        tm = fmaxf(tm, __shfl_xor(tm, 32));
        const float mn = fmaxf(mx, tm);
        if (tt != 4) { const float f = __builtin_amdgcn_exp2f(mx - mn); l *= f;
#pragma unroll
            for (int d = 0; d < 2; ++d)
#pragma unroll
                for (int i = 0; i < 16; ++i) o[d][i] *= f; }
        mx = mn;
#pragma unroll
        for (int i = 0; i < 16; ++i) { const float p = __builtin_amdgcn_exp2f(sc[i] - mx); sc[i] = p; l += p; }
#pragma unroll
        for (int s2 = 0; s2 < 2; ++s2) {
            u32x4 pw; pw.x = cvt_pk_bf16(sc[8 * s2 + 0], sc[8 * s2 + 1]); pw.y = cvt_pk_bf16(sc[8 * s2 + 2], sc[8 * s2 + 3]);
            pw.z = cvt_pk_bf16(sc[8 * s2 + 4], sc[8 * s2 + 5]); pw.w = cvt_pk_bf16(sc[8 * s2 + 6], sc[8 * s2 + 7]);
            const bf16x8 pf = __builtin_bit_cast(bf16x8, pw);
            const int kvr = 32 * (w + tt) + 16 * s2 + 4 * hi + q4;
#pragma unroll
            for (int d = 0; d < 2; ++d) {
                LAS const unsigned char* vp = Vl + kvr * 128 + ((d ^ ((q4 >> 1) & 1)) * 64) + 32 * blk + 8 * p4;
                const s16x4 lo = vtr(vp), hi4 = vtr(vp + 8 * 128);
                const bf16x8 vf = (bf16x8){lo[0], lo[1], lo[2], lo[3], hi4[0], hi4[1], hi4[2], hi4[3]};
                o[d] = __builtin_amdgcn_mfma_f32_32x32x16_bf16(vf, pf, o[d], 0, 0, 0);
            }
        }
    }
    l += __shfl_xor(l, 32);
    if (more) attn_load_q(proj, nxt, qf, lane, wid);
    const float lse = mx + __builtin_amdgcn_logf(l);
    const int tok = (nb * 128 + 32 * w + r32) * t.dil + t.r;
    const size_t qrow = (size_t)t.b * SEQ + tok, hrow = (size_t)(t.b * NH + t.h) * SEQ + tok;
    if (!FINAL) {
        const float c1 = 1.0f / l;
        if (hi == 0) lse23[(size_t)t.br * M * NH + hrow] = lse;
        bf16_t* ob = o23 + ((size_t)t.br * M * NH + hrow) * HD + 4 * hi;
#pragma unroll
        for (int d = 0; d < 2; ++d)
#pragma unroll
            for (int g = 0; g < 4; ++g) { u32x2 wv; wv.x = cvt_pk_bf16(o[d][4 * g] * c1, o[d][4 * g + 1] * c1); wv.y = cvt_pk_bf16(o[d][4 * g + 2] * c1, o[d][4 * g + 3] * c1); *(u32x2*)(ob + 32 * d + 8 * g) = wv; }
    } else {
        const float l2 = lse23[hrow], l3 = lse23[(size_t)M * NH + hrow];
        const float mm = fmaxf(lse, fmaxf(l2, l3));
        const float e1 = __builtin_amdgcn_exp2f(lse - mm), e2 = __builtin_amdgcn_exp2f(l2 - mm), e3 = __builtin_amdgcn_exp2f(l3 - mm);
        const float inv = 1.0f / (e1 + e2 + e3);
        const float c1 = e1 * inv / l, c2 = e2 * inv, c3 = e3 * inv;
        const bf16_t* o2 = o23 + hrow * HD + 4 * hi; const bf16_t* o3 = o2 + (size_t)M * AW;
        bf16_t* yo = ycat + qrow * DM + t.h * HD + 4 * hi;
#pragma unroll
        for (int d = 0; d < 2; ++d)
#pragma unroll
            for (int g = 0; g < 4; ++g) { const u32x2 a2 = *(const u32x2*)(o2 + 32 * d + 8 * g), a3 = *(const u32x2*)(o3 + 32 * d + 8 * g);
                u32x2 wv;
                wv.x = cvt_pk_bf16(c1 * o[d][4 * g] + c2 * bf_lo(a2.x) + c3 * bf_lo(a3.x), c1 * o[d][4 * g + 1] + c2 * bf_hi(a2.x) + c3 * bf_hi(a3.x));
                wv.y = cvt_pk_bf16(c1 * o[d][4 * g + 2] + c2 * bf_lo(a2.y) + c3 * bf_lo(a3.y), c1 * o[d][4 * g + 3] + c2 * bf_hi(a2.y) + c3 * bf_hi(a3.y));
                *(u32x2*)(yo + 32 * d + 8 * g) = wv; }
    }
}
template <bool FINAL>
__device__ __forceinline__ void attn_phase(LAS unsigned char* lds, const bf16_t* proj, bf16_t* o23, float* lse23, bf16_t* ycat, int tid, int lane, int wid) {
    constexpr int NR = FINAL ? 1024 : 2048;
    int R = blockIdx.x; if (R >= NR) return;
    u32x4 kv[8], vv[8]; bf16x8 qf[4];
    AttnItem cur = attn_decode<FINAL>(R, wid);
    attn_load(proj, cur, kv, vv, tid); attn_load_q(proj, cur, qf, lane, wid);
    for (;;) {
        attn_stage(lds, kv, vv, tid, wid);
        __syncthreads();
        const int Rn = R + gridDim.x; const bool more = Rn < NR;
        AttnItem nxt = cur;
        if (more) { nxt = attn_decode<FINAL>(Rn, wid); attn_load(proj, nxt, kv, vv, tid); }
        attn_compute<FINAL>(lds, proj, cur, nxt, more, qf, o23, lse23, ycat, lane, wid);
        __syncthreads();
        if (!more) break;
        cur = nxt; R = Rn;
    }
}
__device__ __forceinline__ void conv_phase(const bf16_t* proj, bf16_t* ycat, const float* cw, const float* cb, int tid) {
    const int c0 = (tid & 63) * 8;
    float w0[8], w1[8], w2[8], bb[8];
#pragma unroll
    for (int e = 0; e < 8; ++e) { w0[e] = cw[c0 + e]; w1[e] = cw[AW + c0 + e]; w2[e] = cw[2 * AW + c0 + e]; bb[e] = cb[c0 + e]; }
    for (int chunk = (blockIdx.x * NTHR + tid) >> 6; chunk < M / 16; chunk += (gridDim.x * NTHR) >> 6) {
        const int row0 = chunk * 16, t0 = row0 & (SEQ - 1);
        float p1[8], p2[8];
#pragma unroll
        for (int e = 0; e < 8; ++e) { p1[e] = 0.f; p2[e] = 0.f; }
        if (t0 >= 2) {
            const bf16_t* p = proj + (size_t)(row0 - 2) * 1536 + c0;
            const u32x4 ga = *(const u32x4*)(p + 512), ua = *(const u32x4*)(p + 1024), gb1 = *(const u32x4*)(p + 1536 + 512), ub1 = *(const u32x4*)(p + 1536 + 1024);
#pragma unroll
            for (int e = 0; e < 4; ++e) { p2[2 * e] = bf_lo(ga[e]) * bf_lo(ua[e]); p2[2 * e + 1] = bf_hi(ga[e]) * bf_hi(ua[e]); p1[2 * e] = bf_lo(gb1[e]) * bf_lo(ub1[e]); p1[2 * e + 1] = bf_hi(gb1[e]) * bf_hi(ub1[e]); }
        }
#pragma unroll 4
        for (int rr = 0; rr < 16; ++rr) {
            const bf16_t* p = proj + (size_t)(row0 + rr) * 1536 + c0;
            const u32x4 gb = *(const u32x4*)p, gc = *(const u32x4*)(p + 512), uu = *(const u32x4*)(p + 1024);
            float p0[8], y[8];
#pragma unroll
            for (int e = 0; e < 4; ++e) { p0[2 * e] = bf_lo(gc[e]) * bf_lo(uu[e]); p0[2 * e + 1] = bf_hi(gc[e]) * bf_hi(uu[e]); }
#pragma unroll
            for (int e = 0; e < 8; ++e) y[e] = w2[e] * p0[e] + w1[e] * p1[e] + w0[e] * p2[e] + bb[e];
            u32x4 o;
#pragma unroll
            for (int e = 0; e < 4; ++e) o[e] = cvt_pk_bf16(bf_lo(gb[e]) * y[2 * e], bf_hi(gb[e]) * y[2 * e + 1]);
            *(u32x4*)(ycat + (size_t)(row0 + rr) * DM + AW + c0) = o;
#pragma unroll
            for (int e = 0; e < 8; ++e) { p2[e] = p1[e]; p1[e] = p0[e]; }
        }
    }
}


#define XB_TMO      128
#define XB_XCNT(j)  (256  + 64 * (j))
#define XB_XSUB(j)  (1280 + 64 * (j))
#define XB_XGEN(j)  (2304 + 64 * (j))
#define XB_TOP      3328
#define XB_TOPGEN   3392
#define XCD_BAR_WORDS 3456
#define XB_SPIN_CAP (1u << 18)

__device__ __forceinline__ unsigned xb_ld(unsigned* p)              { return __hip_atomic_load(p, __ATOMIC_RELAXED, __HIP_MEMORY_SCOPE_AGENT); }
__device__ __forceinline__ unsigned xb_add(unsigned* p, unsigned v) { return __hip_atomic_fetch_add(p, v, __ATOMIC_RELAXED, __HIP_MEMORY_SCOPE_AGENT); }
__device__ __forceinline__ unsigned xb_xcc_id() { return (unsigned)__builtin_amdgcn_s_getreg((3 << 11) | 20) & 0xFu; }
#define XB_SPIN(cond, bar) do { unsigned _sp = 0; while (cond) { __builtin_amdgcn_s_sleep(1); \
    if ((++_sp & 255u) == 0u) { if (xb_ld(&(bar)[XB_TMO])) break; if (_sp > XB_SPIN_CAP) { atomicAdd(&(bar)[XB_TMO], 1u); break; } } } } while (0)

struct XcdBarrier {
    unsigned* bar; unsigned x;
    volatile LAS unsigned* st;
};

__device__ __forceinline__ XcdBarrier xcd_barrier_post(unsigned* bar, volatile LAS unsigned* st) {
    XcdBarrier b; b.bar = bar; b.x = xb_xcc_id(); b.st = st;
    if (threadIdx.x == 0) (void)xb_add(&bar[XB_XCNT(b.x)], 1u);
    return b;
}
__device__ __forceinline__ void xcd_barrier_complete(unsigned* bar, unsigned x, unsigned& nloc, unsigned& nx) {
    const unsigned G = gridDim.x * gridDim.y * gridDim.z;
    unsigned sum, cnt, mine, sp = 0u;
    for (;;) {
        sum = 0u; cnt = 0u; mine = 0u;
#pragma unroll
        for (unsigned j = 0; j < 16; ++j) { const unsigned c = xb_ld(&bar[XB_XCNT(j)]); sum += c; cnt += (c > 0u) ? 1u : 0u; mine = (j == x) ? c : mine; }
        if (sum == G) break;
        __builtin_amdgcn_s_sleep(1);
        if ((++sp & 255u) == 0u) { if (xb_ld(&bar[XB_TMO])) break; if (sp > XB_SPIN_CAP) { atomicAdd(&bar[XB_TMO], 1u); break; } }
    }
    nloc = mine > 0u ? mine : 1u; nx = cnt > 0u ? cnt : 1u;
}

__device__ __forceinline__ void xcd_barrier(const XcdBarrier& b) {
    asm volatile("s_waitcnt vmcnt(0)" ::: "memory");
    __syncthreads();
    if (threadIdx.x == 0) {
        unsigned* bar = b.bar;
        __builtin_amdgcn_s_waitcnt(0);
        unsigned nloc = b.st[0], nx = b.st[1];
        if (nloc == 0u) { xcd_barrier_complete(bar, b.x, nloc, nx); b.st[0] = nloc; b.st[1] = nx; }
        const unsigned old = xb_add(&bar[XB_XSUB(b.x)], 1u);
        const unsigned gen = old / nloc;
        if (old + 1u == (gen + 1u) * nloc) {
            __builtin_amdgcn_fence(__ATOMIC_RELEASE, "agent");
            asm volatile("s_waitcnt vmcnt(0)" ::: "memory");
            const unsigned og = xb_add(&bar[XB_TOP], 1u);
            const unsigned tg = og / nx;
            if (og + 1u == (tg + 1u) * nx) xb_add(&bar[XB_TOPGEN], 1u);
            else XB_SPIN(xb_ld(&bar[XB_TOPGEN]) == tg, bar);
            __builtin_amdgcn_fence(__ATOMIC_ACQUIRE, "agent");
            xb_add(&bar[XB_XGEN(b.x)], 1u);
            asm volatile("s_waitcnt vmcnt(0)" ::: "memory");
        } else {
            XB_SPIN(xb_ld(&bar[XB_XGEN(b.x)]) == gen, bar);
            __builtin_amdgcn_fence(__ATOMIC_ACQUIRE, "agent");
            asm volatile("s_waitcnt vmcnt(0)" ::: "memory");
        }
    }
    __syncthreads();
}

#ifndef MK_MULTI
#define MK_MULTI 0
#endif
constexpr int N_PHASES = 1 + 11 * DEPTH;
#ifndef PROBE_DUP_MASK
#define PROBE_DUP_MASK 0
#endif
struct Args { In in; float* out; unsigned char* ws; int ph_lo, ph_hi; };
static_assert(sizeof(Args) == 15 * 8 + 8, "Args has no padding");

__global__ void __launch_bounds__(NTHR, 2) fwd_megakernel(Args a) {
    extern __shared__ __attribute__((aligned(16))) unsigned char lds_raw[];
    LAS unsigned char* lds = (LAS unsigned char*)lds_raw;
    cg::grid_group grid = cg::this_grid();
    const int wave0 = __builtin_amdgcn_readfirstlane(threadIdx.x >> 6);
    unsigned char* ws = a.ws;
    volatile LAS unsigned* MISC = (volatile LAS unsigned*)(lds + MISC_OFF);
    if (threadIdx.x < 16) MISC[threadIdx.x] = 0u;
    __syncthreads();
    XcdBarrier bar; bar.bar = (unsigned*)(ws + WS_CTL); bar.x = 0; bar.st = nullptr;
    if (a.ph_hi - a.ph_lo > 1) bar = xcd_barrier_post((unsigned*)(ws + WS_CTL), MISC + 8);
    float* mod = (float*)(ws + WS_MOD);
    bf16_t* Hb = (bf16_t*)(ws + WS_H); bf16_t* YC = (bf16_t*)(ws + WS_YC); bf16_t* ACT = (bf16_t*)(ws + WS_ACT);
    bf16_t* QKVb = (bf16_t*)(ws + WS_QKV);
    bf16_t* O23 = (bf16_t*)(ws + WS_O23); float* LSE = (float*)(ws + WS_LSE);
    for (int ph_ = a.ph_lo; ph_ < a.ph_hi; ++ph_) {
        int ph = ph_; asm volatile("" : "+s"(ph));
        int nrep = ((PROBE_DUP_MASK >> (ph == 0 ? 11 : (ph - 1) % 11)) & 1) + 1; asm volatile("" : "+s"(nrep));
        for (int rep = 0; rep < nrep; ++rep) {
        asm volatile("" : "+s"(ph));
        int wave = wave0; asm volatile("" : "+s"(wave));
        int lane = (int)__builtin_amdgcn_mbcnt_hi(~0u, __builtin_amdgcn_mbcnt_lo(~0u, 0u)); asm volatile("" : "+v"(lane));
        const int tid = wave * 64 + lane;
        if (ph == 0) { prologue(a.in, ws, lds, tid, lane, wave); }
        else {
            const int q = ph - 1, L = q / 11, k = q % 11;
            unsigned char* lw = ws + WS_W + (size_t)L * LW_BYTES;
            const float* lmod = mod + (size_t)L * NB * MODW;
            const float* xcur = (L == 0 && k <= 2) ? a.in.x : a.out;
            if (k == 0 || k == 3 || k == 8) {
                const int sub = k == 0 ? 0 : (k == 3 ? 1 : 2);
                norm_phase(xcur, Hb, a.in.norm_g + (size_t)(L * 3 + sub) * DM, lmod + sub * 3 * DM, lane, wave);
            } else if (k == 1 || k == 9) {
                const int f = k == 9;
                pg8::Gemm g{Hb, (const bf16_t*)(lw + LW_W1 + f * W1_BYTES), M, 2 * FF, DM}; pg8::StaticOrder S; S.init(M, 2 * FF, gridDim.x, blockIdx.x);
                pg8::EpiSwiglu E{ACT, FF};
                pg8::gemm_phase<pg8::EpiSwiglu, pg8::StaticOrder, true, true>(lds, tid, g, S, E);
            } else if (k == 2 || k == 10 || k == 7) {
                const int f = k == 10, sub = k == 2 ? 0 : (k == 7 ? 1 : 2);
                const bf16_t* A = k == 7 ? YC : ACT; const bf16_t* Bt = k == 7 ? (const bf16_t*)(lw + LW_WOUT) : (const bf16_t*)(lw + LW_W2 + f * W2_BYTES);
                pg8::Gemm g{A, Bt, M, DM, k == 7 ? DM : FF}; pg8::StaticOrder S; S.init(M, DM, gridDim.x, blockIdx.x);
                pg8::EpiResid E{xcur, a.out, lmod + sub * 3 * DM + 2 * DM, MODW, 13, k == 7 ? 1.0f : 0.5f};
                pg8::gemm_phase<pg8::EpiResid, pg8::StaticOrder, true, true>(lds, tid, g, S, E);
            } else if (k == 4) {
                pg8::Gemm g{Hb, (const bf16_t*)(lw + LW_WIN), M, INC, DM}; pg8::StaticOrder S; S.init(M, INC, gridDim.x, blockIdx.x);
                pg8::EpiWin E{ACT, 1536, QKVb, a.in.q_g + L * HD, a.in.k_g + L * HD, QSCALE};
                pg8::gemm_phase<pg8::EpiWin, pg8::StaticOrder, true, true>(lds, tid, g, S, E);
            } else if (k == 5) {
                attn_phase<false>(lds, QKVb, O23, LSE, nullptr, tid, lane, wave);
            } else {
                attn_phase<true>(lds, QKVb, O23, LSE, YC, tid, lane, wave);
                conv_phase(ACT, YC, a.in.conv_w + (size_t)L * 3 * AW, a.in.conv_b + (size_t)L * AW, tid);
            }
        }
        __syncthreads(); }
        if (ph_ + 1 < a.ph_hi) { if (ph_ == 0) grid.sync(); else xcd_barrier(bar); }
    }
}

extern "C" void kernel_launch(void* const* d_in, const int* in_sizes, int n_in, void* d_out, int out_size, void* d_ws, size_t ws_size, hipStream_t stream) {
    static int grid_blocks = 0;
    if (grid_blocks == 0) {
        if (n_in != 13 || in_sizes[0] != M * DM || out_size != M * DM || ws_size < WS_END) { fprintf(stderr, "kernel_launch: unexpected shapes (n_in %d, in0 %d, out %d, ws %zu)\n", n_in, n_in > 0 ? in_sizes[0] : -1, out_size, ws_size); grid_blocks = -1; return; }
        int dev = 0, cus = 0, per_cu = 0;
        hipGetDevice(&dev);
        hipDeviceGetAttribute(&cus, hipDeviceAttributeMultiprocessorCount, dev);
        if (hipFuncSetAttribute((const void*)fwd_megakernel, hipFuncAttributeMaxDynamicSharedMemorySize, LDS_BYTES) != hipSuccess) fprintf(stderr, "kernel_launch: hipFuncSetAttribute failed\n");
        if (hipOccupancyMaxActiveBlocksPerMultiprocessor(&per_cu, (const void*)fwd_megakernel, NTHR, LDS_BYTES) != hipSuccess || per_cu < 1) { fprintf(stderr, "kernel_launch: occupancy query says %d\n", per_cu); per_cu = 1; }
        (void)hipGetLastError();
        grid_blocks = cus * per_cu;
    }
    if (grid_blocks < 0) return;
    Args a{};
    const float** ip = (const float**)&a.in;
    for (int i = 0; i < 13; ++i) ip[i] = (const float*)d_in[i];
    a.out = (float*)d_out; a.ws = (unsigned char*)d_ws;
    if (hipMemsetAsync((char*)d_ws + WS_CTL, 0, CTL_BYTES, stream) != hipSuccess) { fprintf(stderr, "kernel_launch: memset failed\n"); return; }
#if MK_MULTI
    for (int ph = 0; ph < N_PHASES; ++ph) { a.ph_lo = ph; a.ph_hi = ph + 1; hipLaunchKernelGGL(fwd_megakernel, dim3(grid_blocks), dim3(NTHR), LDS_BYTES, stream, a); }
#else
    a.ph_lo = 0; a.ph_hi = N_PHASES;
    void* args[] = {&a};
    hipError_t e = hipLaunchCooperativeKernel((const void*)fwd_megakernel, dim3(grid_blocks), dim3(NTHR), args, LDS_BYTES, stream);
    if (e != hipSuccess) fprintf(stderr, "cooperative launch failed: %s (grid %d)\n", hipGetErrorString(e), grid_blocks);
#endif
}
```

```cpp
#include <hip/hip_runtime.h>
#include <hip/hip_cooperative_groups.h>
#include <cstdio>
#include <cstdint>
namespace cg = cooperative_groups;
namespace pg8 {
#define PG8_LAS __attribute__((address_space(3)))
typedef unsigned short bf16_t;
typedef short bf16x8 __attribute__((ext_vector_type(8)));
typedef float f32x4 __attribute__((ext_vector_type(4)));
typedef unsigned u32x4 __attribute__((ext_vector_type(4)));
constexpr int BM = 256, BK = 64, HALF = 128, HTB = HALF * BK * 2  , STAGE_BYTES = 8 * HTB, NXCD = 8, WGM = 8;

__host__ __device__ __forceinline__ int lds_byte(int r, int c) { const int st = (r >> 4) * 2 + (c >> 5), rr = r & 15, cc = c & 31, ob = rr * 64 + cc * 2; return st * 1024 + (ob ^ (((ob >> 9) & 1) << 5)); }
__host__ __device__ __forceinline__ void stage_rc(int b, int& R, int& C) { const int st = b / 1024, sb = b % 1024, swz = sb ^ (((sb >> 9) & 1) << 5); R = (st >> 1) * 16 + swz / 64; C = (st & 1) * 32 + (swz % 64) / 2; }
__host__ __device__ __forceinline__ int perm32(int rho) { const int n = rho >> 4, i = rho & 15; return 8 * (i >> 2) + 4 * n + (i & 3); }

struct Unit { int pm, pn; };
struct Gemm { const bf16_t* A; const bf16_t* Bt; int M, N, K; };

struct StaticOrder {
    int nM, nN, nwg, G, c;
    __host__ __device__ void init(int M, int N, int G_, int c_) { nM = M / BM; nN = N / BM; nwg = nM * nN; G = G_; c = c_; }
    __host__ __device__ bool next(int i, Unit& u) const {
        const long L = (long)i * G + c; if (L >= nwg) return false;
        int wgid = (int)L; { const int q = nwg / NXCD, r = nwg % NXCD, xcd = wgid % NXCD, off = wgid / NXCD; wgid = (xcd < r ? xcd * (q + 1) : r * (q + 1) + (xcd - r) * q) + off; }
        const int nig = WGM * nN, gid = wgid / nig, fm = gid * WGM, gsz = (nM - fm) < WGM ? (nM - fm) : WGM;
        u.pm = fm + ((wgid % nig) % gsz); u.pn = (wgid % nig) / gsz; return true;
    }
    __device__ __forceinline__ void a_ready(const Unit&) const {}
    __device__ __forceinline__ void done(const Unit&) const {}
};

typedef unsigned u32x2 __attribute__((ext_vector_type(2)));
__device__ __forceinline__ unsigned cvt_pk_bf16(float lo, float hi) { typedef float f2 __attribute__((ext_vector_type(2))); typedef __bf16 b2 __attribute__((ext_vector_type(2)));
    f2 v = {lo, hi}; b2 b = __builtin_convertvector(v, b2); return __builtin_bit_cast(unsigned, b); }
__device__ __forceinline__ float silu_f(float g) { return g * __builtin_amdgcn_rcpf(1.0f + __builtin_amdgcn_exp2f(-1.4426950408889634f * g)); }

struct EpiSwiglu {
    static constexpr bool PERM = true, AFTER_DRAIN = false;
    bf16_t* O; int ldc;
    const float* rss; const float* sw;
    __device__ __forceinline__ void operator()(const f32x4 (&acc)[2][2][4][2], const Unit& u, int wr, int wc, int fr, int fq) const {
        const int row0 = u.pm * BM + wr * 64 + fr, col0 = u.pn * HALF + wc * 32 + 8 * fq;
        const float* swp = sw + (size_t)((u.pm * BM) >> 13) * (2 * 2816) + u.pn * BM + wc * 32 + 8 * fq;
        f32x4 sv[2][2];
#pragma unroll
        for (int bj = 0; bj < 2; ++bj)
#pragma unroll
            for (int n = 0; n < 2; ++n) sv[bj][n] = *(const f32x4*)(swp + bj * HALF + 4 * n);
#pragma unroll
        for (int ai = 0; ai < 2; ++ai)
#pragma unroll
            for (int m = 0; m < 4; ++m) {
                const float rs = __builtin_amdgcn_rsqf(rss[row0 + ai * HALF + m * 16] * (1.0f / 1024.0f) + 1e-6f);
                const f32x4 g0 = acc[ai][0][m][0] * rs + sv[0][0], g1 = acc[ai][0][m][1] * rs + sv[0][1], u0 = acc[ai][1][m][0] * rs + sv[1][0], u1 = acc[ai][1][m][1] * rs + sv[1][1];
                u32x4 w;
                w.x = cvt_pk_bf16(silu_f(g0[0]) * u0[0], silu_f(g0[1]) * u0[1]); w.y = cvt_pk_bf16(silu_f(g0[2]) * u0[2], silu_f(g0[3]) * u0[3]);
                w.z = cvt_pk_bf16(silu_f(g1[0]) * u1[0], silu_f(g1[1]) * u1[1]); w.w = cvt_pk_bf16(silu_f(g1[2]) * u1[2], silu_f(g1[3]) * u1[3]);
                *(u32x4*)(O + (size_t)(row0 + ai * HALF + m * 16) * ldc + col0) = w;
            }
    }
};
struct EpiWin {
    static constexpr bool PERM = true, AFTER_DRAIN = false;
    bf16_t* O; int ldc; bf16_t* QKV; const float* qg; const float* kg; float qscale; const float* rss; const float* sw;
    __device__ __forceinline__ void operator()(const f32x4 (&acc)[2][2][4][2], const Unit& u, int wr, int wc, int fr, int fq) const {
        const int row0 = u.pm * BM + wr * 64 + fr, col0 = u.pn * BM + wc * 64 + 8 * fq;
        const int kind = u.pn < 2 ? 1 : (u.pn < 4 ? 2 : 0);
        f32x4 gv[2][2];
#pragma unroll
        for (int bj = 0; bj < 2; ++bj)
#pragma unroll
            for (int n = 0; n < 2; ++n) gv[bj][n] = kind ? *(const f32x4*)((kind == 1 ? qg : kg) + 32 * bj + 8 * fq + 4 * n) : (f32x4){1.f, 1.f, 1.f, 1.f};
        const float ks = kind == 1 ? qscale : 1.0f;
        const float* swp = sw + (size_t)((u.pm * BM) >> 13) * (2 * 2816) + u.pn * BM + wc * 32 + 8 * fq;
        f32x4 sv[2][2];
#pragma unroll
        for (int bj = 0; bj < 2; ++bj)
#pragma unroll
            for (int n = 0; n < 2; ++n) sv[bj][n] = *(const f32x4*)(swp + bj * HALF + 4 * n);
#pragma unroll
        for (int ai = 0; ai < 2; ++ai)
#pragma unroll
            for (int m = 0; m < 4; ++m) {
                const float rn = __builtin_amdgcn_rsqf(rss[row0 + ai * HALF + m * 16] * (1.0f / 1024.0f) + 1e-6f);
                f32x4 hv[2][2];
#pragma unroll
                for (int bj = 0; bj < 2; ++bj)
#pragma unroll
                    for (int n = 0; n < 2; ++n) hv[bj][n] = acc[ai][bj][m][n] * rn + sv[bj][n];
                float rs = 1.0f;
                if (kind) {
                    float ss = 0.f;
#pragma unroll
                    for (int bj = 0; bj < 2; ++bj)
#pragma unroll
                        for (int n = 0; n < 2; ++n) { const f32x4 x = hv[bj][n]; ss += (x[0] * x[0] + x[1] * x[1]) + (x[2] * x[2] + x[3] * x[3]); }
                    ss += __shfl_xor(ss, 16); ss += __shfl_xor(ss, 32);
                    rs = ks * __builtin_amdgcn_rsqf(ss * (1.0f / 64.0f) + 1e-6f);
                }
                const int row = row0 + ai * HALF + m * 16;
                bf16_t* rowp = u.pn < 6 ? QKV + ((size_t)(((u.pn >> 1) * 4 + (row >> 13)) * 8 + (u.pn & 1) * 4 + wc) * 8192 + (row & 8191)) * 64 + 8 * fq
                                        : O + (size_t)row * ldc + (col0 - 1536);
#pragma unroll
                for (int bj = 0; bj < 2; ++bj) {
                    const f32x4 v0 = hv[bj][0] * (gv[bj][0] * rs), v1 = hv[bj][1] * (gv[bj][1] * rs);
                    u32x4 w; w.x = cvt_pk_bf16(v0[0], v0[1]); w.y = cvt_pk_bf16(v0[2], v0[3]); w.z = cvt_pk_bf16(v1[0], v1[1]); w.w = cvt_pk_bf16(v1[2], v1[3]);
                    *(u32x4*)(rowp + 32 * bj) = w;
                }
            }
    }
};
struct EpiResid {
    static constexpr bool PERM = false, AFTER_DRAIN = false;
    struct P { const float* xin; float* out; const float* gate; bf16_t* xg; float* rss; const float* ng; const float* nmod; float gs; int has; };
    const PG8_LAS P* pp;
    __device__ __forceinline__ void operator()(const f32x4 (&acc)[2][2][4][2], const Unit& u, int wr, int wc, int fr, int fq) const {
        const float* xin = pp->xin; float* out = pp->out; const float* gate = pp->gate; bf16_t* xg = pp->xg; float* rss = pp->rss; const float* ng = pp->ng; const float* nmod = pp->nmod;
        const float gs = pp->gs; const int has = pp->has;
        const int b = (u.pm * BM) >> 13;
        const float* gp = gate + (size_t)b * 9216;
        const int row0 = u.pm * BM + wr * 64 + fr, col0 = u.pn * BM + wc * 32 + 4 * fq;
        f32x4 gv[2][2], Gn[2][2];
#pragma unroll
        for (int bj = 0; bj < 2; ++bj)
#pragma unroll
            for (int n = 0; n < 2; ++n) { gv[bj][n] = *(const f32x4*)(gp + col0 + bj * HALF + n * 16) * gs;
                Gn[bj][n] = *(const f32x4*)(ng + col0 + bj * HALF + n * 16) * (*(const f32x4*)(nmod + (size_t)b * 9216 + 1024 + col0 + bj * HALF + n * 16) + 1.0f); }
#pragma unroll
        for (int ai = 0; ai < 2; ++ai)
#pragma unroll
            for (int m = 0; m < 4; ++m) { const int row = row0 + ai * HALF + m * 16; const size_t off = (size_t)row * 1024 + col0; float ss = 0.f;
#pragma unroll
                for (int bj = 0; bj < 2; ++bj)
#pragma unroll
                    for (int n = 0; n < 2; ++n) { const f32x4 xv = *(const f32x4*)(xin + off + bj * HALF + n * 16); const f32x4 o = xv + gv[bj][n] * acc[ai][bj][m][n];
                        *(f32x4*)(out + off + bj * HALF + n * 16) = o;
                        if (has) { const f32x4 y = o * Gn[bj][n]; u32x2 w; w.x = cvt_pk_bf16(y[0], y[1]); w.y = cvt_pk_bf16(y[2], y[3]); *(u32x2*)(xg + off + bj * HALF + n * 16) = w;
                            ss += (o[0] * o[0] + o[1] * o[1]) + (o[2] * o[2] + o[3] * o[3]); } }
                if (has) { ss += __shfl_xor(ss, 16); ss += __shfl_xor(ss, 32);
                    if (fq == 0) __hip_atomic_fetch_add(rss + row, ss, __ATOMIC_RELAXED, __HIP_MEMORY_SCOPE_AGENT); } }
    }
};
template <class Epi, class Sched, bool ALIGN_EPI = false, bool SP2 = false>
__device__ __forceinline__ void gemm_phase(PG8_LAS unsigned char* lds, const int tid, const Gemm g, const Sched& S, const Epi& E) {
    const int wid = __builtin_amdgcn_readfirstlane(tid >> 6), lane = tid & 63, wr = wid >> 2, wc = wid & 3, fr = lane & 15, fq = lane >> 4;
    const int K = g.K, nt = K / BK;
    unsigned voffA[2], voffB[2];
#pragma unroll
    for (int i = 0; i < 2; ++i) { int R, C; stage_rc(tid * 16 + i * 8192, R, C); const int Rb = Epi::PERM ? ((R & ~31) + perm32(R & 31)) : R;
        voffA[i] = (unsigned)(R * K + C) * 2u; voffB[i] = (unsigned)(Rb * K + C) * 2u; }
    const size_t kstep = (size_t)(BK * 2);
    const size_t hstep = (size_t)HALF * K * 2;
    const size_t tstep = 2 * hstep;
    const unsigned ldsw = (unsigned)wid * 1024u;
    const int aoff = lds_byte(wr * 64 + fr, fq * 8), boff = lds_byte(wc * 32 + fr, fq * 8);
#define PG8_SA(b, h) (((b) * 2 + (h)) * HTB)
#define PG8_SB(b, h) ((4 + (b) * 2 + (h)) * HTB)
#define PG8_STAGE(bufoff, gbase, voff) do { _Pragma("unroll") for (int _i = 0; _i < 2; ++_i) \
        __builtin_amdgcn_global_load_lds((const unsigned*)((const char*)(gbase) + (voff)[_i]), (PG8_LAS unsigned*)(lds + (bufoff) + ldsw + _i * 8192), 16, 0, 0); } while (0)
#define PG8_LDA(dst, b, h) do { _Pragma("unroll") for (int m = 0; m < 4; ++m) _Pragma("unroll") for (int k = 0; k < 2; ++k) dst[m][k] = *(const PG8_LAS bf16x8*)(lds + PG8_SA(b, h) + aoff + m * 2048 + k * 1024); } while (0)
#define PG8_LDB(dst, b, h) do { _Pragma("unroll") for (int n = 0; n < 2; ++n) _Pragma("unroll") for (int k = 0; k < 2; ++k) dst[n][k] = *(const PG8_LAS bf16x8*)(lds + PG8_SB(b, h) + boff + n * 2048 + k * 1024); } while (0)
#define PG8_MMA(ai, bj, At, Bt) do { __builtin_amdgcn_s_setprio(1); _Pragma("unroll") for (int m = 0; m < 4; ++m) _Pragma("unroll") for (int n = 0; n < 2; ++n) _Pragma("unroll") for (int k = 0; k < 2; ++k) \
        acc[ai][bj][m][n] = __builtin_amdgcn_mfma_f32_16x16x32_bf16(Bt[n][k], At[m][k], acc[ai][bj][m][n], 0, 0, 0); __builtin_amdgcn_s_setprio(0); } while (0)
#define PG8_WAIT_V(n) asm volatile("s_waitcnt vmcnt(" #n ")" ::: "memory")
#define PG8_WAIT_L(n) asm volatile("s_waitcnt lgkmcnt(" #n ")" ::: "memory")
#define PG8_BAR __builtin_amdgcn_s_barrier()
#define PG8_SCHED __builtin_amdgcn_sched_barrier(0)
    Unit cur, nxt; int ui = 0;
    if (!S.next(0, cur)) return;
    f32x4 acc[2][2][4][2];
#pragma unroll
    for (int a = 0; a < 2; ++a)
#pragma unroll
        for (int b = 0; b < 2; ++b)
#pragma unroll
            for (int m = 0; m < 4; ++m)
#pragma unroll
                for (int n = 0; n < 2; ++n) acc[a][b][m][n] = (f32x4){0.f, 0.f, 0.f, 0.f};
    bf16x8 At[4][2], B0[2][2], B1[2][2];
    const char* cA = (const char*)g.A + (size_t)cur.pm * tstep; const char* cB = (const char*)g.Bt + (size_t)cur.pn * tstep;
    S.a_ready(cur);
    if constexpr (SP2) {
        PG8_STAGE(PG8_SB(0, 0), cB, voffB); PG8_STAGE(PG8_SB(0, 1), cB + hstep, voffB); PG8_STAGE(PG8_SA(0, 0), cA, voffA); PG8_STAGE(PG8_SA(0, 1), cA + hstep, voffA);
        if (wr == 1) PG8_BAR;
        PG8_WAIT_V(2); PG8_BAR;
        PG8_STAGE(PG8_SB(1, 0), cB + kstep, voffB); PG8_STAGE(PG8_SA(1, 0), cA + kstep, voffA); PG8_STAGE(PG8_SB(1, 1), cB + hstep + kstep, voffB);
        PG8_WAIT_V(6); PG8_BAR;
    } else {
        PG8_STAGE(PG8_SB(0, 0), cB, voffB); PG8_STAGE(PG8_SA(0, 0), cA, voffA); PG8_STAGE(PG8_SB(0, 1), cB + hstep, voffB); PG8_STAGE(PG8_SA(0, 1), cA + hstep, voffA);
        if (wr == 1) PG8_BAR;
        PG8_WAIT_V(4); PG8_BAR;
        PG8_STAGE(PG8_SB(1, 0), cB + kstep, voffB); PG8_STAGE(PG8_SA(1, 0), cA + kstep, voffA); PG8_STAGE(PG8_SB(1, 1), cB + hstep + kstep, voffB);
        PG8_WAIT_V(6); PG8_BAR;
    }
    for (;;) {
        const bool has_next = S.next(ui + 1, nxt);
        const char* nA = has_next ? (const char*)g.A + (size_t)nxt.pm * tstep : cA; const char* nB = has_next ? (const char*)g.Bt + (size_t)nxt.pn * tstep : cB;
        for (int t = 0; t < nt; t += 2) {
            const bool last = (t == nt - 2);
            const char* a1 = cA + (size_t)(t + 1) * kstep;
            const char* a2 = last ? nA : cA + (size_t)(t + 2) * kstep; const char* b2 = last ? nB : cB + (size_t)(t + 2) * kstep;
            const char* a3 = a2 + kstep; const char* b3 = b2 + kstep;
            if (last && has_next) S.a_ready(nxt);
            if constexpr (SP2) {
            PG8_LDB(B0, 0, 0); PG8_LDB(B1, 0, 1); PG8_SCHED; PG8_LDA(At, 0, 0); PG8_STAGE(PG8_SA(1, 1), a1 + hstep, voffA);
            PG8_WAIT_V(8); PG8_WAIT_L(0); PG8_BAR; PG8_MMA(0, 0, At, B0); PG8_MMA(0, 1, At, B1); PG8_BAR; PG8_SCHED;
            PG8_LDA(At, 0, 1); PG8_STAGE(PG8_SB(0, 0), b2, voffB); PG8_STAGE(PG8_SB(0, 1), b2 + hstep, voffB); PG8_STAGE(PG8_SA(0, 0), a2, voffA);
            PG8_WAIT_V(8); PG8_WAIT_L(0); PG8_BAR; PG8_MMA(1, 0, At, B0); PG8_MMA(1, 1, At, B1); PG8_BAR; PG8_SCHED;
            PG8_LDB(B0, 1, 0); PG8_LDB(B1, 1, 1); PG8_SCHED; PG8_LDA(At, 1, 0); PG8_STAGE(PG8_SA(0, 1), a2 + hstep, voffA);
            PG8_WAIT_V(8); PG8_WAIT_L(0); PG8_BAR; PG8_MMA(0, 0, At, B0); PG8_MMA(0, 1, At, B1); PG8_BAR; PG8_SCHED;
            PG8_LDA(At, 1, 1); PG8_STAGE(PG8_SB(1, 0), b3, voffB); PG8_STAGE(PG8_SB(1, 1), b3 + hstep, voffB); PG8_STAGE(PG8_SA(1, 0), a3, voffA);
            PG8_WAIT_V(8); PG8_WAIT_L(0); PG8_BAR; PG8_MMA(1, 0, At, B0); PG8_MMA(1, 1, At, B1); PG8_BAR; PG8_SCHED;
            } else {
            PG8_LDB(B0, 0, 0); PG8_SCHED; PG8_LDA(At, 0, 0); PG8_STAGE(PG8_SA(1, 1), a1 + hstep, voffA);
            PG8_WAIT_L(8); PG8_BAR; PG8_WAIT_L(0); PG8_MMA(0, 0, At, B0); PG8_BAR; PG8_SCHED;
            PG8_LDB(B1, 0, 1); PG8_STAGE(PG8_SB(0, 0), b2, voffB);
            PG8_BAR; PG8_WAIT_L(0); PG8_MMA(0, 1, At, B1); PG8_BAR;
            PG8_LDA(At, 0, 1); PG8_STAGE(PG8_SA(0, 0), a2, voffA);
            PG8_BAR; PG8_WAIT_L(0); PG8_MMA(1, 0, At, B0); PG8_BAR; PG8_SCHED;
            PG8_STAGE(PG8_SB(0, 1), b2 + hstep, voffB);
            PG8_WAIT_V(6); PG8_BAR; PG8_MMA(1, 1, At, B1); PG8_BAR;
            PG8_LDB(B0, 1, 0); PG8_SCHED; PG8_LDA(At, 1, 0); PG8_STAGE(PG8_SA(0, 1), a2 + hstep, voffA);
            PG8_WAIT_L(8); PG8_BAR; PG8_WAIT_L(0); PG8_MMA(0, 0, At, B0); PG8_BAR; PG8_SCHED;
            PG8_LDB(B1, 1, 1); PG8_STAGE(PG8_SB(1, 0), b3, voffB);
            PG8_BAR; PG8_WAIT_L(0); PG8_MMA(0, 1, At, B1); PG8_BAR;
            PG8_LDA(At, 1, 1); PG8_STAGE(PG8_SA(1, 0), a3, voffA);
            PG8_BAR; PG8_WAIT_L(0); PG8_MMA(1, 0, At, B0); PG8_BAR; PG8_SCHED;
            PG8_STAGE(PG8_SB(1, 1), b3 + hstep, voffB);
            PG8_WAIT_V(6); PG8_BAR; PG8_MMA(1, 1, At, B1); PG8_BAR;
            }
        }
        if constexpr (ALIGN_EPI) { if (wr == 0) PG8_BAR; }
        if constexpr (!Epi::AFTER_DRAIN) { E(acc, cur, wr, wc, fr, fq); S.done(cur); }
        if (!has_next) break;
#pragma unroll
        for (int a = 0; a < 2; ++a)
#pragma unroll
            for (int b = 0; b < 2; ++b)
#pragma unroll
                for (int m = 0; m < 4; ++m)
#pragma unroll
                    for (int n = 0; n < 2; ++n) acc[a][b][m][n] = (f32x4){0.f, 0.f, 0.f, 0.f};
        cur = nxt; cA = nA; cB = nB; ++ui;
        if constexpr (ALIGN_EPI) { if (wr == 1) PG8_BAR; }
    }
    PG8_WAIT_V(0);
    if constexpr (!ALIGN_EPI) { if (wr == 0) PG8_BAR; }
    PG8_BAR;
    if constexpr (Epi::AFTER_DRAIN) { E.fused(acc, cur, wr, wc, fr, fq, lds, wid, lane); S.done(cur); }
#undef PG8_SA
#undef PG8_SB
#undef PG8_STAGE
#undef PG8_LDA
#undef PG8_LDB
#undef PG8_MMA
#undef PG8_WAIT_V
#undef PG8_WAIT_L
#undef PG8_BAR
#undef PG8_SCHED
}
}

#define LAS __attribute__((address_space(3)))
typedef unsigned short bf16_t;
typedef short bf16x8 __attribute__((ext_vector_type(8)));
typedef short s16x4 __attribute__((ext_vector_type(4)));
typedef float f32x4 __attribute__((ext_vector_type(4)));
typedef float f32x16 __attribute__((ext_vector_type(16)));
typedef unsigned u32x4 __attribute__((ext_vector_type(4)));
typedef unsigned u32x2 __attribute__((ext_vector_type(2)));
constexpr int DM = 1024, NB = 4, SEQ = 8192, DEPTH = 2, FF = 2816, NH = 8, HD = 64, AW = 512, INC = 3072, MODW = 9216;
constexpr int M = NB * SEQ;
constexpr float EPS = 1e-6f;
constexpr float QSCALE = 0.125f * 1.4426950408889634f;
constexpr float NEGBIG = -1e30f;
constexpr int NWAVES = 8, NTHR = 512;
constexpr size_t MiB = 1u << 20;
constexpr size_t WS_MOD = 0;
constexpr size_t WS_W = 2 * MiB;
constexpr size_t W1_BYTES = (size_t)2 * FF * DM * 2, W2_BYTES = (size_t)DM * FF * 2, WIN_BYTES = (size_t)INC * DM * 2, WOUT_BYTES = (size_t)DM * DM * 2;
constexpr size_t LW_W1 = 0, LW_W2 = 2 * W1_BYTES, LW_WIN = LW_W2 + 2 * W2_BYTES, LW_WOUT = LW_WIN + WIN_BYTES, LW_BYTES = LW_WOUT + WOUT_BYTES;
static_assert(WS_W + DEPTH * LW_BYTES <= 88 * MiB, "weights");
constexpr size_t WS_H = 88 * MiB;
constexpr size_t WS_YC = 152 * MiB;
constexpr size_t WS_ACT = 216 * MiB;
constexpr size_t WS_QKV = WS_ACT + 96 * MiB;
constexpr size_t WS_O23 = 408 * MiB;
constexpr size_t WS_LSE = 472 * MiB;
constexpr size_t WS_CTL = 474 * MiB, CTL_BYTES = 16384;
constexpr int NSW = 2 * FF;
constexpr size_t WS_SW = WS_CTL + CTL_BYTES, SW_BYTES = (size_t)DEPTH * 3 * NB * NSW * 4;
constexpr size_t WS_RSS = WS_SW + SW_BYTES, RSS_BYTES = (size_t)DEPTH * 3 * M * 4;
constexpr size_t ZERO_BYTES = CTL_BYTES + SW_BYTES + RSS_BYTES;
constexpr size_t WS_ST = 476 * MiB;
static_assert(WS_CTL + ZERO_BYTES <= WS_ST, "zeroed region");
constexpr size_t WS_END = 477 * MiB;
constexpr int RING_BYTES = 131072, WSCR_OFF = RING_BYTES, MISC_OFF = RING_BYTES + NWAVES * 512, LDS_BYTES = MISC_OFF + 256;

__device__ __forceinline__ float bf_lo(unsigned u) { return __uint_as_float(u << 16); }
__device__ __forceinline__ float bf_hi(unsigned u) { return __uint_as_float(u & 0xffff0000u); }
__device__ __forceinline__ float wave_sum(float v) {
#pragma unroll
    for (int o = 1; o < 64; o <<= 1) v += __shfl_xor(v, o);
    return v;
}
using pg8::cvt_pk_bf16;

struct In { const float *x, *c, *w_ada, *b_ada, *norm_g, *w_in, *q_g, *k_g, *conv_w, *conv_b, *w_out, *w1, *w2; };

__device__ __forceinline__ void mod_phase(const In& I, unsigned char* ws, LAS unsigned char* lds, int tid, int lane, int wave) {
    LAS float* sc = (LAS float*)(lds + 69632);
    LAS float* red = (LAS float*)(lds + 69632 + 16384);
    float* mod = (float*)(ws + WS_MOD); float* ST = (float*)(ws + WS_ST);
    for (int i = tid; i < NB * DM; i += NTHR) { const float v = I.c[i]; sc[i] = v / (1.0f + __expf(-v)); }
    __syncthreads();
    for (int it = blockIdx.x; it < DEPTH * (MODW / 64); it += gridDim.x) {
        const int l = it / (MODW / 64), j0 = (it % (MODW / 64)) * 64;
        const float* wp = I.w_ada + (size_t)l * DM * MODW + j0 + lane;
        float a0 = 0.f, a1 = 0.f, a2 = 0.f, a3 = 0.f; const int k0 = wave * 128;
#pragma unroll 8
        for (int k = k0; k < k0 + 128; ++k) { const float w = wp[(size_t)k * MODW]; a0 += sc[k] * w; a1 += sc[DM + k] * w; a2 += sc[2 * DM + k] * w; a3 += sc[3 * DM + k] * w; }
        red[(wave * 4 + 0) * 64 + lane] = a0; red[(wave * 4 + 1) * 64 + lane] = a1; red[(wave * 4 + 2) * 64 + lane] = a2; red[(wave * 4 + 3) * 64 + lane] = a3;
        __syncthreads();
        if (tid < 256) { const int b = tid >> 6, cl = tid & 63; float s = 0.f;
#pragma unroll
            for (int w = 0; w < 8; ++w) s += red[(w * 4 + b) * 64 + cl];
            const int j = j0 + cl; const float v = s + I.b_ada[(size_t)l * MODW + j];
            mod[(size_t)(l * NB + b) * MODW + j] = v;
            const int sub = j / 3072, jj = j % 3072; if (jj < DM) ST[((size_t)(l * 3 + sub) * DM + jj) * NB + b] = v; }
        __syncthreads();
    }
}
__device__ __forceinline__ void transpose_item(const float* W, int K, int N, bf16_t* WT, int k0, int src_n0, int dst_n0, LAS float* scr, int lane, const float* st, float* sw) {
#pragma unroll 8
    for (int i = 0; i < 32; ++i) { const int kk = 2 * i + (lane >> 5); scr[kk * 33 + (lane & 31)] = W[(size_t)(k0 + kk) * N + src_n0 + (lane & 31)]; }
    asm volatile("s_waitcnt lgkmcnt(0)" ::: "memory");
    const int c = lane & 7;
#pragma unroll
    for (int j = 0; j < 4; ++j) { const int n = (lane >> 3) + 8 * j; const LAS float* s = scr + (8 * c) * 33 + n;
        u32x4 o; o.x = cvt_pk_bf16(s[0 * 33], s[1 * 33]); o.y = cvt_pk_bf16(s[2 * 33], s[3 * 33]); o.z = cvt_pk_bf16(s[4 * 33], s[5 * 33]); o.w = cvt_pk_bf16(s[6 * 33], s[7 * 33]);
        *(u32x4*)(WT + (size_t)(dst_n0 + n) * K + k0 + 8 * c) = o; }
    if (st) { const int n = lane & 31, hf = lane >> 5; f32x4 a4 = {0.f, 0.f, 0.f, 0.f};
#pragma unroll 8
        for (int i = 0; i < 32; ++i) { const int kk = hf * 32 + i; a4 += *(const f32x4*)(st + (size_t)(k0 + kk) * NB) * scr[kk * 33 + n]; }
#pragma unroll
        for (int b = 0; b < 4; ++b) a4[b] += __shfl_xor(a4[b], 32);
        if (hf == 0) {
#pragma unroll
            for (int b = 0; b < 4; ++b) __hip_atomic_fetch_add(sw + (size_t)b * NSW + dst_n0 + n, a4[b], __ATOMIC_RELAXED, __HIP_MEMORY_SCOPE_AGENT); } }
    asm volatile("s_waitcnt lgkmcnt(0)" ::: "memory");
}
__device__ __forceinline__ void weights_phase(const In& I, unsigned char* ws, LAS unsigned char* lds, int tid, int lane, int wave) {
    LAS float* scr = (LAS float*)(lds + wave * 8448);
    const int gw = blockIdx.x * NWAVES + wave, NGW = gridDim.x * NWAVES;
    const float* ST = (const float*)(ws + WS_ST); float* SW = (float*)(ws + WS_SW);
    constexpr int I_W1 = (DM / 64) * (2 * FF / 32), I_W2 = (FF / 64) * (DM / 32), I_WIN = (DM / 64) * (INC / 32), I_WOUT = (DM / 64) * (DM / 32);
    constexpr int I_LAYER = 2 * I_W1 + 2 * I_W2 + I_WIN + I_WOUT;
    for (int it = gw; it < DEPTH * I_LAYER; it += NGW) {
        const int l = it / I_LAYER; int r = it % I_LAYER;
        unsigned char* lw = ws + WS_W + (size_t)l * LW_BYTES;
        if (r < 2 * I_W1) { const int f = r / I_W1; r %= I_W1; const int nblk = 2 * FF / 32, kb = r / nblk, nb = r % nblk, n0 = nb * 32;
            const int pn = n0 >> 8, bj = (n0 >> 7) & 1, i = n0 & 127, sub = 2 * f;
            transpose_item(I.w1 + (size_t)(l * 2 + f) * DM * 2 * FF, DM, 2 * FF, (bf16_t*)(lw + LW_W1 + f * W1_BYTES), kb * 64, bj * FF + 128 * pn + i, n0, scr, lane,
                           ST + (size_t)(l * 3 + sub) * DM * NB, SW + (size_t)(l * 3 + sub) * NB * NSW); continue; }
        r -= 2 * I_W1;
        if (r < 2 * I_W2) { const int f = r / I_W2; r %= I_W2; const int nblk = DM / 32, kb = r / nblk, nb = r % nblk;
            transpose_item(I.w2 + (size_t)(l * 2 + f) * FF * DM, FF, DM, (bf16_t*)(lw + LW_W2 + f * W2_BYTES), kb * 64, nb * 32, nb * 32, scr, lane, nullptr, nullptr); continue; }
        r -= 2 * I_W2;
        if (r < I_WIN) { const int nblk = INC / 32, kb = r / nblk, nb = r % nblk, n0 = nb * 32; const int pn = n0 >> 8, bj = (n0 >> 7) & 1, wc = (n0 >> 5) & 3;
            transpose_item(I.w_in + (size_t)l * DM * INC, DM, INC, (bf16_t*)(lw + LW_WIN), kb * 64, 256 * pn + 64 * wc + 32 * bj, n0, scr, lane,
                           ST + (size_t)(l * 3 + 1) * DM * NB, SW + (size_t)(l * 3 + 1) * NB * NSW); continue; }
        r -= I_WIN;
        { const int nblk = DM / 32, kb = r / nblk, nb = r % nblk;
            transpose_item(I.w_out + (size_t)l * DM * DM, DM, DM, (bf16_t*)(lw + LW_WOUT), kb * 64, nb * 32, nb * 32, scr, lane, nullptr, nullptr); }
    }
    const float* mod = (const float*)(ws + WS_MOD); bf16_t* XG = (bf16_t*)(ws + WS_H); float* RSS = (float*)(ws + WS_RSS);
    for (int chunk = gw; chunk < M / 16; chunk += NGW) {
        const int row0 = chunk * 16, b = row0 >> 13;
        const float* mp = mod + (size_t)b * MODW;
        f32x4 G[4];
#pragma unroll
        for (int j = 0; j < 4; ++j) { const int c = 4 * lane + 256 * j; G[j] = *(const f32x4*)(I.norm_g + c) * (*(const f32x4*)(mp + DM + c) + 1.0f); }
        for (int r = 0; r < 16; ++r) {
            const f32x4* xr = (const f32x4*)(I.x + (size_t)(row0 + r) * DM) + lane;
            f32x4 v[4]; float ssq = 0.f;
#pragma unroll
            for (int j = 0; j < 4; ++j) { v[j] = xr[64 * j]; ssq += (v[j].x * v[j].x + v[j].y * v[j].y) + (v[j].z * v[j].z + v[j].w * v[j].w); }
            ssq = wave_sum(ssq);
            if (lane == 0) RSS[row0 + r] = ssq;
            u32x2* o8 = (u32x2*)(XG + (size_t)(row0 + r) * DM) + lane;
#pragma unroll
            for (int j = 0; j < 4; ++j) { const f32x4 o = v[j] * G[j]; u32x2 w; w.x = cvt_pk_bf16(o.x, o.y); w.y = cvt_pk_bf16(o.z, o.w); o8[64 * j] = w; }
        }
    }
}

__device__ __forceinline__ int crow(int i, int hi) { return (i & 3) + 8 * (i >> 2) + 4 * hi; }
typedef short v4i16_t __attribute__((ext_vector_type(4)));
__device__ __forceinline__ s16x4 vtr(LAS const unsigned char* p) { return __builtin_bit_cast(s16x4, __builtin_amdgcn_ds_read_tr16_b64_v4i16((LAS v4i16_t*)p)); }

struct AttnItem { int dil, b, h, r, nb, br; };
template <bool FINAL> __device__ __forceinline__ AttnItem attn_decode(int R, int wid) {
    AttnItem t; const int it = 2 * R + (wid >> 2);
    if (!FINAL) { const int br = it >> 11, rem = it & 2047, bh = rem >> 6, rn = rem & 63; t.br = br; t.dil = br ? 16 : 4; const int nbc = 64 / t.dil; t.r = rn / nbc; t.nb = rn % nbc; t.b = bh >> 3; t.h = bh & 7; }
    else { const int bh = it >> 6; t.br = 0; t.dil = 1; t.r = 0; t.nb = it & 63; t.b = bh >> 3; t.h = bh & 7; }
    return t;
}
__device__ __forceinline__ void attn_load(const bf16_t* proj, const AttnItem& t, u32x4 (&kv)[8], u32x4 (&vv)[8], int tid) {
    const int th = tid & 255;
    const bf16_t* kb = proj + (size_t)((NB + t.b) * NH + t.h) * SEQ * HD;
#pragma unroll
    for (int c = 0; c < 8; ++c) { const int idx = th + 256 * c, j = idx >> 3, ch = idx & 7; const int sidx = (t.nb - 1) * 128 + j;
        if (sidx >= 0) { const bf16_t* p = kb + ((size_t)sidx * t.dil + t.r) * HD + ch * 8; kv[c] = *(const u32x4*)p; vv[c] = *(const u32x4*)(p + (size_t)NB * NH * SEQ * HD); }
        else { kv[c] = (u32x4){0u, 0u, 0u, 0u}; vv[c] = (u32x4){0u, 0u, 0u, 0u}; } }
}
__device__ __forceinline__ void attn_load_q(const bf16_t* proj, const AttnItem& t, bf16x8 (&qf)[4], int lane, int wid) {
    const int w = wid & 3, r32 = lane & 31, hi = lane >> 5;
    const size_t qrow = (size_t)(t.b * NH + t.h) * SEQ + (size_t)(t.nb * 128 + 32 * w + r32) * t.dil + t.r;
#pragma unroll
    for (int ks = 0; ks < 4; ++ks) qf[ks] = *(const bf16x8*)(proj + qrow * HD + 16 * ks + 8 * hi);
}
__device__ __forceinline__ void attn_stage(LAS unsigned char* lds, const u32x4 (&kv)[8], const u32x4 (&vv)[8], int tid, int wid) {
    const int th = tid & 255; LAS unsigned char* Kl = lds + (wid >> 2) * 65536; LAS unsigned char* Vl = Kl + 32768;
#pragma unroll
    for (int c = 0; c < 8; ++c) { const int idx = th + 256 * c, j = idx >> 3, ch = idx & 7;
        *(LAS u32x4*)(Kl + j * 128 + ((ch ^ ((j >> 1) & 7)) * 16)) = kv[c];
        *(LAS u32x4*)(Vl + j * 128 + (((ch >> 2) ^ ((j >> 1) & 1)) * 64) + (ch & 3) * 16) = vv[c]; }
}
template <bool FINAL>
__device__ __forceinline__ void attn_compute(LAS unsigned char* lds, const bf16_t* proj, const AttnItem& t, const AttnItem& nxt, bool more, bf16x8 (&qf)[4], bf16_t* o23, float* lse23, bf16_t* ycat, int lane, int wid) {
    const int w = wid & 3, r32 = lane & 31, hi = lane >> 5;
    LAS unsigned char* Kl = lds + (wid >> 2) * 65536; LAS unsigned char* Vl = Kl + 32768;
    const int nb = t.nb;
    f32x16 o[2];
#pragma unroll
    for (int d = 0; d < 2; ++d) o[d] = (f32x16){0.f, 0.f, 0.f, 0.f, 0.f, 0.f, 0.f, 0.f, 0.f, 0.f, 0.f, 0.f, 0.f, 0.f, 0.f, 0.f};
    const int i16 = lane & 15, q4 = i16 >> 2, p4 = i16 & 3, blk = (lane >> 4) & 1;
    float mx = NEGBIG, l = 0.f;
#pragma unroll
    for (int tt = 4; tt >= 0; --tt) {
        if (nb == 0 && w + tt < 4) continue;
        const int kvrow = 32 * (w + tt) + r32;
        f32x16 sc = {0.f, 0.f, 0.f, 0.f, 0.f, 0.f, 0.f, 0.f, 0.f, 0.f, 0.f, 0.f, 0.f, 0.f, 0.f, 0.f};
#pragma unroll
        for (int ks = 0; ks < 4; ++ks) { const bf16x8 kf = *(LAS const bf16x8*)(Kl + kvrow * 128 + (((2 * ks + hi) ^ ((kvrow >> 1) & 7)) * 16)); sc = __builtin_amdgcn_mfma_f32_32x32x16_bf16(kf, qf[ks], sc, 0, 0, 0); }
        if (tt == 4) {
#pragma unroll
            for (int i = 0; i < 16; ++i) if (crow(i, hi) > r32) sc[i] = NEGBIG; }
        if (tt == 0) {
#pragma unroll
            for (int i = 0; i < 16; ++i) if (crow(i, hi) < r32) sc[i] = NEGBIG; }
        float tm = sc[0];
#pragma unroll
        for (int i = 1; i < 16; ++i) tm = fmaxf(tm, sc[i]);
        tm = fmaxf(tm, __shfl_xor(tm, 32));
        const float mn = fmaxf(mx, tm);
        if (tt != 4) { const float f = __builtin_amdgcn_exp2f(mx - mn); l *= f;
#pragma unroll
            for (int d = 0; d < 2; ++d)
#pragma unroll
                for (int i = 0; i < 16; ++i) o[d][i] *= f; }
        mx = mn;
#pragma unroll
        for (int i = 0; i < 16; ++i) { const float p = __builtin_amdgcn_exp2f(sc[i] - mx); sc[i] = p; l += p; }
#pragma unroll
        for (int s2 = 0; s2 < 2; ++s2) {
            u32x4 pw; pw.x = cvt_pk_bf16(sc[8 * s2 + 0], sc[8 * s2 + 1]); pw.y = cvt_pk_bf16(sc[8 * s2 + 2], sc[8 * s2 + 3]);
            pw.z = cvt_pk_bf16(sc[8 * s2 + 4], sc[8 * s2 + 5]); pw.w = cvt_pk_bf16(sc[8 * s2 + 6], sc[8 * s2 + 7]);
            const bf16x8 pf = __builtin_bit_cast(bf16x8, pw);
            const int kvr = 32 * (w + tt) + 16 * s2 + 4 * hi + q4;
#pragma unroll
            for (int d = 0; d < 2; ++d) {
                LAS const unsigned char* vp = Vl + kvr * 128 + ((d ^ ((q4 >> 1) & 1)) * 64) + 32 * blk + 8 * p4;
                const s16x4 lo = vtr(vp), hi4 = vtr(vp + 8 * 128);
                const bf16x8 vf = (bf16x8){lo[0], lo[1], lo[2], lo[3], hi4[0], hi4[1], hi4[2], hi4[3]};
                o[d] = __builtin_amdgcn_mfma_f32_32x32x16_bf16(vf, pf, o[d], 0, 0, 0);
            }
        }
    }
    l += __shfl_xor(l, 32);
    if (more) attn_load_q(proj, nxt, qf, lane, wid);
    const float lse = mx + __builtin_amdgcn_logf(l);
    const int tok = (nb * 128 + 32 * w + r32) * t.dil + t.r;
    const size_t qrow = (size_t)t.b * SEQ + tok, hrow = (size_t)(t.b * NH + t.h) * SEQ + tok;
    if (!FINAL) {
        const float c1 = 1.0f / l;
        if (hi == 0) lse23[(size_t)t.br * M * NH + hrow] = lse;
        bf16_t* ob = o23 + ((size_t)t.br * M * NH + hrow) * HD + 4 * hi;
#pragma unroll
        for (int d = 0; d < 2; ++d)
#pragma unroll
            for (int g = 0; g < 4; ++g) { u32x2 wv; wv.x = cvt_pk_bf16(o[d][4 * g] * c1, o[d][4 * g + 1] * c1); wv.y = cvt_pk_bf16(o[d][4 * g + 2] * c1, o[d][4 * g + 3] * c1); *(u32x2*)(ob + 32 * d + 8 * g) = wv; }
    } else {
        const float l2 = lse23[hrow], l3 = lse23[(size_t)M * NH + hrow];
        const float mm = fmaxf(lse, fmaxf(l2, l3));
        const float e1 = __builtin_amdgcn_exp2f(lse - mm), e2 = __builtin_amdgcn_exp2f(l2 - mm), e3 = __builtin_amdgcn_exp2f(l3 - mm);
        const float inv = 1.0f / (e1 + e2 + e3);
        const float c1 = e1 * inv / l, c2 = e2 * inv, c3 = e3 * inv;
        const bf16_t* o2 = o23 + hrow * HD + 4 * hi; const bf16_t* o3 = o2 + (size_t)M * AW;
        bf16_t* yo = ycat + qrow * DM + t.h * HD + 4 * hi;
#pragma unroll
        for (int d = 0; d < 2; ++d)
#pragma unroll
            for (int g = 0; g < 4; ++g) { const u32x2 a2 = *(const u32x2*)(o2 + 32 * d + 8 * g), a3 = *(const u32x2*)(o3 + 32 * d + 8 * g);
                u32x2 wv;
                wv.x = cvt_pk_bf16(c1 * o[d][4 * g] + c2 * bf_lo(a2.x) + c3 * bf_lo(a3.x), c1 * o[d][4 * g + 1] + c2 * bf_hi(a2.x) + c3 * bf_hi(a3.x));
                wv.y = cvt_pk_bf16(c1 * o[d][4 * g + 2] + c2 * bf_lo(a2.y) + c3 * bf_lo(a3.y), c1 * o[d][4 * g + 3] + c2 * bf_hi(a2.y) + c3 * bf_hi(a3.y));
                *(u32x2*)(yo + 32 * d + 8 * g) = wv; }
    }
}
template <bool FINAL>
__device__ __forceinline__ void attn_phase(LAS unsigned char* lds, const bf16_t* proj, bf16_t* o23, float* lse23, bf16_t* ycat, int tid, int lane, int wid) {
    constexpr int NR = FINAL ? 1024 : 2048;
    int R = blockIdx.x; if (R >= NR) return;
    u32x4 kv[8], vv[8]; bf16x8 qf[4];
    AttnItem cur = attn_decode<FINAL>(R, wid);
    attn_load(proj, cur, kv, vv, tid); attn_load_q(proj, cur, qf, lane, wid);
    for (;;) {
        attn_stage(lds, kv, vv, tid, wid);
        __syncthreads();
        const int Rn = R + gridDim.x; const bool more = Rn < NR;
        AttnItem nxt = cur;
        if (more) { nxt = attn_decode<FINAL>(Rn, wid); attn_load(proj, nxt, kv, vv, tid); }
        attn_compute<FINAL>(lds, proj, cur, nxt, more, qf, o23, lse23, ycat, lane, wid);
        __syncthreads();
        if (!more) break;
        cur = nxt; R = Rn;
    }
}
__device__ __forceinline__ void conv_phase(const bf16_t* proj, bf16_t* ycat, const float* cw, const float* cb, int tid) {
    const int c0 = (tid & 63) * 8;
    float w0[8], w1[8], w2[8], bb[8];
#pragma unroll
    for (int e = 0; e < 8; ++e) { w0[e] = cw[c0 + e]; w1[e] = cw[AW + c0 + e]; w2[e] = cw[2 * AW + c0 + e]; bb[e] = cb[c0 + e]; }
    for (int chunk = (blockIdx.x * NTHR + tid) >> 6; chunk < M / 16; chunk += (gridDim.x * NTHR) >> 6) {
        const int row0 = chunk * 16, t0 = row0 & (SEQ - 1);
        float p1[8], p2[8];
#pragma unroll
        for (int e = 0; e < 8; ++e) { p1[e] = 0.f; p2[e] = 0.f; }
        if (t0 >= 2) {
            const bf16_t* p = proj + (size_t)(row0 - 2) * 1536 + c0;
            const u32x4 ga = *(const u32x4*)(p + 512), ua = *(const u32x4*)(p + 1024), gb1 = *(const u32x4*)(p + 1536 + 512), ub1 = *(const u32x4*)(p + 1536 + 1024);
#pragma unroll
            for (int e = 0; e < 4; ++e) { p2[2 * e] = bf_lo(ga[e]) * bf_lo(ua[e]); p2[2 * e + 1] = bf_hi(ga[e]) * bf_hi(ua[e]); p1[2 * e] = bf_lo(gb1[e]) * bf_lo(ub1[e]); p1[2 * e + 1] = bf_hi(gb1[e]) * bf_hi(ub1[e]); }
        }
#pragma unroll 4
        for (int rr = 0; rr < 16; ++rr) {
            const bf16_t* p = proj + (size_t)(row0 + rr) * 1536 + c0;
            const u32x4 gb = *(const u32x4*)p, gc = *(const u32x4*)(p + 512), uu = *(const u32x4*)(p + 1024);
            float p0[8], y[8];
#pragma unroll
            for (int e = 0; e < 4; ++e) { p0[2 * e] = bf_lo(gc[e]) * bf_lo(uu[e]); p0[2 * e + 1] = bf_hi(gc[e]) * bf_hi(uu[e]); }
#pragma unroll
            for (int e = 0; e < 8; ++e) y[e] = w2[e] * p0[e] + w1[e] * p1[e] + w0[e] * p2[e] + bb[e];
            u32x4 o;
#pragma unroll
            for (int e = 0; e < 4; ++e) o[e] = cvt_pk_bf16(bf_lo(gb[e]) * y[2 * e], bf_hi(gb[e]) * y[2 * e + 1]);
            *(u32x4*)(ycat + (size_t)(row0 + rr) * DM + AW + c0) = o;
#pragma unroll
            for (int e = 0; e < 8; ++e) { p2[e] = p1[e]; p1[e] = p0[e]; }
        }
    }
}


#define XB_TMO      128
#define XB_XCNT(j)  (256  + 64 * (j))
#define XB_XSUB(j)  (1280 + 64 * (j))
#define XB_XGEN(j)  (2304 + 64 * (j))
#define XB_TOP      3328
#define XB_TOPGEN   3392
#define XCD_BAR_WORDS 3456
#define XB_SPIN_CAP (1u << 18)

__device__ __forceinline__ unsigned xb_ld(unsigned* p)              { return __hip_atomic_load(p, __ATOMIC_RELAXED, __HIP_MEMORY_SCOPE_AGENT); }
__device__ __forceinline__ unsigned xb_add(unsigned* p, unsigned v) { return __hip_atomic_fetch_add(p, v, __ATOMIC_RELAXED, __HIP_MEMORY_SCOPE_AGENT); }
__device__ __forceinline__ unsigned xb_xcc_id() { return (unsigned)__builtin_amdgcn_s_getreg((3 << 11) | 20) & 0xFu; }
#define XB_SPIN(cond, bar) do { unsigned _sp = 0; while (cond) { __builtin_amdgcn_s_sleep(1); \
    if ((++_sp & 255u) == 0u) { if (xb_ld(&(bar)[XB_TMO])) break; if (_sp > XB_SPIN_CAP) { atomicAdd(&(bar)[XB_TMO], 1u); break; } } } } while (0)

struct XcdBarrier {
    unsigned* bar; unsigned x;
    volatile LAS unsigned* st;
};

__device__ __forceinline__ XcdBarrier xcd_barrier_post(unsigned* bar, volatile LAS unsigned* st) {
    XcdBarrier b; b.bar = bar; b.x = xb_xcc_id(); b.st = st;
    if (threadIdx.x == 0) (void)xb_add(&bar[XB_XCNT(b.x)], 1u);
    return b;
}
__device__ __forceinline__ void xcd_barrier_complete(unsigned* bar, unsigned x, unsigned& nloc, unsigned& nx) {
    const unsigned G = gridDim.x * gridDim.y * gridDim.z;
    unsigned sum, cnt, mine, sp = 0u;
    for (;;) {
        sum = 0u; cnt = 0u; mine = 0u;
#pragma unroll
        for (unsigned j = 0; j < 16; ++j) { const unsigned c = xb_ld(&bar[XB_XCNT(j)]); sum += c; cnt += (c > 0u) ? 1u : 0u; mine = (j == x) ? c : mine; }
        if (sum == G) break;
        __builtin_amdgcn_s_sleep(1);
        if ((++sp & 255u) == 0u) { if (xb_ld(&bar[XB_TMO])) break; if (sp > XB_SPIN_CAP) { atomicAdd(&bar[XB_TMO], 1u); break; } }
    }
    nloc = mine > 0u ? mine : 1u; nx = cnt > 0u ? cnt : 1u;
}

__device__ __forceinline__ void xcd_barrier(const XcdBarrier& b) {
    asm volatile("s_waitcnt vmcnt(0)" ::: "memory");
    __syncthreads();
    if (threadIdx.x == 0) {
        unsigned* bar = b.bar;
        __builtin_amdgcn_s_waitcnt(0);
        unsigned nloc = b.st[0], nx = b.st[1];
        if (nloc == 0u) { xcd_barrier_complete(bar, b.x, nloc, nx); b.st[0] = nloc; b.st[1] = nx; }
        const unsigned old = xb_add(&bar[XB_XSUB(b.x)], 1u);
        const unsigned gen = old / nloc;
        if (old + 1u == (gen + 1u) * nloc) {
            __builtin_amdgcn_fence(__ATOMIC_RELEASE, "agent");
            asm volatile("s_waitcnt vmcnt(0)" ::: "memory");
            const unsigned og = xb_add(&bar[XB_TOP], 1u);
            const unsigned tg = og / nx;
            if (og + 1u == (tg + 1u) * nx) xb_add(&bar[XB_TOPGEN], 1u);
            else XB_SPIN(xb_ld(&bar[XB_TOPGEN]) == tg, bar);
            __builtin_amdgcn_fence(__ATOMIC_ACQUIRE, "agent");
            xb_add(&bar[XB_XGEN(b.x)], 1u);
            asm volatile("s_waitcnt vmcnt(0)" ::: "memory");
        } else {
            XB_SPIN(xb_ld(&bar[XB_XGEN(b.x)]) == gen, bar);
            __builtin_amdgcn_fence(__ATOMIC_ACQUIRE, "agent");
            asm volatile("s_waitcnt vmcnt(0)" ::: "memory");
        }
    }
    __syncthreads();
}

#ifndef MK_MULTI
#define MK_MULTI 0
#endif
constexpr int N_PHASES = 2 + 8 * DEPTH;
#ifndef PROBE_DUP_MASK
#define PROBE_DUP_MASK 0
#endif
struct Args { In in; float* out; unsigned char* ws; int ph_lo, ph_hi; };
static_assert(sizeof(Args) == 15 * 8 + 8, "Args has no padding");
template <class T> __device__ __forceinline__ T* uptr(T* p) {
    const unsigned long long v = (unsigned long long)p;
    const unsigned lo = __builtin_amdgcn_readfirstlane((unsigned)v), hi = __builtin_amdgcn_readfirstlane((unsigned)(v >> 32));
    return (T*)(((unsigned long long)hi << 32) | lo);
}

__global__ void __launch_bounds__(NTHR, 2) fwd_megakernel(Args a) {
    extern __shared__ __attribute__((aligned(16))) unsigned char lds_raw[];
    LAS unsigned char* lds = (LAS unsigned char*)lds_raw;
    cg::grid_group grid = cg::this_grid();
    const int wave0 = __builtin_amdgcn_readfirstlane(threadIdx.x >> 6);
    unsigned char* ws = a.ws;
    volatile LAS unsigned* MISC = (volatile LAS unsigned*)(lds + MISC_OFF);
    if (threadIdx.x < 16) MISC[threadIdx.x] = 0u;
    __syncthreads();
    XcdBarrier bar; bar.bar = (unsigned*)(ws + WS_CTL); bar.x = 0; bar.st = nullptr;
    if (a.ph_hi - a.ph_lo > 1) bar = xcd_barrier_post((unsigned*)(ws + WS_CTL), MISC + 8);
    float* mod = (float*)(ws + WS_MOD);
    bf16_t* XG = (bf16_t*)(ws + WS_H); bf16_t* YC = (bf16_t*)(ws + WS_YC); bf16_t* ACT = (bf16_t*)(ws + WS_ACT);
    bf16_t* QKVb = (bf16_t*)(ws + WS_QKV);
    bf16_t* O23 = (bf16_t*)(ws + WS_O23); float* LSE = (float*)(ws + WS_LSE);
    float* SW = (float*)(ws + WS_SW); float* RSS = (float*)(ws + WS_RSS);
    for (int ph_ = a.ph_lo; ph_ < a.ph_hi; ++ph_) {
        int ph = ph_; asm volatile("" : "+s"(ph));
        int nrep = ph < 2 ? 1 : ((PROBE_DUP_MASK >> ((ph - 2) % 8)) & 1) + 1; asm volatile("" : "+s"(nrep));
        for (int rep = 0; rep < nrep; ++rep) {
        asm volatile("" : "+s"(ph));
        int wave = wave0; asm volatile("" : "+s"(wave));
        int lane = (int)__builtin_amdgcn_mbcnt_hi(~0u, __builtin_amdgcn_mbcnt_lo(~0u, 0u)); asm volatile("" : "+v"(lane));
        const int tid = wave * 64 + lane;
        if (ph == 0) { mod_phase(a.in, ws, lds, tid, lane, wave); }
        else if (ph == 1) { weights_phase(a.in, ws, lds, tid, lane, wave); }
        else {
            const int q = ph - 2, L = q / 8, k = q % 8;
            unsigned char* lw = ws + WS_W + (size_t)L * LW_BYTES;
            const float* lmod = mod + (size_t)L * NB * MODW;
            if (k == 0 || k == 6) {
                const int f = k == 6, sub = 2 * f;
                pg8::Gemm g{XG, (const bf16_t*)(lw + LW_W1 + f * W1_BYTES), M, 2 * FF, DM}; pg8::StaticOrder S; S.init(M, 2 * FF, gridDim.x, blockIdx.x);
                pg8::EpiSwiglu E{ACT, FF, RSS + (size_t)(L * 3 + sub) * M, SW + (size_t)(L * 3 + sub) * NB * NSW};
                pg8::gemm_phase<pg8::EpiSwiglu, pg8::StaticOrder, true, true>(lds, tid, g, S, E);
            } else if (k == 1 || k == 7 || k == 5) {
                const int f = k == 7, sub = k == 1 ? 0 : (k == 5 ? 1 : 2);
                const float* xcur = (L == 0 && k == 1) ? a.in.x : a.out;
                const bf16_t* A = k == 5 ? YC : ACT; const bf16_t* Bt = k == 5 ? (const bf16_t*)(lw + LW_WOUT) : (const bf16_t*)(lw + LW_W2 + f * W2_BYTES);
                pg8::Gemm g{A, Bt, M, DM, k == 5 ? DM : FF}; pg8::StaticOrder S; S.init(M, DM, gridDim.x, blockIdx.x);
                const int nn = L * 3 + sub + 1;
                const bool has = nn < DEPTH * 3; const int ni = has ? nn : 0;
                LAS pg8::EpiResid::P* pp = (LAS pg8::EpiResid::P*)(lds + MISC_OFF + 64);
                if (tid == 0) { pp->xin = xcur; pp->out = a.out; pp->gate = lmod + sub * 3 * DM + 2 * DM; pp->xg = XG; pp->rss = RSS + (size_t)ni * M; pp->ng = a.in.norm_g + (size_t)ni * DM;
                    pp->nmod = mod + (size_t)(ni / 3) * NB * MODW + (ni % 3) * 3 * DM; pp->gs = k == 5 ? 1.0f : 0.5f; pp->has = has ? 1 : 0; }
                __syncthreads();
                pg8::EpiResid E{pp};
                pg8::gemm_phase<pg8::EpiResid, pg8::StaticOrder, true, true>(lds, tid, g, S, E);
            } else if (k == 2) {
                pg8::Gemm g{XG, (const bf16_t*)(lw + LW_WIN), M, INC, DM}; pg8::StaticOrder S; S.init(M, INC, gridDim.x, blockIdx.x);
                pg8::EpiWin E{ACT, 1536, QKVb, a.in.q_g + L * HD, a.in.k_g + L * HD, QSCALE, RSS + (size_t)(L * 3 + 1) * M, SW + (size_t)(L * 3 + 1) * NB * NSW};
                pg8::gemm_phase<pg8::EpiWin, pg8::StaticOrder, true, true>(lds, tid, g, S, E);
            } else if (k == 3) {
                attn_phase<false>(lds, QKVb, O23, LSE, nullptr, tid, lane, wave);
            } else {
                attn_phase<true>(lds, QKVb, O23, LSE, YC, tid, lane, wave);
                conv_phase(ACT, YC, a.in.conv_w + (size_t)L * 3 * AW, a.in.conv_b + (size_t)L * AW, tid);
            }
        }
        __syncthreads(); }
        if (ph_ + 1 < a.ph_hi) { if (ph_ == 0) grid.sync(); else xcd_barrier(bar); }
    }
}

extern "C" void kernel_launch(void* const* d_in, const int* in_sizes, int n_in, void* d_out, int out_size, void* d_ws, size_t ws_size, hipStream_t stream) {
    static int grid_blocks = 0;
    if (grid_blocks == 0) {
        if (n_in != 13 || in_sizes[0] != M * DM || out_size != M * DM || ws_size < WS_END) { fprintf(stderr, "kernel_launch: unexpected shapes (n_in %d, in0 %d, out %d, ws %zu)\n", n_in, n_in > 0 ? in_sizes[0] : -1, out_size, ws_size); grid_blocks = -1; return; }
        int dev = 0, cus = 0, per_cu = 0;
        hipGetDevice(&dev);
        hipDeviceGetAttribute(&cus, hipDeviceAttributeMultiprocessorCount, dev);
        if (hipFuncSetAttribute((const void*)fwd_megakernel, hipFuncAttributeMaxDynamicSharedMemorySize, LDS_BYTES) != hipSuccess) fprintf(stderr, "kernel_launch: hipFuncSetAttribute failed\n");
        if (hipOccupancyMaxActiveBlocksPerMultiprocessor(&per_cu, (const void*)fwd_megakernel, NTHR, LDS_BYTES) != hipSuccess || per_cu < 1) { fprintf(stderr, "kernel_launch: occupancy query says %d\n", per_cu); per_cu = 1; }
        (void)hipGetLastError();
        grid_blocks = cus * per_cu;
    }
    if (grid_blocks < 0) return;
    Args a{};
    const float** ip = (const float**)&a.in;
    for (int i = 0; i < 13; ++i) ip[i] = (const float*)d_in[i];
    a.out = (float*)d_out; a.ws = (unsigned char*)d_ws;
    if (hipMemsetAsync((char*)d_ws + WS_CTL, 0, ZERO_BYTES, stream) != hipSuccess) { fprintf(stderr, "kernel_launch: memset failed\n"); return; }
#if MK_MULTI
    for (int ph = 0; ph < N_PHASES; ++ph) { a.ph_lo = ph; a.ph_hi = ph + 1; hipLaunchKernelGGL(fwd_megakernel, dim3(grid_blocks), dim3(NTHR), LDS_BYTES, stream, a); }
#else
    a.ph_lo = 0; a.ph_hi = N_PHASES;
    void* args[] = {&a};
    hipError_t e = hipLaunchCooperativeKernel((const void*)fwd_megakernel, dim3(grid_blocks), dim3(NTHR), args, LDS_BYTES, stream);
    if (e != hipSuccess) fprintf(stderr, "cooperative launch failed: %s (grid %d)\n", hipGetErrorString(e), grid_blocks);
#endif
}
```

```cpp
#include <hip/hip_runtime.h>
#include <hip/hip_cooperative_groups.h>
#include <cstdio>
#include <cstdint>
namespace cg = cooperative_groups;
namespace pg8 {
#define PG8_LAS __attribute__((address_space(3)))
typedef unsigned short bf16_t;
typedef short bf16x8 __attribute__((ext_vector_type(8)));
typedef float f32x4 __attribute__((ext_vector_type(4)));
typedef unsigned u32x4 __attribute__((ext_vector_type(4)));
constexpr int BM = 256, BK = 64, HALF = 128, HTB = HALF * BK * 2  , STAGE_BYTES = 8 * HTB, NXCD = 8, WGM = 8;

__host__ __device__ __forceinline__ int lds_byte(int r, int c) { const int st = (r >> 4) * 2 + (c >> 5), rr = r & 15, cc = c & 31, ob = rr * 64 + cc * 2; return st * 1024 + (ob ^ (((ob >> 9) & 1) << 5)); }
__host__ __device__ __forceinline__ void stage_rc(int b, int& R, int& C) { const int st = b / 1024, sb = b % 1024, swz = sb ^ (((sb >> 9) & 1) << 5); R = (st >> 1) * 16 + swz / 64; C = (st & 1) * 32 + (swz % 64) / 2; }
__host__ __device__ __forceinline__ int perm32(int rho) { const int n = rho >> 4, i = rho & 15; return 8 * (i >> 2) + 4 * n + (i & 3); }

struct Unit { int pm, pn; };
struct Gemm { const bf16_t* A; const bf16_t* Bt; int M, N, K; size_t bstride; };

struct StaticOrder {
    int nM, nN, nwg, G, c;
    __host__ __device__ void init(int M, int N, int G_, int c_) { nM = M / BM; nN = N / BM; nwg = nM * nN; G = G_; c = c_; }
    __host__ __device__ bool next(int i, Unit& u) const {
        const long L = (long)i * G + c; if (L >= nwg) return false;
        int wgid = (int)L; { const int q = nwg / NXCD, r = nwg % NXCD, xcd = wgid % NXCD, off = wgid / NXCD; wgid = (xcd < r ? xcd * (q + 1) : r * (q + 1) + (xcd - r) * q) + off; }
        const int nig = WGM * nN, gid = wgid / nig, fm = gid * WGM, gsz = (nM - fm) < WGM ? (nM - fm) : WGM;
        u.pm = fm + ((wgid % nig) % gsz); u.pn = (wgid % nig) / gsz; return true;
    }
    __device__ __forceinline__ void a_ready(const Unit&) const {}
    __device__ __forceinline__ void done(const Unit&) const {}
};

typedef unsigned u32x2 __attribute__((ext_vector_type(2)));
__device__ __forceinline__ unsigned cvt_pk_bf16(float lo, float hi) { typedef float f2 __attribute__((ext_vector_type(2))); typedef __bf16 b2 __attribute__((ext_vector_type(2)));
    f2 v = {lo, hi}; b2 b = __builtin_convertvector(v, b2); return __builtin_bit_cast(unsigned, b); }
__device__ __forceinline__ float silu_f(float g) { return g * __builtin_amdgcn_rcpf(1.0f + __builtin_amdgcn_exp2f(-1.4426950408889634f * g)); }

struct EpiSwiglu {
    static constexpr bool PERM = true, AFTER_DRAIN = false;
    bf16_t* O; int ldc;
    const float* rss; const float* sw;
    __device__ __forceinline__ void operator()(const f32x4 (&acc)[2][2][4][2], const Unit& u, int wr, int wc, int fr, int fq) const {
        const int row0 = u.pm * BM + wr * 64 + fr, col0 = u.pn * HALF + wc * 32 + 8 * fq;
        const float* swp = sw + (size_t)((u.pm * BM) >> 13) * (2 * 2816) + u.pn * BM + wc * 32 + 8 * fq;
        f32x4 sv[2][2];
#pragma unroll
        for (int bj = 0; bj < 2; ++bj)
#pragma unroll
            for (int n = 0; n < 2; ++n) sv[bj][n] = *(const f32x4*)(swp + bj * HALF + 4 * n);
        float rsv[2][4];
#pragma unroll
        for (int ai = 0; ai < 2; ++ai)
#pragma unroll
            for (int m = 0; m < 4; ++m) rsv[ai][m] = rss[row0 + ai * HALF + m * 16];
#pragma unroll
        for (int ai = 0; ai < 2; ++ai)
#pragma unroll
            for (int m = 0; m < 4; ++m) {
                const float rs = __builtin_amdgcn_rsqf(rsv[ai][m] * (1.0f / 1024.0f) + 1e-6f);
                const f32x4 g0 = acc[ai][0][m][0] * rs + sv[0][0], g1 = acc[ai][0][m][1] * rs + sv[0][1], u0 = acc[ai][1][m][0] * rs + sv[1][0], u1 = acc[ai][1][m][1] * rs + sv[1][1];
                u32x4 w;
                w.x = cvt_pk_bf16(silu_f(g0[0]) * u0[0], silu_f(g0[1]) * u0[1]); w.y = cvt_pk_bf16(silu_f(g0[2]) * u0[2], silu_f(g0[3]) * u0[3]);
                w.z = cvt_pk_bf16(silu_f(g1[0]) * u1[0], silu_f(g1[1]) * u1[1]); w.w = cvt_pk_bf16(silu_f(g1[2]) * u1[2], silu_f(g1[3]) * u1[3]);
                *(u32x4*)(O + (size_t)(row0 + ai * HALF + m * 16) * ldc + col0) = w;
            }
    }
};
struct EpiWin {
    static constexpr bool PERM = true, AFTER_DRAIN = false;
    bf16_t* O; int ldc; bf16_t* QKV; const float* qg; const float* kg; float qscale; const float* rss; const float* sw;
    __device__ __forceinline__ void operator()(const f32x4 (&acc)[2][2][4][2], const Unit& u, int wr, int wc, int fr, int fq) const {
        const int row0 = u.pm * BM + wr * 64 + fr, col0 = u.pn * BM + wc * 64 + 8 * fq;
        const int kind = u.pn < 2 ? 1 : (u.pn < 4 ? 2 : 0);
        f32x4 gv[2][2];
#pragma unroll
        for (int bj = 0; bj < 2; ++bj)
#pragma unroll
            for (int n = 0; n < 2; ++n) gv[bj][n] = kind ? *(const f32x4*)((kind == 1 ? qg : kg) + 32 * bj + 8 * fq + 4 * n) : (f32x4){1.f, 1.f, 1.f, 1.f};
        const float ks = kind == 1 ? qscale : 1.0f;
        const float* swp = sw + (size_t)((u.pm * BM) >> 13) * (2 * 2816) + u.pn * BM + wc * 32 + 8 * fq;
        f32x4 sv[2][2];
#pragma unroll
        for (int bj = 0; bj < 2; ++bj)
#pragma unroll
            for (int n = 0; n < 2; ++n) sv[bj][n] = *(const f32x4*)(swp + bj * HALF + 4 * n);
        float rsv[2][4];
#pragma unroll
        for (int ai = 0; ai < 2; ++ai)
#pragma unroll
            for (int m = 0; m < 4; ++m) rsv[ai][m] = rss[row0 + ai * HALF + m * 16];
#pragma unroll
        for (int ai = 0; ai < 2; ++ai)
#pragma unroll
            for (int m = 0; m < 4; ++m) {
                const float rn = __builtin_amdgcn_rsqf(rsv[ai][m] * (1.0f / 1024.0f) + 1e-6f);
                f32x4 hv[2][2];
#pragma unroll
                for (int bj = 0; bj < 2; ++bj)
#pragma unroll
                    for (int n = 0; n < 2; ++n) hv[bj][n] = acc[ai][bj][m][n] * rn + sv[bj][n];
                float rs = 1.0f;
                if (kind) {
                    float ss = 0.f;
#pragma unroll
                    for (int bj = 0; bj < 2; ++bj)
#pragma unroll
                        for (int n = 0; n < 2; ++n) { const f32x4 x = hv[bj][n]; ss += (x[0] * x[0] + x[1] * x[1]) + (x[2] * x[2] + x[3] * x[3]); }
                    ss += __shfl_xor(ss, 16); ss += __shfl_xor(ss, 32);
                    rs = ks * __builtin_amdgcn_rsqf(ss * (1.0f / 64.0f) + 1e-6f);
                }
                const int row = row0 + ai * HALF + m * 16;
                const int tk = row & 8191, tp = (tk & ~2047) | ((tk & 15) << 7) | ((tk & 2047) >> 4);
                if (u.pn >= 8) {
                    const f32x4 p0 = hv[0][0] * hv[1][0], p1 = hv[0][1] * hv[1][1];
                    u32x4 w; w.x = cvt_pk_bf16(p0[0], p0[1]); w.y = cvt_pk_bf16(p0[2], p0[3]); w.z = cvt_pk_bf16(p1[0], p1[1]); w.w = cvt_pk_bf16(p1[2], p1[3]);
                    *(u32x4*)(O + (size_t)row * ldc + 512 + 128 * (u.pn - 8) + 32 * wc + 8 * fq) = w;
                    continue;
                }
                const size_t hrow = (size_t)((row >> 13) * 8 + (u.pn & 1) * 4 + wc) * 8192 + tp;
                bf16_t* rowp = u.pn < 2 ? QKV + hrow * 64 + 8 * fq : u.pn < 6 ? QKV + (size_t)4 * 8 * 8192 * 64 + hrow * 128 + ((u.pn >> 1) - 1) * 64 + 8 * fq
                                        : O + (size_t)row * ldc + (col0 - 1536);
#pragma unroll
                for (int bj = 0; bj < 2; ++bj) {
                    const f32x4 v0 = hv[bj][0] * (gv[bj][0] * rs), v1 = hv[bj][1] * (gv[bj][1] * rs);
                    u32x4 w; w.x = cvt_pk_bf16(v0[0], v0[1]); w.y = cvt_pk_bf16(v0[2], v0[3]); w.z = cvt_pk_bf16(v1[0], v1[1]); w.w = cvt_pk_bf16(v1[2], v1[3]);
                    *(u32x4*)(rowp + 32 * bj) = w;
                }
            }
    }
};
struct EpiResid {
    static constexpr bool PERM = true, AFTER_DRAIN = false;
    struct P { const bf16_t* xinb; float* out; bf16_t* outb; const float* gate; float* rss; float gs; int flags; };
    const PG8_LAS P* pp;
    __device__ __forceinline__ void operator()(const f32x4 (&acc)[2][2][4][2], const Unit& u, int wr, int wc, int fr, int fq) const {
#define PG8_GAS __attribute__((address_space(1)))
        const PG8_GAS bf16_t* xinb = (const PG8_GAS bf16_t*)pp->xinb; PG8_GAS float* out = (PG8_GAS float*)pp->out; PG8_GAS bf16_t* outb = (PG8_GAS bf16_t*)pp->outb; const PG8_GAS float* gate = (const PG8_GAS float*)pp->gate;
        PG8_GAS float* rss = (PG8_GAS float*)pp->rss; const float gs = pp->gs; const int flags = pp->flags; const bool has = flags & 1, outf = flags & 4;
        const int b = (u.pm * BM) >> 13;
        const PG8_GAS float* gp = gate + (size_t)b * 9216;
        const int row0 = u.pm * BM + wr * 64 + fr, col0 = u.pn * BM + wc * 32 + 8 * fq;
        f32x4 gv[2][2];
#pragma unroll
        for (int bj = 0; bj < 2; ++bj)
#pragma unroll
            for (int n = 0; n < 2; ++n) gv[bj][n] = *(const PG8_GAS f32x4*)(gp + col0 + bj * HALF + n * 4) * gs;
#pragma unroll
        for (int ai = 0; ai < 2; ++ai) {
            u32x4 xa[2][4][2];
#pragma unroll
            for (int m = 0; m < 4; ++m)
#pragma unroll
                for (int bj = 0; bj < 2; ++bj) xa[ai][m][bj] = *(const PG8_GAS u32x4*)(xinb + (size_t)(row0 + ai * HALF + m * 16) * 1024 + col0 + bj * HALF);
#pragma unroll
            for (int m = 0; m < 4; ++m) { const int row = row0 + ai * HALF + m * 16; const size_t off = (size_t)row * 1024 + col0; float ss = 0.f;
#pragma unroll
                for (int bj = 0; bj < 2; ++bj) {
                    const u32x4 t = xa[ai][m][bj];
                    const f32x4 x0 = (f32x4){__uint_as_float(t.x << 16), __uint_as_float(t.x & 0xffff0000u), __uint_as_float(t.y << 16), __uint_as_float(t.y & 0xffff0000u)};
                    const f32x4 x1 = (f32x4){__uint_as_float(t.z << 16), __uint_as_float(t.z & 0xffff0000u), __uint_as_float(t.w << 16), __uint_as_float(t.w & 0xffff0000u)};
                    const f32x4 o0 = x0 + gv[bj][0] * acc[ai][bj][m][0], o1 = x1 + gv[bj][1] * acc[ai][bj][m][1];
                    if (outf) { *(PG8_GAS f32x4*)(out + off + bj * HALF) = o0; *(PG8_GAS f32x4*)(out + off + bj * HALF + 4) = o1; }
                    else { u32x4 w; w.x = cvt_pk_bf16(o0[0], o0[1]); w.y = cvt_pk_bf16(o0[2], o0[3]); w.z = cvt_pk_bf16(o1[0], o1[1]); w.w = cvt_pk_bf16(o1[2], o1[3]); *(PG8_GAS u32x4*)(outb + off + bj * HALF) = w; }
                    if (has) { ss += ((o0[0] * o0[0] + o0[1] * o0[1]) + (o0[2] * o0[2] + o0[3] * o0[3])) + ((o1[0] * o1[0] + o1[1] * o1[1]) + (o1[2] * o1[2] + o1[3] * o1[3])); } }
                if (has) { ss += __shfl_xor(ss, 16); ss += __shfl_xor(ss, 32);
                    if (fq == 0) __hip_atomic_fetch_add((float*)(rss + row), ss, __ATOMIC_RELAXED, __HIP_MEMORY_SCOPE_AGENT); } }
            asm volatile("" ::: "memory"); }
    }
};
template <class Epi, class Sched, bool ALIGN_EPI = false, bool SP2 = false>
__device__ __forceinline__ void gemm_phase(PG8_LAS unsigned char* lds, const int tid, const Gemm g, const Sched& S, const Epi& E) {
    const int wid = __builtin_amdgcn_readfirstlane(tid >> 6), lane = tid & 63, wr = wid >> 2, wc = wid & 3, fr = lane & 15, fq = lane >> 4;
    const int K = g.K, nt = K / BK;
    unsigned voffA[2], voffB[2];
#pragma unroll
    for (int i = 0; i < 2; ++i) { int R, C; stage_rc(tid * 16 + i * 8192, R, C); const int Rb = Epi::PERM ? ((R & ~31) + perm32(R & 31)) : R;
        voffA[i] = (unsigned)(R * K + C) * 2u; voffB[i] = (unsigned)(Rb * K + C) * 2u; }
    const size_t kstep = (size_t)(BK * 2);
    const size_t hstep = (size_t)HALF * K * 2;
    const size_t tstep = 2 * hstep;
    const unsigned ldsw = (unsigned)wid * 1024u;
    const int aoff = lds_byte(wr * 64 + fr, fq * 8), boff = lds_byte(wc * 32 + fr, fq * 8);
#define PG8_SA(b, h) (((b) * 2 + (h)) * HTB)
#define PG8_SB(b, h) ((4 + (b) * 2 + (h)) * HTB)
#define PG8_STAGE(bufoff, gbase, voff) do { _Pragma("unroll") for (int _i = 0; _i < 2; ++_i) \
        __builtin_amdgcn_global_load_lds((const unsigned*)((const char*)(gbase) + (voff)[_i]), (PG8_LAS unsigned*)(lds + (bufoff) + ldsw + _i * 8192), 16, 0, 0); } while (0)
#define PG8_LDA(dst, b, h) do { _Pragma("unroll") for (int m = 0; m < 4; ++m) _Pragma("unroll") for (int k = 0; k < 2; ++k) dst[m][k] = *(const PG8_LAS bf16x8*)(lds + PG8_SA(b, h) + aoff + m * 2048 + k * 1024); } while (0)
#define PG8_LDB(dst, b, h) do { _Pragma("unroll") for (int n = 0; n < 2; ++n) _Pragma("unroll") for (int k = 0; k < 2; ++k) dst[n][k] = *(const PG8_LAS bf16x8*)(lds + PG8_SB(b, h) + boff + n * 2048 + k * 1024); } while (0)
#define PG8_MMA(ai, bj, At, Bt) do { __builtin_amdgcn_s_setprio(1); _Pragma("unroll") for (int m = 0; m < 4; ++m) _Pragma("unroll") for (int n = 0; n < 2; ++n) _Pragma("unroll") for (int k = 0; k < 2; ++k) \
        acc[ai][bj][m][n] = __builtin_amdgcn_mfma_f32_16x16x32_bf16(Bt[n][k], At[m][k], acc[ai][bj][m][n], 0, 0, 0); __builtin_amdgcn_s_setprio(0); } while (0)
#define PG8_WAIT_V(n) asm volatile("s_waitcnt vmcnt(" #n ")" ::: "memory")
#define PG8_WAIT_L(n) asm volatile("s_waitcnt lgkmcnt(" #n ")" ::: "memory")
#define PG8_BAR __builtin_amdgcn_s_barrier()
#define PG8_SCHED __builtin_amdgcn_sched_barrier(0)
    Unit cur, nxt; int ui = 0;
    if (!S.next(0, cur)) return;
    f32x4 acc[2][2][4][2];
#pragma unroll
    for (int a = 0; a < 2; ++a)
#pragma unroll
        for (int b = 0; b < 2; ++b)
#pragma unroll
            for (int m = 0; m < 4; ++m)
#pragma unroll
                for (int n = 0; n < 2; ++n) acc[a][b][m][n] = (f32x4){0.f, 0.f, 0.f, 0.f};
    bf16x8 At[4][2], B0[2][2], B1[2][2];
    const char* cA = (const char*)g.A + (size_t)cur.pm * tstep; const char* cB = (const char*)g.Bt + (size_t)cur.pn * tstep + (size_t)(cur.pm >> 5) * g.bstride;
    S.a_ready(cur);
    if constexpr (SP2) {
        PG8_STAGE(PG8_SB(0, 0), cB, voffB); PG8_STAGE(PG8_SB(0, 1), cB + hstep, voffB); PG8_STAGE(PG8_SA(0, 0), cA, voffA); PG8_STAGE(PG8_SA(0, 1), cA + hstep, voffA);
        if (wr == 1) PG8_BAR;
        PG8_WAIT_V(2); PG8_BAR;
        PG8_STAGE(PG8_SB(1, 0), cB + kstep, voffB); PG8_STAGE(PG8_SA(1, 0), cA + kstep, voffA); PG8_STAGE(PG8_SB(1, 1), cB + hstep + kstep, voffB);
        PG8_WAIT_V(6); PG8_BAR;
    } else {
        PG8_STAGE(PG8_SB(0, 0), cB, voffB); PG8_STAGE(PG8_SA(0, 0), cA, voffA); PG8_STAGE(PG8_SB(0, 1), cB + hstep, voffB); PG8_STAGE(PG8_SA(0, 1), cA + hstep, voffA);
        if (wr == 1) PG8_BAR;
        PG8_WAIT_V(4); PG8_BAR;
        PG8_STAGE(PG8_SB(1, 0), cB + kstep, voffB); PG8_STAGE(PG8_SA(1, 0), cA + kstep, voffA); PG8_STAGE(PG8_SB(1, 1), cB + hstep + kstep, voffB);
        PG8_WAIT_V(6); PG8_BAR;
    }
    for (;;) {
        const bool has_next = S.next(ui + 1, nxt);
        const char* nA = has_next ? (const char*)g.A + (size_t)nxt.pm * tstep : cA; const char* nB = has_next ? (const char*)g.Bt + (size_t)nxt.pn * tstep + (size_t)(nxt.pm >> 5) * g.bstride : cB;
        for (int t = 0; t < nt; t += 2) {
            const bool last = (t == nt - 2);
            const char* a1 = cA + (size_t)(t + 1) * kstep;
            const char* a2 = last ? nA : cA + (size_t)(t + 2) * kstep; const char* b2 = last ? nB : cB + (size_t)(t + 2) * kstep;
            const char* a3 = a2 + kstep; const char* b3 = b2 + kstep;
            if (last && has_next) S.a_ready(nxt);
            if constexpr (SP2) {
            PG8_LDB(B0, 0, 0); PG8_LDB(B1, 0, 1); PG8_SCHED; PG8_LDA(At, 0, 0); PG8_STAGE(PG8_SA(1, 1), a1 + hstep, voffA);
            PG8_WAIT_V(8); PG8_WAIT_L(0); PG8_BAR; PG8_MMA(0, 0, At, B0); PG8_MMA(0, 1, At, B1); PG8_BAR; PG8_SCHED;
            PG8_LDA(At, 0, 1); PG8_STAGE(PG8_SB(0, 0), b2, voffB); PG8_STAGE(PG8_SB(0, 1), b2 + hstep, voffB); PG8_STAGE(PG8_SA(0, 0), a2, voffA);
            PG8_WAIT_V(8); PG8_WAIT_L(0); PG8_BAR; PG8_MMA(1, 0, At, B0); PG8_MMA(1, 1, At, B1); PG8_BAR; PG8_SCHED;
            PG8_LDB(B0, 1, 0); PG8_LDB(B1, 1, 1); PG8_SCHED; PG8_LDA(At, 1, 0); PG8_STAGE(PG8_SA(0, 1), a2 + hstep, voffA);
            PG8_WAIT_V(8); PG8_WAIT_L(0); PG8_BAR; PG8_MMA(0, 0, At, B0); PG8_MMA(0, 1, At, B1); PG8_BAR; PG8_SCHED;
            PG8_LDA(At, 1, 1); PG8_STAGE(PG8_SB(1, 0), b3, voffB); PG8_STAGE(PG8_SB(1, 1), b3 + hstep, voffB); PG8_STAGE(PG8_SA(1, 0), a3, voffA);
            PG8_WAIT_V(8); PG8_WAIT_L(0); PG8_BAR; PG8_MMA(1, 0, At, B0); PG8_MMA(1, 1, At, B1); PG8_BAR; PG8_SCHED;
            } else {
            PG8_LDB(B0, 0, 0); PG8_SCHED; PG8_LDA(At, 0, 0); PG8_STAGE(PG8_SA(1, 1), a1 + hstep, voffA);
            PG8_WAIT_L(8); PG8_BAR; PG8_WAIT_L(0); PG8_MMA(0, 0, At, B0); PG8_BAR; PG8_SCHED;
            PG8_LDB(B1, 0, 1); PG8_STAGE(PG8_SB(0, 0), b2, voffB);
            PG8_BAR; PG8_WAIT_L(0); PG8_MMA(0, 1, At, B1); PG8_BAR;
            PG8_LDA(At, 0, 1); PG8_STAGE(PG8_SA(0, 0), a2, voffA);
            PG8_BAR; PG8_WAIT_L(0); PG8_MMA(1, 0, At, B0); PG8_BAR; PG8_SCHED;
            PG8_STAGE(PG8_SB(0, 1), b2 + hstep, voffB);
            PG8_WAIT_V(6); PG8_BAR; PG8_MMA(1, 1, At, B1); PG8_BAR;
            PG8_LDB(B0, 1, 0); PG8_SCHED; PG8_LDA(At, 1, 0); PG8_STAGE(PG8_SA(0, 1), a2 + hstep, voffA);
            PG8_WAIT_L(8); PG8_BAR; PG8_WAIT_L(0); PG8_MMA(0, 0, At, B0); PG8_BAR; PG8_SCHED;
            PG8_LDB(B1, 1, 1); PG8_STAGE(PG8_SB(1, 0), b3, voffB);
            PG8_BAR; PG8_WAIT_L(0); PG8_MMA(0, 1, At, B1); PG8_BAR;
            PG8_LDA(At, 1, 1); PG8_STAGE(PG8_SA(1, 0), a3, voffA);
            PG8_BAR; PG8_WAIT_L(0); PG8_MMA(1, 0, At, B0); PG8_BAR; PG8_SCHED;
            PG8_STAGE(PG8_SB(1, 1), b3 + hstep, voffB);
            PG8_WAIT_V(6); PG8_BAR; PG8_MMA(1, 1, At, B1); PG8_BAR;
            }
        }
        if constexpr (ALIGN_EPI) { if (wr == 0) PG8_BAR; }
        if constexpr (!Epi::AFTER_DRAIN) { E(acc, cur, wr, wc, fr, fq); S.done(cur); }
        if (!has_next) break;
#pragma unroll
        for (int a = 0; a < 2; ++a)
#pragma unroll
            for (int b = 0; b < 2; ++b)
#pragma unroll
                for (int m = 0; m < 4; ++m)
#pragma unroll
                    for (int n = 0; n < 2; ++n) acc[a][b][m][n] = (f32x4){0.f, 0.f, 0.f, 0.f};
        cur = nxt; cA = nA; cB = nB; ++ui;
        if constexpr (ALIGN_EPI) { if (wr == 1) PG8_BAR; }
    }
    PG8_WAIT_V(0);
    if constexpr (!ALIGN_EPI) { if (wr == 0) PG8_BAR; }
    PG8_BAR;
    if constexpr (Epi::AFTER_DRAIN) { E.fused(acc, cur, wr, wc, fr, fq, lds, wid, lane); S.done(cur); }
#undef PG8_SA
#undef PG8_SB
#undef PG8_STAGE
#undef PG8_LDA
#undef PG8_LDB
#undef PG8_MMA
#undef PG8_WAIT_V
#undef PG8_WAIT_L
#undef PG8_BAR
#undef PG8_SCHED
}
}

#define LAS __attribute__((address_space(3)))
typedef unsigned short bf16_t;
typedef short bf16x8 __attribute__((ext_vector_type(8)));
typedef short s16x4 __attribute__((ext_vector_type(4)));
typedef float f32x4 __attribute__((ext_vector_type(4)));
typedef float f32x16 __attribute__((ext_vector_type(16)));
typedef unsigned u32x4 __attribute__((ext_vector_type(4)));
typedef unsigned u32x2 __attribute__((ext_vector_type(2)));
constexpr int DM = 1024, NB = 4, SEQ = 8192, DEPTH = 2, FF = 2816, NH = 8, HD = 64, AW = 512, INC = 3072, MODW = 9216;
constexpr int M = NB * SEQ;
constexpr float EPS = 1e-6f;
constexpr float QSCALE = 0.125f * 1.4426950408889634f;
constexpr float NEGBIG = -1e30f;
constexpr int NWAVES = 8, NTHR = 512;
constexpr size_t MiB = 1u << 20;
constexpr size_t WS_MOD = 0;
constexpr size_t WS_ST = MiB / 2;
constexpr size_t WS_GT = 3 * MiB / 4;
constexpr size_t WS_CTL = 1 * MiB, CTL_BYTES = 16384;
constexpr int NSW = 2 * FF;
constexpr size_t WS_SW = WS_CTL + CTL_BYTES, SW_BYTES = (size_t)DEPTH * 3 * NB * NSW * 4;
constexpr size_t WS_RSS = WS_SW + SW_BYTES, RSS_BYTES = (size_t)DEPTH * 3 * M * 4;
constexpr size_t ZERO_BYTES = CTL_BYTES + SW_BYTES + RSS_BYTES;
constexpr size_t WS_W = 5 * MiB / 2;
static_assert(WS_CTL + ZERO_BYTES <= WS_W, "zeroed region");
constexpr size_t W1_BYTES = (size_t)2 * FF * DM * 2, W2_BYTES = (size_t)DM * FF * 2, WIN_BYTES = (size_t)INC * DM * 2, WOUT_BYTES = (size_t)DM * DM * 2;
constexpr size_t LW_W1 = 0, LW_WIN = 2 * NB * W1_BYTES, LW_W2 = LW_WIN + NB * WIN_BYTES, LW_WOUT = LW_W2 + 2 * W2_BYTES, LW_BYTES = LW_WOUT + WOUT_BYTES;
static_assert(WS_W + DEPTH * LW_BYTES <= 253 * MiB, "weights");
constexpr size_t WS_ACT = 253 * MiB;
constexpr size_t WS_QKV = WS_ACT + 96 * MiB;
constexpr size_t WS_XB = 445 * MiB;
constexpr size_t WS_LSE = 509 * MiB;
constexpr size_t WS_END = 511 * MiB;
constexpr size_t OUT_O23 = 0, OUT_YC = 64 * MiB;
constexpr int RING_BYTES = 131072, WSCR_OFF = RING_BYTES, MISC_OFF = RING_BYTES + NWAVES * 512, LDS_BYTES = MISC_OFF + 256;

__device__ __forceinline__ float bf_lo(unsigned u) { return __uint_as_float(u << 16); }
__device__ __forceinline__ float bf_hi(unsigned u) { return __uint_as_float(u & 0xffff0000u); }
__device__ __forceinline__ float wave_sum(float v) {
#pragma unroll
    for (int o = 1; o < 64; o <<= 1) v += __shfl_xor(v, o);
    return v;
}
using pg8::cvt_pk_bf16;

struct In { const float *x, *c, *w_ada, *b_ada, *norm_g, *w_in, *q_g, *k_g, *conv_w, *conv_b, *w_out, *w1, *w2; };

__device__ __forceinline__ void mod_phase(const In& I, unsigned char* ws, LAS unsigned char* lds, int tid, int lane, int wave) {
    LAS float* sc = (LAS float*)(lds + 69632);
    LAS float* red = (LAS float*)(lds + 69632 + 16384);
    float* mod = (float*)(ws + WS_MOD); float* ST = (float*)(ws + WS_ST); float* GT = (float*)(ws + WS_GT);
    for (int i = tid; i < NB * DM; i += NTHR) { const float v = I.c[i]; sc[i] = v / (1.0f + __expf(-v)); }
    __syncthreads();
    typedef float f32x2 __attribute__((ext_vector_type(2)));
    for (int it = blockIdx.x; it < DEPTH * (MODW / 72); it += gridDim.x) {
        const int l = it / (MODW / 72), j0 = (it % (MODW / 72)) * 72;
        const int ln = lane < 36 ? lane : 35;
        const float* wp = I.w_ada + (size_t)l * DM * MODW + j0 + 2 * ln;
        f32x2 a0 = {0.f, 0.f}, a1 = a0, a2 = a0, a3 = a0; const int k0 = wave * 128;
#pragma unroll 16
        for (int k = k0; k < k0 + 128; ++k) { const f32x2 w = *(const f32x2*)(wp + (size_t)k * MODW); a0 += w * sc[k]; a1 += w * sc[DM + k]; a2 += w * sc[2 * DM + k]; a3 += w * sc[3 * DM + k]; }
        if (lane < 36) { LAS float* rp = red + wave * 4 * 72 + 2 * lane; rp[0] = a0.x; rp[1] = a0.y; rp[72] = a1.x; rp[73] = a1.y; rp[144] = a2.x; rp[145] = a2.y; rp[216] = a3.x; rp[217] = a3.y; }
        __syncthreads();
        if (tid < 288) { const int b = tid / 72, cl = tid % 72; float s = 0.f;
#pragma unroll
            for (int w = 0; w < 8; ++w) s += red[(w * 4 + b) * 72 + cl];
            const int j = j0 + cl; const float v = s + I.b_ada[(size_t)l * MODW + j];
            mod[(size_t)(l * NB + b) * MODW + j] = v;
            const int sub = j / 3072, jj = j % 3072; if (jj < DM) ST[((size_t)(l * 3 + sub) * DM + jj) * NB + b] = v;
            else if (jj < 2 * DM) GT[((size_t)(l * 3 + sub) * DM + jj - DM) * NB + b] = I.norm_g[(size_t)(l * 3 + sub) * DM + jj - DM] * (1.0f + v); }
        __syncthreads();
    }
}
__device__ __forceinline__ void transpose_item(const float* W, int K, int N, bf16_t* WT, int k0, int src_n0, int dst_n0, LAS float* scr, int lane, const float* st, float* sw, const float* gt, size_t cstride) {
    { f32x4 v[8]; const int c4 = lane & 7, kr = lane >> 3;
#pragma unroll
        for (int i = 0; i < 8; ++i) v[i] = *(const f32x4*)(W + (size_t)(k0 + 8 * i + kr) * N + src_n0 + 4 * c4);
#pragma unroll
        for (int i = 0; i < 8; ++i) { LAS float* d = scr + (8 * i + kr) * 33 + 4 * c4; d[0] = v[i].x; d[1] = v[i].y; d[2] = v[i].z; d[3] = v[i].w; } }
    asm volatile("s_waitcnt lgkmcnt(0)" ::: "memory");
    const int c = lane & 7;
    if (!gt) {
#pragma unroll
        for (int j = 0; j < 4; ++j) { const int n = (lane >> 3) + 8 * j; const LAS float* s = scr + (8 * c) * 33 + n;
            u32x4 o; o.x = cvt_pk_bf16(s[0 * 33], s[1 * 33]); o.y = cvt_pk_bf16(s[2 * 33], s[3 * 33]); o.z = cvt_pk_bf16(s[4 * 33], s[5 * 33]); o.w = cvt_pk_bf16(s[6 * 33], s[7 * 33]);
            *(u32x4*)(WT + (size_t)(dst_n0 + n) * K + k0 + 8 * c) = o; }
    } else {
        f32x4 gk[8];
#pragma unroll
        for (int i = 0; i < 8; ++i) gk[i] = *(const f32x4*)(gt + (size_t)(k0 + 8 * c + i) * NB);
#pragma unroll
        for (int j = 0; j < 4; ++j) { const int n = (lane >> 3) + 8 * j; const LAS float* s = scr + (8 * c) * 33 + n;
            float w[8];
#pragma unroll
            for (int i = 0; i < 8; ++i) w[i] = s[i * 33];
#pragma unroll
            for (int b = 0; b < NB; ++b) {
                u32x4 o; o.x = cvt_pk_bf16(w[0] * gk[0][b], w[1] * gk[1][b]); o.y = cvt_pk_bf16(w[2] * gk[2][b], w[3] * gk[3][b]); o.z = cvt_pk_bf16(w[4] * gk[4][b], w[5] * gk[5][b]); o.w = cvt_pk_bf16(w[6] * gk[6][b], w[7] * gk[7][b]);
                *(u32x4*)(WT + (size_t)b * cstride + (size_t)(dst_n0 + n) * K + k0 + 8 * c) = o; } }
    }
    if (st) { const int n = lane & 31, hf = lane >> 5; f32x4 a4 = {0.f, 0.f, 0.f, 0.f};
#pragma unroll 8
        for (int i = 0; i < 32; ++i) { const int kk = hf * 32 + i; a4 += *(const f32x4*)(st + (size_t)(k0 + kk) * NB) * scr[kk * 33 + n]; }
#pragma unroll
        for (int b = 0; b < 4; ++b) a4[b] += __shfl_xor(a4[b], 32);
        if (hf == 0) {
#pragma unroll
            for (int b = 0; b < 4; ++b) __hip_atomic_fetch_add(sw + (size_t)b * NSW + dst_n0 + n, a4[b], __ATOMIC_RELAXED, __HIP_MEMORY_SCOPE_AGENT); } }
    asm volatile("s_waitcnt lgkmcnt(0)" ::: "memory");
}
__device__ __forceinline__ void weights_phase(const In& I, unsigned char* ws, LAS unsigned char* lds, int tid, int lane, int wave, float* SW) {
    LAS float* scr = (LAS float*)(lds + wave * 8448);
    const int gw = blockIdx.x * NWAVES + wave, NGW = gridDim.x * NWAVES;
    const float* ST = (const float*)(ws + WS_ST); const float* GT = (const float*)(ws + WS_GT);
    constexpr int I_W1 = (DM / 64) * (2 * FF / 32), I_W2 = (FF / 64) * (DM / 32), I_WIN = (DM / 64) * (INC / 32), I_WOUT = (DM / 64) * (DM / 32);
    constexpr int I_LAYER = 2 * I_W1 + 2 * I_W2 + I_WIN + I_WOUT;
    for (int it = gw; it < DEPTH * I_LAYER; it += NGW) {
        const int l = it / I_LAYER; int r = it % I_LAYER;
        unsigned char* lw = ws + WS_W + (size_t)l * LW_BYTES;
        if (r < 2 * I_W1) { const int f = r / I_W1; r %= I_W1; const int nblk = 2 * FF / 32, kb = r / nblk, nb = r % nblk, n0 = nb * 32;
            const int pn = n0 >> 8, bj = (n0 >> 7) & 1, i = n0 & 127, sub = 2 * f;
            transpose_item(I.w1 + (size_t)(l * 2 + f) * DM * 2 * FF, DM, 2 * FF, (bf16_t*)(lw + LW_W1 + (size_t)f * NB * W1_BYTES), kb * 64, bj * FF + 128 * pn + i, n0, scr, lane,
                           ST + (size_t)(l * 3 + sub) * DM * NB, SW + (size_t)(l * 3 + sub) * NB * NSW, GT + (size_t)(l * 3 + sub) * DM * NB, W1_BYTES / 2); continue; }
        r -= 2 * I_W1;
        if (r < 2 * I_W2) { const int f = r / I_W2; r %= I_W2; const int nblk = DM / 32, kb = r / nblk, nb = r % nblk;
            transpose_item(I.w2 + (size_t)(l * 2 + f) * FF * DM, FF, DM, (bf16_t*)(lw + LW_W2 + f * W2_BYTES), kb * 64, nb * 32, nb * 32, scr, lane, nullptr, nullptr, nullptr, 0); continue; }
        r -= 2 * I_W2;
        if (r < I_WIN) { const int nblk = INC / 32, kb = r / nblk, nb = r % nblk, n0 = nb * 32; const int pn = n0 >> 8, bj = (n0 >> 7) & 1, wc = (n0 >> 5) & 3;
            const int srcn = pn < 8 ? 256 * pn + 64 * wc + 32 * bj : (bj ? 2560 : 2048) + 128 * (pn - 8) + 32 * wc;
            transpose_item(I.w_in + (size_t)l * DM * INC, DM, INC, (bf16_t*)(lw + LW_WIN), kb * 64, srcn, n0, scr, lane,
                           ST + (size_t)(l * 3 + 1) * DM * NB, SW + (size_t)(l * 3 + 1) * NB * NSW, GT + (size_t)(l * 3 + 1) * DM * NB, WIN_BYTES / 2); continue; }
        r -= I_WIN;
        { const int nblk = DM / 32, kb = r / nblk, nb = r % nblk;
            transpose_item(I.w_out + (size_t)l * DM * DM, DM, DM, (bf16_t*)(lw + LW_WOUT), kb * 64, nb * 32, nb * 32, scr, lane, nullptr, nullptr, nullptr, 0); }
    }
    bf16_t* XB = (bf16_t*)(ws + WS_XB); float* RSS = (float*)(ws + WS_RSS);
    for (int chunk = gw; chunk < M / 16; chunk += NGW) {
        const int row0 = chunk * 16;
        for (int r4 = 0; r4 < 16; r4 += 4) {
            f32x4 v[4][4];
#pragma unroll
            for (int q = 0; q < 4; ++q) { const f32x4* xr = (const f32x4*)(I.x + (size_t)(row0 + r4 + q) * DM) + lane;
#pragma unroll
                for (int j = 0; j < 4; ++j) v[q][j] = xr[64 * j]; }
#pragma unroll
            for (int q = 0; q < 4; ++q) { float ssq = 0.f;
#pragma unroll
                for (int j = 0; j < 4; ++j) ssq += (v[q][j].x * v[q][j].x + v[q][j].y * v[q][j].y) + (v[q][j].z * v[q][j].z + v[q][j].w * v[q][j].w);
                ssq = wave_sum(ssq);
                if (lane == 0) RSS[row0 + r4 + q] = ssq;
                u32x2* x8 = (u32x2*)(XB + (size_t)(row0 + r4 + q) * DM) + lane;
#pragma unroll
                for (int j = 0; j < 4; ++j) { u32x2 xw; xw.x = cvt_pk_bf16(v[q][j].x, v[q][j].y); xw.y = cvt_pk_bf16(v[q][j].z, v[q][j].w); x8[64 * j] = xw; } }
        }
    }
}

__device__ __forceinline__ int crow(int i, int hi) { return (i & 3) + 8 * (i >> 2) + 4 * hi; }
__device__ __forceinline__ u32x4 pair16(u32x2 wa, u32x2 wb) {
    const auto r0 = __builtin_amdgcn_permlane32_swap(wa.x, wb.x, false, false);
    const auto r1 = __builtin_amdgcn_permlane32_swap(wa.y, wb.y, false, false);
    return (u32x4){r0[0], r1[0], r0[1], r1[1]};
}
__device__ __forceinline__ int tpos(int t) { return (t & ~2047) | ((t & 15) << 7) | ((t & 2047) >> 4); }
typedef short v4i16_t __attribute__((ext_vector_type(4)));
__device__ __forceinline__ s16x4 vtr(LAS const unsigned char* p) { return __builtin_bit_cast(s16x4, __builtin_amdgcn_ds_read_tr16_b64_v4i16((LAS v4i16_t*)p)); }

struct AttnItem { int dil, b, h, r, nb, br; };
template <bool FINAL> __device__ __forceinline__ AttnItem attn_decode(int R, int wid) {
    AttnItem t; const int it = 2 * R + (wid >> 2);
    if (!FINAL) { const int br = it >> 11, rem = it & 2047, bh = rem >> 6, rn = rem & 63; t.br = br; t.dil = br ? 16 : 4; const int nbc = 64 / t.dil; t.r = rn / nbc; t.nb = rn % nbc; t.b = bh >> 3; t.h = bh & 7; }
    else { const int bh = it >> 6; t.br = 0; t.dil = 1; t.r = 0; t.nb = it & 63; t.b = bh >> 3; t.h = bh & 7; }
    return t;
}
__device__ __forceinline__ void attn_load(const bf16_t* proj, const AttnItem& t, u32x4 (&kv)[6], u32x4 (&vv)[6], int tid) {
    const int nb0 = t.nb & ~1;
    const bf16_t* kb = proj + (size_t)NB * NH * SEQ * HD + (size_t)(t.b * NH + t.h) * SEQ * 2 * HD;
#pragma unroll
    for (int c = 0; c < 6; ++c) { const int idx = tid + 512 * c, j = idx >> 3, ch = idx & 7; const int sidx = (nb0 - 1) * 128 + j;
        const int sj = sidx >= 0 ? sidx : sidx + 128;
        const bf16_t* p = kb + (size_t)tpos(sj * t.dil + t.r) * 2 * HD + ch * 8; kv[c] = *(const u32x4*)p; vv[c] = *(const u32x4*)(p + HD); }
}
__device__ __forceinline__ void attn_load_q(const bf16_t* proj, const AttnItem& t, bf16x8 (&qf)[4], int lane, int wid) {
    const int w = wid & 3, r32 = lane & 31, hi = lane >> 5;
    const size_t qrow = (size_t)(t.b * NH + t.h) * SEQ + tpos((t.nb * 128 + 32 * w + r32) * t.dil + t.r);
#pragma unroll
    for (int ks = 0; ks < 4; ++ks) qf[ks] = *(const bf16x8*)(proj + qrow * HD + 16 * ks + 8 * hi);
}
__device__ __forceinline__ void attn_stage(LAS unsigned char* lds, const u32x4 (&kv)[6], const u32x4 (&vv)[6], int tid, int wid) {
    LAS unsigned char* Kl = lds; LAS unsigned char* Vl = lds + 49152;
#pragma unroll
    for (int c = 0; c < 6; ++c) { const int idx = tid + 512 * c, j = idx >> 3, ch = idx & 7;
        *(LAS u32x4*)(Kl + j * 128 + ((ch ^ ((j >> 1) & 7)) * 16)) = kv[c];
        *(LAS u32x4*)(Vl + j * 128 + (((ch >> 2) ^ ((j >> 1) & 1)) * 64) + (ch & 3) * 16) = vv[c]; }
}
template <int T0, int NT, bool FIRST>
__device__ __forceinline__ void attn_group(LAS const unsigned char* Kl, LAS const unsigned char* Vl, const bf16x8 (&qf)[4], f32x16 (&o)[2], float& mx, float& l, int nb, int w, int lane) {
    const int r32 = lane & 31, hi = lane >> 5;
    f32x16 s[NT];
#pragma unroll
    for (int t = 0; t < NT; ++t) { const float z = (T0 + t < 4 && nb == 0 && w + T0 + t < 4) ? NEGBIG : 0.f;
        s[t] = (f32x16){z, z, z, z, z, z, z, z, z, z, z, z, z, z, z, z}; }
    {
        LAS const unsigned char* kp = Kl + (32 * (w + T0) + r32) * 128;
        const int sw = (r32 >> 1) & 7;
#pragma unroll
        for (int ks = 0; ks < 4; ++ks) {
            bf16x8 kf[NT];
#pragma unroll
            for (int t = 0; t < NT; ++t) kf[t] = *(LAS const bf16x8*)(kp + t * 4096 + (((2 * ks + hi) ^ sw) * 16));
#pragma unroll
            for (int t = 0; t < NT; ++t) s[t] = __builtin_amdgcn_mfma_f32_32x32x16_bf16(kf[t], qf[ks], s[t], 0, 0, 0);
        }
    }
#pragma unroll
    for (int t = 0; t < NT; ++t) {
        const int tt = T0 + t;
        if (tt == 0) {
#pragma unroll
            for (int i = 0; i < 16; ++i) if (crow(i, hi) < r32) s[t][i] = NEGBIG; }
        if (tt == 4) {
#pragma unroll
            for (int i = 0; i < 16; ++i) if (crow(i, hi) > r32) s[t][i] = NEGBIG; }
    }
    float m0 = s[0][0], m1 = s[0][1], m2 = s[0][2], m3 = s[0][3];
#pragma unroll
    for (int t = 0; t < NT; ++t)
#pragma unroll
        for (int i = 0; i < 16; i += 4) { m0 = fmaxf(m0, s[t][i]); m1 = fmaxf(m1, s[t][i + 1]); m2 = fmaxf(m2, s[t][i + 2]); m3 = fmaxf(m3, s[t][i + 3]); }
    float gm = fmaxf(fmaxf(m0, m1), fmaxf(m2, m3));
    gm = fmaxf(gm, __shfl_xor(gm, 32));
    if (FIRST) mx = gm;
    else { const float mn = fmaxf(mx, gm); const float f = __builtin_amdgcn_exp2f(mx - mn); l *= f; mx = mn;
#pragma unroll
        for (int d = 0; d < 2; ++d)
#pragma unroll
            for (int i = 0; i < 16; ++i) o[d][i] *= f; }
    float l0 = 0.f, l1 = 0.f, l2 = 0.f, l3 = 0.f;
#pragma unroll
    for (int t = 0; t < NT; ++t)
#pragma unroll
        for (int i = 0; i < 16; i += 4) {
            const float p0 = __builtin_amdgcn_exp2f(s[t][i] - mx), p1 = __builtin_amdgcn_exp2f(s[t][i + 1] - mx), p2 = __builtin_amdgcn_exp2f(s[t][i + 2] - mx), p3 = __builtin_amdgcn_exp2f(s[t][i + 3] - mx);
            s[t][i] = p0; s[t][i + 1] = p1; s[t][i + 2] = p2; s[t][i + 3] = p3; l0 += p0; l1 += p1; l2 += p2; l3 += p3; }
    l += (l0 + l1) + (l2 + l3);
    const int i16 = lane & 15, q4 = i16 >> 2, p4 = i16 & 3, blk = (lane >> 4) & 1;
    LAS const unsigned char* vb = Vl + (32 * (w + T0) + 4 * hi + q4) * 128 + 32 * blk + 8 * p4;
    const int vsw = ((q4 >> 1) & 1) * 64;
#pragma unroll
    for (int t = 0; t < NT; ++t)
#pragma unroll
        for (int s2 = 0; s2 < 2; ++s2) {
            u32x4 pw; pw.x = cvt_pk_bf16(s[t][8 * s2 + 0], s[t][8 * s2 + 1]); pw.y = cvt_pk_bf16(s[t][8 * s2 + 2], s[t][8 * s2 + 3]);
            pw.z = cvt_pk_bf16(s[t][8 * s2 + 4], s[t][8 * s2 + 5]); pw.w = cvt_pk_bf16(s[t][8 * s2 + 6], s[t][8 * s2 + 7]);
            const bf16x8 pf = __builtin_bit_cast(bf16x8, pw);
#pragma unroll
            for (int d = 0; d < 2; ++d) {
                LAS const unsigned char* vp = vb + (t * 32 + s2 * 16) * 128 + ((d * 64) ^ vsw);
                const s16x4 lo = vtr(vp), hi4 = vtr(vp + 8 * 128);
                const bf16x8 vf = (bf16x8){lo[0], lo[1], lo[2], lo[3], hi4[0], hi4[1], hi4[2], hi4[3]};
                o[d] = __builtin_amdgcn_mfma_f32_32x32x16_bf16(vf, pf, o[d], 0, 0, 0);
            }
        }
}
template <bool FINAL>
__device__ __forceinline__ void attn_compute(LAS unsigned char* lds, const bf16_t* proj, const AttnItem& t, const AttnItem& nxt, bool more, bf16x8 (&qf)[4], bf16_t* o23, float* lse23, bf16_t* ycat, int lane, int wid) {
    const int w = wid & 3, r32 = lane & 31, hi = lane >> 5;
    LAS unsigned char* Kl = lds + (wid >> 2) * 16384; LAS unsigned char* Vl = Kl + 49152;
    const int nb = t.nb;
    const int tok = (nb * 128 + 32 * w + r32) * t.dil + t.r;
    const size_t qrow = (size_t)t.b * SEQ + tok, hrow = (size_t)(t.b * NH + t.h) * SEQ + tpos(tok);
    float l2 = 0.f, l3 = 0.f; u32x2 a2[8], a3[8];
    if (FINAL) { l2 = lse23[hrow]; l3 = lse23[(size_t)M * NH + hrow];
        const bf16_t* o2 = o23 + hrow * HD + 4 * hi; const bf16_t* o3 = o2 + (size_t)M * AW;
#pragma unroll
        for (int i = 0; i < 8; ++i) { a2[i] = *(const u32x2*)(o2 + 32 * (i >> 2) + 8 * (i & 3)); a3[i] = *(const u32x2*)(o3 + 32 * (i >> 2) + 8 * (i & 3)); } }
    f32x16 o[2];
#pragma unroll
    for (int d = 0; d < 2; ++d) o[d] = (f32x16){0.f, 0.f, 0.f, 0.f, 0.f, 0.f, 0.f, 0.f, 0.f, 0.f, 0.f, 0.f, 0.f, 0.f, 0.f, 0.f};
    float mx = NEGBIG, l = 0.f;
    attn_group<2, 3, true>(Kl, Vl, qf, o, mx, l, nb, w, lane);
    attn_group<0, 2, false>(Kl, Vl, qf, o, mx, l, nb, w, lane);
    l += __shfl_xor(l, 32);
    attn_load_q(proj, nxt, qf, lane, wid);
    const float lse = mx + __builtin_amdgcn_logf(l);
    if (!FINAL) {
        const float c1 = 1.0f / l;
        if (hi == 0) lse23[(size_t)t.br * M * NH + hrow] = lse;
        bf16_t* ob = o23 + ((size_t)t.br * M * NH + hrow) * HD + 8 * hi;
#pragma unroll
        for (int d = 0; d < 2; ++d)
#pragma unroll
            for (int g = 0; g < 4; g += 2) { u32x2 wa, wb;
                wa.x = cvt_pk_bf16(o[d][4 * g] * c1, o[d][4 * g + 1] * c1); wa.y = cvt_pk_bf16(o[d][4 * g + 2] * c1, o[d][4 * g + 3] * c1);
                wb.x = cvt_pk_bf16(o[d][4 * g + 4] * c1, o[d][4 * g + 5] * c1); wb.y = cvt_pk_bf16(o[d][4 * g + 6] * c1, o[d][4 * g + 7] * c1);
                *(u32x4*)(ob + 32 * d + 8 * g) = pair16(wa, wb); }
    } else {
        const float mm = fmaxf(lse, fmaxf(l2, l3));
        const float e1 = __builtin_amdgcn_exp2f(lse - mm), e2 = __builtin_amdgcn_exp2f(l2 - mm), e3 = __builtin_amdgcn_exp2f(l3 - mm);
        const float inv = 1.0f / (e1 + e2 + e3);
        const float c1 = e1 * inv / l, c2 = e2 * inv, c3 = e3 * inv;
        bf16_t* yo = ycat + qrow * DM + t.h * HD + 8 * hi;
#pragma unroll
        for (int d = 0; d < 2; ++d)
#pragma unroll
            for (int g = 0; g < 4; g += 2) { u32x2 wp[2];
#pragma unroll
                for (int e = 0; e < 2; ++e) { const int gg = g + e; const u32x2 b2 = a2[4 * d + gg], b3 = a3[4 * d + gg];
                    wp[e].x = cvt_pk_bf16(c1 * o[d][4 * gg] + c2 * bf_lo(b2.x) + c3 * bf_lo(b3.x), c1 * o[d][4 * gg + 1] + c2 * bf_hi(b2.x) + c3 * bf_hi(b3.x));
                    wp[e].y = cvt_pk_bf16(c1 * o[d][4 * gg + 2] + c2 * bf_lo(b2.y) + c3 * bf_lo(b3.y), c1 * o[d][4 * gg + 3] + c2 * bf_hi(b2.y) + c3 * bf_hi(b3.y)); }
                *(u32x4*)(yo + 32 * d + 8 * g) = pair16(wp[0], wp[1]); }
    }
}
template <bool FINAL>
__device__ __forceinline__ void attn_phase(LAS unsigned char* lds, const bf16_t* proj, bf16_t* o23, float* lse23, bf16_t* ycat, int tid, int lane, int wid) {
    constexpr int NR = FINAL ? 1024 : 2048, RB = FINAL ? 32 : 64;
    const int G = gridDim.x, J = G >> 3, xcd = blockIdx.x & 7, jj = blockIdx.x >> 3;
    const bool affine = (G & 7) == 0 && J > 0 && (RB % J) == 0;
    const int SPB = affine ? RB / J : 1, NS = affine ? 4 * SPB : (NR - (int)blockIdx.x + G - 1) / G;
    auto round_of = [&](int t) -> int {
        if (!affine) return (int)blockIdx.x + t * G;
        const int sidx = t / SPB, rr = jj + J * (t % SPB), bh = 4 * xcd + sidx;
        return FINAL ? bh * 32 + rr : (rr >> 5) * 1024 + bh * 32 + (rr & 31); };
    if (NS <= 0) return;
    int t = 0;
    u32x4 kv[6], vv[6]; bf16x8 qf[4];
    AttnItem cur = attn_decode<FINAL>(round_of(0), wid);
    attn_load(proj, cur, kv, vv, tid); attn_load_q(proj, cur, qf, lane, wid);
    for (;;) {
        attn_stage(lds, kv, vv, tid, wid);
        asm volatile("s_waitcnt lgkmcnt(0)\n\ts_barrier" ::: "memory");
        const bool more = t + 1 < NS;
        const AttnItem nxt = attn_decode<FINAL>(round_of(more ? t + 1 : t), wid);
        attn_load(proj, nxt, kv, vv, tid);
        attn_compute<FINAL>(lds, proj, cur, nxt, more, qf, o23, lse23, ycat, lane, wid);
        asm volatile("s_waitcnt lgkmcnt(0)\n\ts_barrier" ::: "memory");
        if (!more) break;
        cur = nxt; ++t;
    }
}
__device__ __forceinline__ void conv_phase(const bf16_t* proj, bf16_t* ycat, const float* cw, const float* cb, int tid) {
    const int c0 = (tid & 63) * 8;
    float w0[8], w1[8], w2[8], bb[8];
#pragma unroll
    for (int e = 0; e < 8; ++e) { w0[e] = cw[c0 + e]; w1[e] = cw[AW + c0 + e]; w2[e] = cw[2 * AW + c0 + e]; bb[e] = cb[c0 + e]; }
    for (int chunk = (blockIdx.x * NTHR + tid) >> 6; chunk < M / 16; chunk += (gridDim.x * NTHR) >> 6) {
        const int row0 = chunk * 16, t0 = row0 & (SEQ - 1);
        float p1[8], p2[8];
#pragma unroll
        for (int e = 0; e < 8; ++e) { p1[e] = 0.f; p2[e] = 0.f; }
        if (t0 >= 2) {
            const bf16_t* p = proj + (size_t)(row0 - 2) * 1024 + 512 + c0;
            const u32x4 pa = *(const u32x4*)p, pb = *(const u32x4*)(p + 1024);
#pragma unroll
            for (int e = 0; e < 4; ++e) { p2[2 * e] = bf_lo(pa[e]); p2[2 * e + 1] = bf_hi(pa[e]); p1[2 * e] = bf_lo(pb[e]); p1[2 * e + 1] = bf_hi(pb[e]); }
        }
#pragma unroll 4
        for (int rr = 0; rr < 16; ++rr) {
            const bf16_t* p = proj + (size_t)(row0 + rr) * 1024 + c0;
            const u32x4 gb = *(const u32x4*)p, pc = *(const u32x4*)(p + 512);
            float p0[8], y[8];
#pragma unroll
            for (int e = 0; e < 4; ++e) { p0[2 * e] = bf_lo(pc[e]); p0[2 * e + 1] = bf_hi(pc[e]); }
#pragma unroll
            for (int e = 0; e < 8; ++e) y[e] = w2[e] * p0[e] + w1[e] * p1[e] + w0[e] * p2[e] + bb[e];
            u32x4 o;
#pragma unroll
            for (int e = 0; e < 4; ++e) o[e] = cvt_pk_bf16(bf_lo(gb[e]) * y[2 * e], bf_hi(gb[e]) * y[2 * e + 1]);
            *(u32x4*)(ycat + (size_t)(row0 + rr) * DM + AW + c0) = o;
#pragma unroll
            for (int e = 0; e < 8; ++e) { p2[e] = p1[e]; p1[e] = p0[e]; }
        }
    }
}

#define XB_TMO      128
#define XB_XCNT(j)  (256  + 64 * (j))
#define XB_XSUB(j)  (1280 + 64 * (j))
#define XB_XGEN(j)  (2304 + 64 * (j))
#define XB_TOP      3328
#define XB_TOPGEN   3392
#define XCD_BAR_WORDS 3456
#define XB_SPIN_CAP (1u << 18)

__device__ __forceinline__ unsigned xb_ld(unsigned* p)              { return __hip_atomic_load(p, __ATOMIC_RELAXED, __HIP_MEMORY_SCOPE_AGENT); }
__device__ __forceinline__ unsigned xb_add(unsigned* p, unsigned v) { return __hip_atomic_fetch_add(p, v, __ATOMIC_RELAXED, __HIP_MEMORY_SCOPE_AGENT); }
__device__ __forceinline__ unsigned xb_xcc_id() { return (unsigned)__builtin_amdgcn_s_getreg((3 << 11) | 20) & 0xFu; }
#define XB_SPIN(cond, bar) do { unsigned _sp = 0; while (cond) { __builtin_amdgcn_s_sleep(1); \
    if ((++_sp & 255u) == 0u) { if (xb_ld(&(bar)[XB_TMO])) break; if (_sp > XB_SPIN_CAP) { atomicAdd(&(bar)[XB_TMO], 1u); break; } } } } while (0)

struct XcdBarrier {
    unsigned* bar; unsigned x;
    volatile LAS unsigned* st;
};

__device__ __forceinline__ XcdBarrier xcd_barrier_post(unsigned* bar, volatile LAS unsigned* st) {
    XcdBarrier b; b.bar = bar; b.x = xb_xcc_id(); b.st = st;
    if (threadIdx.x == 0) (void)xb_add(&bar[XB_XCNT(b.x)], 1u);
    return b;
}
__device__ __forceinline__ void xcd_barrier_complete(unsigned* bar, unsigned x, unsigned& nloc, unsigned& nx) {
    const unsigned G = gridDim.x * gridDim.y * gridDim.z;
    unsigned sum, cnt, mine, sp = 0u;
    for (;;) {
        sum = 0u; cnt = 0u; mine = 0u;
#pragma unroll
        for (unsigned j = 0; j < 16; ++j) { const unsigned c = xb_ld(&bar[XB_XCNT(j)]); sum += c; cnt += (c > 0u) ? 1u : 0u; mine = (j == x) ? c : mine; }
        if (sum == G) break;
        __builtin_amdgcn_s_sleep(1);
        if ((++sp & 255u) == 0u) { if (xb_ld(&bar[XB_TMO])) break; if (sp > XB_SPIN_CAP) { atomicAdd(&bar[XB_TMO], 1u); break; } }
    }
    nloc = mine > 0u ? mine : 1u; nx = cnt > 0u ? cnt : 1u;
}

__device__ __forceinline__ void xcd_barrier(const XcdBarrier& b) {
    asm volatile("s_waitcnt vmcnt(0)" ::: "memory");
    __syncthreads();
    if (threadIdx.x == 0) {
        unsigned* bar = b.bar;
        __builtin_amdgcn_s_waitcnt(0);
        unsigned nloc = b.st[0], nx = b.st[1];
        if (nloc == 0u) { xcd_barrier_complete(bar, b.x, nloc, nx); b.st[0] = nloc; b.st[1] = nx; }
        const unsigned old = xb_add(&bar[XB_XSUB(b.x)], 1u);
        const unsigned gen = old / nloc;
        if (old + 1u == (gen + 1u) * nloc) {
            __builtin_amdgcn_fence(__ATOMIC_RELEASE, "agent");
            asm volatile("s_waitcnt vmcnt(0)" ::: "memory");
            const unsigned og = xb_add(&bar[XB_TOP], 1u);
            const unsigned tg = og / nx;
            if (og + 1u == (tg + 1u) * nx) xb_add(&bar[XB_TOPGEN], 1u);
            else XB_SPIN(xb_ld(&bar[XB_TOPGEN]) == tg, bar);
            __builtin_amdgcn_fence(__ATOMIC_ACQUIRE, "agent");
            xb_add(&bar[XB_XGEN(b.x)], 1u);
            asm volatile("s_waitcnt vmcnt(0)" ::: "memory");
        } else {
            XB_SPIN(xb_ld(&bar[XB_XGEN(b.x)]) == gen, bar);
            __builtin_amdgcn_fence(__ATOMIC_ACQUIRE, "agent");
            asm volatile("s_waitcnt vmcnt(0)" ::: "memory");
        }
    }
    __syncthreads();
}

#ifndef MK_MULTI
#define MK_MULTI 0
#endif
constexpr int N_PHASES = 2 + 8 * DEPTH;
#ifndef PROBE_DUP_MASK
#define PROBE_DUP_MASK 0
#endif
struct Args { In in; float* out; unsigned char* ws; int ph_lo, ph_hi; };
static_assert(sizeof(Args) == 15 * 8 + 8, "Args has no padding");
template <class T> __device__ __forceinline__ T* uptr(T* p) {
    const unsigned long long v = (unsigned long long)p;
    const unsigned lo = __builtin_amdgcn_readfirstlane((unsigned)v), hi = __builtin_amdgcn_readfirstlane((unsigned)(v >> 32));
    return (T*)(((unsigned long long)hi << 32) | lo);
}

__global__ void __launch_bounds__(NTHR, 2) fwd_megakernel(Args a) {
    extern __shared__ __attribute__((aligned(16))) unsigned char lds_raw[];
    LAS unsigned char* lds = (LAS unsigned char*)lds_raw;
    cg::grid_group grid = cg::this_grid();
    const int wave0 = __builtin_amdgcn_readfirstlane(threadIdx.x >> 6);
    unsigned char* ws = a.ws;
    volatile LAS unsigned* MISC = (volatile LAS unsigned*)(lds + MISC_OFF);
    if (threadIdx.x < 16) MISC[threadIdx.x] = 0u;
    __syncthreads();
    XcdBarrier bar; bar.bar = (unsigned*)(ws + WS_CTL); bar.x = 0; bar.st = nullptr;
    if (a.ph_hi - a.ph_lo > 1 && a.ph_lo >= 0) bar = xcd_barrier_post((unsigned*)(ws + WS_CTL), MISC + 8);
    for (int ph_ = a.ph_lo < 0 ? 0 : a.ph_lo; ph_ < a.ph_hi; ++ph_) {
        int ph = ph_; asm volatile("" : "+s"(ph));
        int nrep = ph < 2 ? ((PROBE_DUP_MASK >> 8) & 1) + 1 : ((PROBE_DUP_MASK >> ((ph - 2) % 8)) & 1) + 1;
        if (ph == 3 && ((PROBE_DUP_MASK >> 9) & 1)) nrep = 2;
        asm volatile("" : "+s"(nrep));
        for (int rep = 0; rep < nrep; ++rep) {
        asm volatile("" : "+s"(ph));
        int wave = wave0; asm volatile("" : "+s"(wave));
        int lane = (int)__builtin_amdgcn_mbcnt_hi(~0u, __builtin_amdgcn_mbcnt_lo(~0u, 0u)); asm volatile("" : "+v"(lane));
        const int tid = wave * 64 + lane;
        size_t wz = 0; asm volatile("" : "+s"(wz));
        unsigned char* ws = a.ws + wz;
        float* mod = (float*)(ws + WS_MOD);
        unsigned char* ob = (unsigned char*)a.out + wz;
        bf16_t* YC = (bf16_t*)(ob + OUT_YC); bf16_t* ACT = (bf16_t*)(ws + WS_ACT);
        bf16_t* QKVb = (bf16_t*)(ws + WS_QKV); bf16_t* XB = (bf16_t*)(ws + WS_XB);
        bf16_t* O23 = (bf16_t*)(ob + OUT_O23); float* LSE = (float*)(ws + WS_LSE);
        float* SW = (float*)(ws + WS_SW); float* RSS = (float*)(ws + WS_RSS);
        if (ph == 0) { mod_phase(a.in, ws, lds, tid, lane, wave); }
        else if (ph == 1) { weights_phase(a.in, ws, lds, tid, lane, wave, (float*)(ws + WS_SW)); }
        else {
            const int q = ph - 2, L = q / 8, k = q % 8;
            unsigned char* lw = ws + WS_W + (size_t)L * LW_BYTES;
            const float* lmod = mod + (size_t)L * NB * MODW;
            if (k == 0 || k == 6) {
                const int f = k == 6, sub = 2 * f;
                pg8::Gemm g{XB, (const bf16_t*)(lw + LW_W1 + (size_t)f * NB * W1_BYTES), M, 2 * FF, DM, W1_BYTES}; pg8::StaticOrder S; S.init(M, 2 * FF, gridDim.x, blockIdx.x);
                pg8::EpiSwiglu E{ACT, FF, RSS + (size_t)(L * 3 + sub) * M, SW + (size_t)(L * 3 + sub) * NB * NSW};
                pg8::gemm_phase<pg8::EpiSwiglu, pg8::StaticOrder, true, true>(lds, tid, g, S, E);
            } else if (k == 1 || k == 7 || k == 5) {
                const int f = k == 7, sub = k == 1 ? 0 : (k == 5 ? 1 : 2);
                const bool last = (L == DEPTH - 1 && k == 7);
                const bf16_t* A = k == 5 ? YC : ACT; const bf16_t* Bt = k == 5 ? (const bf16_t*)(lw + LW_WOUT) : (const bf16_t*)(lw + LW_W2 + f * W2_BYTES);
                pg8::Gemm g{A, Bt, M, DM, k == 5 ? DM : FF, 0}; pg8::StaticOrder S; S.init(M, DM, gridDim.x, blockIdx.x);
                const int nn = L * 3 + sub + 1;
                const bool has = nn < DEPTH * 3; const int ni = has ? nn : 0;
                LAS pg8::EpiResid::P* pp = (LAS pg8::EpiResid::P*)(lds + MISC_OFF + 64);
                if (tid == 0) { pp->xinb = XB; pp->out = a.out; pp->outb = XB; pp->gate = lmod + sub * 3 * DM + 2 * DM; pp->rss = RSS + (size_t)ni * M;
                    pp->gs = k == 5 ? 1.0f : 0.5f; pp->flags = (has ? 1 : 0) | (last ? 4 : 0); }
                __syncthreads();
                pg8::EpiResid E{pp};
                pg8::gemm_phase<pg8::EpiResid, pg8::StaticOrder, true, true>(lds, tid, g, S, E);
            } else if (k == 2) {
                pg8::Gemm g{XB, (const bf16_t*)(lw + LW_WIN), M, INC, DM, WIN_BYTES}; pg8::StaticOrder S; S.init(M, INC, gridDim.x, blockIdx.x);
                pg8::EpiWin E{ACT, 1024, QKVb, a.in.q_g + L * HD, a.in.k_g + L * HD, QSCALE, RSS + (size_t)(L * 3 + 1) * M, SW + (size_t)(L * 3 + 1) * NB * NSW};
                pg8::gemm_phase<pg8::EpiWin, pg8::StaticOrder, true, true>(lds, tid, g, S, E);
            } else if (k == 3) {
                attn_phase<false>(lds, QKVb, O23, LSE, nullptr, tid, lane, wave);
            } else {
                attn_phase<true>(lds, QKVb, O23, LSE, YC, tid, lane, wave);
                conv_phase(ACT, YC, a.in.conv_w + (size_t)L * 3 * AW, a.in.conv_b + (size_t)L * AW, tid);
            }
        }
        __syncthreads(); }
        if (ph_ + 1 < a.ph_hi) { if (a.ph_lo < 0) grid.sync(); else xcd_barrier(bar); }
    }
}

extern "C" void kernel_launch(void* const* d_in, const int* in_sizes, int n_in, void* d_out, int out_size, void* d_ws, size_t ws_size, hipStream_t stream) {
    static int grid_blocks = 0;
    if (grid_blocks == 0) {
        if (n_in != 13 || in_sizes[0] != M * DM || out_size != M * DM || ws_size < WS_END) { fprintf(stderr, "kernel_launch: unexpected shapes (n_in %d, in0 %d, out %d, ws %zu)\n", n_in, n_in > 0 ? in_sizes[0] : -1, out_size, ws_size); grid_blocks = -1; return; }
        int dev = 0, cus = 0, per_cu = 0;
        hipGetDevice(&dev);
        hipDeviceGetAttribute(&cus, hipDeviceAttributeMultiprocessorCount, dev);
        if (hipFuncSetAttribute((const void*)fwd_megakernel, hipFuncAttributeMaxDynamicSharedMemorySize, LDS_BYTES) != hipSuccess) fprintf(stderr, "kernel_launch: hipFuncSetAttribute failed\n");
        if (hipOccupancyMaxActiveBlocksPerMultiprocessor(&per_cu, (const void*)fwd_megakernel, NTHR, LDS_BYTES) != hipSuccess || per_cu < 1) { fprintf(stderr, "kernel_launch: occupancy query says %d\n", per_cu); per_cu = 1; }
        (void)hipGetLastError();
        grid_blocks = cus * per_cu;
    }
    if (grid_blocks < 0) return;
    Args a{};
    const float** ip = (const float**)&a.in;
    for (int i = 0; i < 13; ++i) ip[i] = (const float*)d_in[i];
    a.out = (float*)d_out; a.ws = (unsigned char*)d_ws;
    if (hipMemsetAsync((char*)d_ws + WS_CTL, 0, ZERO_BYTES, stream) != hipSuccess) { fprintf(stderr, "kernel_launch: memset failed\n"); return; }
#if MK_MULTI
    for (int ph = 0; ph < N_PHASES; ++ph) { a.ph_lo = ph; a.ph_hi = ph + 1; hipLaunchKernelGGL(fwd_megakernel, dim3(grid_blocks), dim3(NTHR), LDS_BYTES, stream, a); }
#else
    a.ph_lo = 0; a.ph_hi = N_PHASES;
    void* args[] = {&a};
    hipError_t e = hipLaunchCooperativeKernel((const void*)fwd_megakernel, dim3(grid_blocks), dim3(NTHR), args, LDS_BYTES, stream);
    if (e != hipSuccess) fprintf(stderr, "cooperative launch failed: %s (grid %d)\n", hipGetErrorString(e), grid_blocks);
#endif
}
```

```cpp
#include <hip/hip_runtime.h>
#include <hip/hip_cooperative_groups.h>
#include <cstdio>
#include <cstdint>
namespace cg = cooperative_groups;
namespace pg8 {
#define PG8_LAS __attribute__((address_space(3)))
typedef unsigned short bf16_t;
typedef short bf16x8 __attribute__((ext_vector_type(8)));
typedef float f32x4 __attribute__((ext_vector_type(4)));
typedef unsigned u32x4 __attribute__((ext_vector_type(4)));
constexpr int BM = 256, BK = 64, HALF = 128, HTB = HALF * BK * 2  , STAGE_BYTES = 8 * HTB, NXCD = 8, WGM = 8;

__host__ __device__ __forceinline__ int lds_byte(int r, int c) { const int st = (r >> 4) * 2 + (c >> 5), rr = r & 15, cc = c & 31, ob = rr * 64 + cc * 2; return st * 1024 + (ob ^ (((ob >> 9) & 1) << 5)); }
__host__ __device__ __forceinline__ void stage_rc(int b, int& R, int& C) { const int st = b / 1024, sb = b % 1024, swz = sb ^ (((sb >> 9) & 1) << 5); R = (st >> 1) * 16 + swz / 64; C = (st & 1) * 32 + (swz % 64) / 2; }
__host__ __device__ __forceinline__ int perm32(int rho) { const int n = rho >> 4, i = rho & 15; return 8 * (i >> 2) + 4 * n + (i & 3); }

struct Unit { int pm, pn; };
struct Gemm { const bf16_t* A; const bf16_t* Bt; int M, N, K; size_t bstride; };

struct StaticOrder {
    int nM, nN, nwg, G, c;
    __host__ __device__ void init(int M, int N, int G_, int c_) { nM = M / BM; nN = N / BM; nwg = nM * nN; G = G_; c = c_; }
    __host__ __device__ bool next(int i, Unit& u) const {
        const long L = (long)i * G + c; if (L >= nwg) return false;
        int wgid = (int)L; { const int q = nwg / NXCD, r = nwg % NXCD, xcd = wgid % NXCD, off = wgid / NXCD; wgid = (xcd < r ? xcd * (q + 1) : r * (q + 1) + (xcd - r) * q) + off; }
        const int nig = WGM * nN, gid = wgid / nig, fm = gid * WGM, gsz = (nM - fm) < WGM ? (nM - fm) : WGM;
        u.pm = fm + ((wgid % nig) % gsz); u.pn = (wgid % nig) / gsz; return true;
    }
    __device__ __forceinline__ void a_ready(const Unit&) const {}
    __device__ __forceinline__ void done(const Unit&) const {}
};

typedef unsigned u32x2 __attribute__((ext_vector_type(2)));
__device__ __forceinline__ unsigned cvt_pk_bf16(float lo, float hi) { typedef float f2 __attribute__((ext_vector_type(2))); typedef __bf16 b2 __attribute__((ext_vector_type(2)));
    f2 v = {lo, hi}; b2 b = __builtin_convertvector(v, b2); return __builtin_bit_cast(unsigned, b); }
__device__ __forceinline__ float silu_f(float g) { return g * __builtin_amdgcn_rcpf(1.0f + __builtin_amdgcn_exp2f(-1.4426950408889634f * g)); }

struct EpiSwiglu {
    static constexpr bool PERM = true, AFTER_DRAIN = false;
    bf16_t* O; int ldc;
    const float* rss; const float* sw;
    __device__ __forceinline__ void operator()(const f32x4 (&acc)[2][2][4][2], const Unit& u, int wr, int wc, int fr, int fq) const {
        const int row0 = u.pm * BM + wr * 64 + fr, col0 = u.pn * HALF + wc * 32 + 8 * fq;
        const float* swp = sw + (size_t)((u.pm * BM) >> 13) * (2 * 2816) + u.pn * BM + wc * 32 + 8 * fq;
        f32x4 sv[2][2];
#pragma unroll
        for (int bj = 0; bj < 2; ++bj)
#pragma unroll
            for (int n = 0; n < 2; ++n) sv[bj][n] = *(const f32x4*)(swp + bj * HALF + 4 * n);
        float rsv[2][4];
#pragma unroll
        for (int ai = 0; ai < 2; ++ai)
#pragma unroll
            for (int m = 0; m < 4; ++m) rsv[ai][m] = rss[row0 + ai * HALF + m * 16];
#pragma unroll
        for (int ai = 0; ai < 2; ++ai)
#pragma unroll
            for (int m = 0; m < 4; ++m) {
                const float rs = __builtin_amdgcn_rsqf(rsv[ai][m] * (1.0f / 1024.0f) + 1e-6f);
                const f32x4 g0 = acc[ai][0][m][0] * rs + sv[0][0], g1 = acc[ai][0][m][1] * rs + sv[0][1], u0 = acc[ai][1][m][0] * rs + sv[1][0], u1 = acc[ai][1][m][1] * rs + sv[1][1];
                u32x4 w;
                w.x = cvt_pk_bf16(silu_f(g0[0]) * u0[0], silu_f(g0[1]) * u0[1]); w.y = cvt_pk_bf16(silu_f(g0[2]) * u0[2], silu_f(g0[3]) * u0[3]);
                w.z = cvt_pk_bf16(silu_f(g1[0]) * u1[0], silu_f(g1[1]) * u1[1]); w.w = cvt_pk_bf16(silu_f(g1[2]) * u1[2], silu_f(g1[3]) * u1[3]);
                *(u32x4*)(O + (size_t)(row0 + ai * HALF + m * 16) * ldc + col0) = w;
            }
    }
};
struct EpiWin {
    static constexpr bool PERM = true, AFTER_DRAIN = false;
    bf16_t* O; int ldc; bf16_t* QKV; const float* qg; const float* kg; float qscale; const float* rss; const float* sw;
    __device__ __forceinline__ void operator()(const f32x4 (&acc)[2][2][4][2], const Unit& u, int wr, int wc, int fr, int fq) const {
        const int row0 = u.pm * BM + wr * 64 + fr, col0 = u.pn * BM + wc * 64 + 8 * fq;
        const int kind = u.pn < 2 ? 1 : (u.pn < 4 ? 2 : 0);
        f32x4 gv[2][2];
#pragma unroll
        for (int bj = 0; bj < 2; ++bj)
#pragma unroll
            for (int n = 0; n < 2; ++n) gv[bj][n] = kind ? *(const f32x4*)((kind == 1 ? qg : kg) + 32 * bj + 8 * fq + 4 * n) : (f32x4){1.f, 1.f, 1.f, 1.f};
        const float ks = kind == 1 ? qscale : 1.0f;
        const float* swp = sw + (size_t)((u.pm * BM) >> 13) * (2 * 2816) + u.pn * BM + wc * 32 + 8 * fq;
        f32x4 sv[2][2];
#pragma unroll
        for (int bj = 0; bj < 2; ++bj)
#pragma unroll
            for (int n = 0; n < 2; ++n) sv[bj][n] = *(const f32x4*)(swp + bj * HALF + 4 * n);
        float rsv[2][4];
#pragma unroll
        for (int ai = 0; ai < 2; ++ai)
#pragma unroll
            for (int m = 0; m < 4; ++m) rsv[ai][m] = rss[row0 + ai * HALF + m * 16];
#pragma unroll
        for (int ai = 0; ai < 2; ++ai)
#pragma unroll
            for (int m = 0; m < 4; ++m) {
                const float rn = __builtin_amdgcn_rsqf(rsv[ai][m] * (1.0f / 1024.0f) + 1e-6f);
                f32x4 hv[2][2];
#pragma unroll
                for (int bj = 0; bj < 2; ++bj)
#pragma unroll
                    for (int n = 0; n < 2; ++n) hv[bj][n] = acc[ai][bj][m][n] * rn + sv[bj][n];
                float rs = 1.0f;
                if (kind) {
                    float ss = 0.f;
#pragma unroll
                    for (int bj = 0; bj < 2; ++bj)
#pragma unroll
                        for (int n = 0; n < 2; ++n) { const f32x4 x = hv[bj][n]; ss += (x[0] * x[0] + x[1] * x[1]) + (x[2] * x[2] + x[3] * x[3]); }
                    ss += __shfl_xor(ss, 16); ss += __shfl_xor(ss, 32);
                    rs = ks * __builtin_amdgcn_rsqf(ss * (1.0f / 64.0f) + 1e-6f);
                }
                const int row = row0 + ai * HALF + m * 16;
                const int tk = row & 8191, tp = (tk & ~2047) | ((tk & 15) << 7) | ((tk & 2047) >> 4);
                if (u.pn >= 8) {
                    const f32x4 p0 = hv[0][0] * hv[1][0], p1 = hv[0][1] * hv[1][1];
                    u32x4 w; w.x = cvt_pk_bf16(p0[0], p0[1]); w.y = cvt_pk_bf16(p0[2], p0[3]); w.z = cvt_pk_bf16(p1[0], p1[1]); w.w = cvt_pk_bf16(p1[2], p1[3]);
                    *(u32x4*)(O + (size_t)row * ldc + 512 + 128 * (u.pn - 8) + 32 * wc + 8 * fq) = w;
                    continue;
                }
                const size_t hrow = (size_t)((row >> 13) * 8 + (u.pn & 1) * 4 + wc) * 8192 + tp;
                bf16_t* rowp = u.pn < 2 ? QKV + hrow * 64 + 8 * fq : u.pn < 6 ? QKV + (size_t)4 * 8 * 8192 * 64 + hrow * 128 + ((u.pn >> 1) - 1) * 64 + 8 * fq
                                        : O + (size_t)row * ldc + (col0 - 1536);
#pragma unroll
                for (int bj = 0; bj < 2; ++bj) {
                    const f32x4 v0 = hv[bj][0] * (gv[bj][0] * rs), v1 = hv[bj][1] * (gv[bj][1] * rs);
                    u32x4 w; w.x = cvt_pk_bf16(v0[0], v0[1]); w.y = cvt_pk_bf16(v0[2], v0[3]); w.z = cvt_pk_bf16(v1[0], v1[1]); w.w = cvt_pk_bf16(v1[2], v1[3]);
                    *(u32x4*)(rowp + 32 * bj) = w;
                }
            }
    }
};
struct EpiResid {
    static constexpr bool PERM = true, AFTER_DRAIN = false;
    struct P { const bf16_t* xinb; float* out; bf16_t* outb; const float* gate; float* rss; float gs; int flags; };
    const PG8_LAS P* pp;
    __device__ __forceinline__ void operator()(const f32x4 (&acc)[2][2][4][2], const Unit& u, int wr, int wc, int fr, int fq) const {
#define PG8_GAS __attribute__((address_space(1)))
        const PG8_GAS bf16_t* xinb = (const PG8_GAS bf16_t*)pp->xinb; PG8_GAS float* out = (PG8_GAS float*)pp->out; PG8_GAS bf16_t* outb = (PG8_GAS bf16_t*)pp->outb; const PG8_GAS float* gate = (const PG8_GAS float*)pp->gate;
        PG8_GAS float* rss = (PG8_GAS float*)pp->rss; const float gs = pp->gs; const int flags = pp->flags; const bool has = flags & 1, outf = flags & 4;
        const int b = (u.pm * BM) >> 13;
        const PG8_GAS float* gp = gate + (size_t)b * 9216;
        const int row0 = u.pm * BM + wr * 64 + fr, col0 = u.pn * BM + wc * 32 + 8 * fq;
        f32x4 gv[2][2];
#pragma unroll
        for (int bj = 0; bj < 2; ++bj)
#pragma unroll
            for (int n = 0; n < 2; ++n) gv[bj][n] = *(const PG8_GAS f32x4*)(gp + col0 + bj * HALF + n * 4) * gs;
#pragma unroll
        for (int ai = 0; ai < 2; ++ai) {
            u32x4 xa[2][4][2];
#pragma unroll
            for (int m = 0; m < 4; ++m)
#pragma unroll
                for (int bj = 0; bj < 2; ++bj) xa[ai][m][bj] = *(const PG8_GAS u32x4*)(xinb + (size_t)(row0 + ai * HALF + m * 16) * 1024 + col0 + bj * HALF);
#pragma unroll
            for (int m = 0; m < 4; ++m) { const int row = row0 + ai * HALF + m * 16; const size_t off = (size_t)row * 1024 + col0; float ss = 0.f;
#pragma unroll
                for (int bj = 0; bj < 2; ++bj) {
                    const u32x4 t = xa[ai][m][bj];
                    const f32x4 x0 = (f32x4){__uint_as_float(t.x << 16), __uint_as_float(t.x & 0xffff0000u), __uint_as_float(t.y << 16), __uint_as_float(t.y & 0xffff0000u)};
                    const f32x4 x1 = (f32x4){__uint_as_float(t.z << 16), __uint_as_float(t.z & 0xffff0000u), __uint_as_float(t.w << 16), __uint_as_float(t.w & 0xffff0000u)};
                    const f32x4 o0 = x0 + gv[bj][0] * acc[ai][bj][m][0], o1 = x1 + gv[bj][1] * acc[ai][bj][m][1];
                    if (outf) { *(PG8_GAS f32x4*)(out + off + bj * HALF) = o0; *(PG8_GAS f32x4*)(out + off + bj * HALF + 4) = o1; }
                    else { u32x4 w; w.x = cvt_pk_bf16(o0[0], o0[1]); w.y = cvt_pk_bf16(o0[2], o0[3]); w.z = cvt_pk_bf16(o1[0], o1[1]); w.w = cvt_pk_bf16(o1[2], o1[3]); *(PG8_GAS u32x4*)(outb + off + bj * HALF) = w; }
                    if (has) { ss += ((o0[0] * o0[0] + o0[1] * o0[1]) + (o0[2] * o0[2] + o0[3] * o0[3])) + ((o1[0] * o1[0] + o1[1] * o1[1]) + (o1[2] * o1[2] + o1[3] * o1[3])); } }
                if (has) { ss += __shfl_xor(ss, 16); ss += __shfl_xor(ss, 32);
                    if (fq == 0) __hip_atomic_fetch_add((float*)(rss + row), ss, __ATOMIC_RELAXED, __HIP_MEMORY_SCOPE_AGENT); } }
            asm volatile("" ::: "memory"); }
    }
};
template <class Epi, class Sched, bool ALIGN_EPI = false, bool SP2 = false>
__device__ __forceinline__ void gemm_phase(PG8_LAS unsigned char* lds, const int tid, const Gemm g, const Sched& S, const Epi& E) {
    const int wid = __builtin_amdgcn_readfirstlane(tid >> 6), lane = tid & 63, wr = wid >> 2, wc = wid & 3, fr = lane & 15, fq = lane >> 4;
    const int K = g.K, nt = K / BK;
    unsigned voffA[2], voffB[2];
#pragma unroll
    for (int i = 0; i < 2; ++i) { int R, C; stage_rc(tid * 16 + i * 8192, R, C); const int Rb = Epi::PERM ? ((R & ~31) + perm32(R & 31)) : R;
        voffA[i] = (unsigned)(R * K + C) * 2u; voffB[i] = (unsigned)(Rb * K + C) * 2u; }
    const size_t kstep = (size_t)(BK * 2);
    const size_t hstep = (size_t)HALF * K * 2;
    const size_t tstep = 2 * hstep;
    const unsigned ldsw = (unsigned)wid * 1024u;
    const int aoff = lds_byte(wr * 64 + fr, fq * 8), boff = lds_byte(wc * 32 + fr, fq * 8);
#define PG8_SA(b, h) (((b) * 2 + (h)) * HTB)
#define PG8_SB(b, h) ((4 + (b) * 2 + (h)) * HTB)
#define PG8_STAGE(bufoff, gbase, voff) do { _Pragma("unroll") for (int _i = 0; _i < 2; ++_i) \
        __builtin_amdgcn_global_load_lds((const unsigned*)((const char*)(gbase) + (voff)[_i]), (PG8_LAS unsigned*)(lds + (bufoff) + ldsw + _i * 8192), 16, 0, 0); } while (0)
#define PG8_LDA(dst, b, h) do { _Pragma("unroll") for (int m = 0; m < 4; ++m) _Pragma("unroll") for (int k = 0; k < 2; ++k) dst[m][k] = *(const PG8_LAS bf16x8*)(lds + PG8_SA(b, h) + aoff + m * 2048 + k * 1024); } while (0)
#define PG8_LDB(dst, b, h) do { _Pragma("unroll") for (int n = 0; n < 2; ++n) _Pragma("unroll") for (int k = 0; k < 2; ++k) dst[n][k] = *(const PG8_LAS bf16x8*)(lds + PG8_SB(b, h) + boff + n * 2048 + k * 1024); } while (0)
#define PG8_MMA(ai, bj, At, Bt) do { __builtin_amdgcn_s_setprio(1); _Pragma("unroll") for (int m = 0; m < 4; ++m) _Pragma("unroll") for (int n = 0; n < 2; ++n) _Pragma("unroll") for (int k = 0; k < 2; ++k) \
        acc[ai][bj][m][n] = __builtin_amdgcn_mfma_f32_16x16x32_bf16(Bt[n][k], At[m][k], acc[ai][bj][m][n], 0, 0, 0); __builtin_amdgcn_s_setprio(0); } while (0)
#define PG8_WAIT_V(n) asm volatile("s_waitcnt vmcnt(" #n ")" ::: "memory")
#define PG8_WAIT_L(n) asm volatile("s_waitcnt lgkmcnt(" #n ")" ::: "memory")
#define PG8_BAR __builtin_amdgcn_s_barrier()
#define PG8_SCHED __builtin_amdgcn_sched_barrier(0)
    Unit cur, nxt; int ui = 0;
    if (!S.next(0, cur)) return;
    f32x4 acc[2][2][4][2];
#pragma unroll
    for (int a = 0; a < 2; ++a)
#pragma unroll
        for (int b = 0; b < 2; ++b)
#pragma unroll
            for (int m = 0; m < 4; ++m)
#pragma unroll
                for (int n = 0; n < 2; ++n) acc[a][b][m][n] = (f32x4){0.f, 0.f, 0.f, 0.f};
    bf16x8 At[4][2], B0[2][2], B1[2][2];
    const char* cA = (const char*)g.A + (size_t)cur.pm * tstep; const char* cB = (const char*)g.Bt + (size_t)cur.pn * tstep + (size_t)(cur.pm >> 5) * g.bstride;
    S.a_ready(cur);
    if constexpr (SP2) {
        PG8_STAGE(PG8_SB(0, 0), cB, voffB); PG8_STAGE(PG8_SB(0, 1), cB + hstep, voffB); PG8_STAGE(PG8_SA(0, 0), cA, voffA); PG8_STAGE(PG8_SA(0, 1), cA + hstep, voffA);
        if (wr == 1) PG8_BAR;
        PG8_WAIT_V(2); PG8_BAR;
        PG8_STAGE(PG8_SB(1, 0), cB + kstep, voffB); PG8_STAGE(PG8_SA(1, 0), cA + kstep, voffA); PG8_STAGE(PG8_SB(1, 1), cB + hstep + kstep, voffB);
        PG8_WAIT_V(6); PG8_BAR;
    } else {
        PG8_STAGE(PG8_SB(0, 0), cB, voffB); PG8_STAGE(PG8_SA(0, 0), cA, voffA); PG8_STAGE(PG8_SB(0, 1), cB + hstep, voffB); PG8_STAGE(PG8_SA(0, 1), cA + hstep, voffA);
        if (wr == 1) PG8_BAR;
        PG8_WAIT_V(4); PG8_BAR;
        PG8_STAGE(PG8_SB(1, 0), cB + kstep, voffB); PG8_STAGE(PG8_SA(1, 0), cA + kstep, voffA); PG8_STAGE(PG8_SB(1, 1), cB + hstep + kstep, voffB);
        PG8_WAIT_V(6); PG8_BAR;
    }
    for (;;) {
        const bool has_next = S.next(ui + 1, nxt);
        const char* nA = has_next ? (const char*)g.A + (size_t)nxt.pm * tstep : cA; const char* nB = has_next ? (const char*)g.Bt + (size_t)nxt.pn * tstep + (size_t)(nxt.pm >> 5) * g.bstride : cB;
        for (int t = 0; t < nt; t += 2) {
            const bool last = (t == nt - 2);
            const char* a1 = cA + (size_t)(t + 1) * kstep;
            const char* a2 = last ? nA : cA + (size_t)(t + 2) * kstep; const char* b2 = last ? nB : cB + (size_t)(t + 2) * kstep;
            const char* a3 = a2 + kstep; const char* b3 = b2 + kstep;
            if (last && has_next) S.a_ready(nxt);
            if constexpr (SP2) {
            PG8_LDB(B0, 0, 0); PG8_LDB(B1, 0, 1); PG8_SCHED; PG8_LDA(At, 0, 0); PG8_STAGE(PG8_SA(1, 1), a1 + hstep, voffA);
            PG8_WAIT_V(8); PG8_WAIT_L(0); PG8_BAR; PG8_MMA(0, 0, At, B0); PG8_MMA(0, 1, At, B1); PG8_BAR; PG8_SCHED;
            PG8_LDA(At, 0, 1); PG8_STAGE(PG8_SB(0, 0), b2, voffB); PG8_STAGE(PG8_SB(0, 1), b2 + hstep, voffB); PG8_STAGE(PG8_SA(0, 0), a2, voffA);
            PG8_WAIT_V(8); PG8_WAIT_L(0); PG8_BAR; PG8_MMA(1, 0, At, B0); PG8_MMA(1, 1, At, B1); PG8_BAR; PG8_SCHED;
            PG8_LDB(B0, 1, 0); PG8_LDB(B1, 1, 1); PG8_SCHED; PG8_LDA(At, 1, 0); PG8_STAGE(PG8_SA(0, 1), a2 + hstep, voffA);
            PG8_WAIT_V(8); PG8_WAIT_L(0); PG8_BAR; PG8_MMA(0, 0, At, B0); PG8_MMA(0, 1, At, B1); PG8_BAR; PG8_SCHED;
            PG8_LDA(At, 1, 1); PG8_STAGE(PG8_SB(1, 0), b3, voffB); PG8_STAGE(PG8_SB(1, 1), b3 + hstep, voffB); PG8_STAGE(PG8_SA(1, 0), a3, voffA);
            PG8_WAIT_V(8); PG8_WAIT_L(0); PG8_BAR; PG8_MMA(1, 0, At, B0); PG8_MMA(1, 1, At, B1); PG8_BAR; PG8_SCHED;
            } else {
            PG8_LDB(B0, 0, 0); PG8_SCHED; PG8_LDA(At, 0, 0); PG8_STAGE(PG8_SA(1, 1), a1 + hstep, voffA);
            PG8_WAIT_L(8); PG8_BAR; PG8_WAIT_L(0); PG8_MMA(0, 0, At, B0); PG8_BAR; PG8_SCHED;
            PG8_LDB(B1, 0, 1); PG8_STAGE(PG8_SB(0, 0), b2, voffB);
            PG8_BAR; PG8_WAIT_L(0); PG8_MMA(0, 1, At, B1); PG8_BAR;
            PG8_LDA(At, 0, 1); PG8_STAGE(PG8_SA(0, 0), a2, voffA);
            PG8_BAR; PG8_WAIT_L(0); PG8_MMA(1, 0, At, B0); PG8_BAR; PG8_SCHED;
            PG8_STAGE(PG8_SB(0, 1), b2 + hstep, voffB);
            PG8_WAIT_V(6); PG8_BAR; PG8_MMA(1, 1, At, B1); PG8_BAR;
            PG8_LDB(B0, 1, 0); PG8_SCHED; PG8_LDA(At, 1, 0); PG8_STAGE(PG8_SA(0, 1), a2 + hstep, voffA);
            PG8_WAIT_L(8); PG8_BAR; PG8_WAIT_L(0); PG8_MMA(0, 0, At, B0); PG8_BAR; PG8_SCHED;
            PG8_LDB(B1, 1, 1); PG8_STAGE(PG8_SB(1, 0), b3, voffB);
            PG8_BAR; PG8_WAIT_L(0); PG8_MMA(0, 1, At, B1); PG8_BAR;
            PG8_LDA(At, 1, 1); PG8_STAGE(PG8_SA(1, 0), a3, voffA);
            PG8_BAR; PG8_WAIT_L(0); PG8_MMA(1, 0, At, B0); PG8_BAR; PG8_SCHED;
            PG8_STAGE(PG8_SB(1, 1), b3 + hstep, voffB);
            PG8_WAIT_V(6); PG8_BAR; PG8_MMA(1, 1, At, B1); PG8_BAR;
            }
        }
        if constexpr (ALIGN_EPI) { if (wr == 0) PG8_BAR; }
        if constexpr (!Epi::AFTER_DRAIN) { E(acc, cur, wr, wc, fr, fq); S.done(cur); }
        if (!has_next) break;
#pragma unroll
        for (int a = 0; a < 2; ++a)
#pragma unroll
            for (int b = 0; b < 2; ++b)
#pragma unroll
                for (int m = 0; m < 4; ++m)
#pragma unroll
                    for (int n = 0; n < 2; ++n) acc[a][b][m][n] = (f32x4){0.f, 0.f, 0.f, 0.f};
        cur = nxt; cA = nA; cB = nB; ++ui;
        if constexpr (ALIGN_EPI) { if (wr == 1) PG8_BAR; }
    }
    PG8_WAIT_V(0);
    if constexpr (!ALIGN_EPI) { if (wr == 0) PG8_BAR; }
    PG8_BAR;
    if constexpr (Epi::AFTER_DRAIN) { E.fused(acc, cur, wr, wc, fr, fq, lds, wid, lane); S.done(cur); }
#undef PG8_SA
#undef PG8_SB
#undef PG8_STAGE
#undef PG8_LDA
#undef PG8_LDB
#undef PG8_MMA
#undef PG8_WAIT_V
#undef PG8_WAIT_L
#undef PG8_BAR
#undef PG8_SCHED
}
}

#define LAS __attribute__((address_space(3)))
typedef unsigned short bf16_t;
typedef short bf16x8 __attribute__((ext_vector_type(8)));
typedef short s16x4 __attribute__((ext_vector_type(4)));
typedef float f32x4 __attribute__((ext_vector_type(4)));
typedef float f32x16 __attribute__((ext_vector_type(16)));
typedef unsigned u32x4 __attribute__((ext_vector_type(4)));
typedef unsigned u32x2 __attribute__((ext_vector_type(2)));
constexpr int DM = 1024, NB = 4, SEQ = 8192, DEPTH = 2, FF = 2816, NH = 8, HD = 64, AW = 512, INC = 3072, MODW = 9216;
constexpr int M = NB * SEQ;
constexpr float EPS = 1e-6f;
constexpr float QSCALE = 0.125f * 1.4426950408889634f;
constexpr float NEGBIG = -1e30f;
constexpr int NWAVES = 8, NTHR = 512;
constexpr size_t MiB = 1u << 20;
constexpr size_t WS_MOD = 0;
constexpr size_t WS_ST = MiB / 2;
constexpr size_t WS_GT = 3 * MiB / 4;
constexpr size_t WS_CTL = 1 * MiB, CTL_BYTES = 16384;
constexpr int NSW = 2 * FF;
constexpr size_t WS_SW = WS_CTL + CTL_BYTES, SW_BYTES = (size_t)DEPTH * 3 * NB * NSW * 4;
constexpr size_t WS_RSS = WS_SW + SW_BYTES, RSS_BYTES = (size_t)DEPTH * 3 * M * 4;
constexpr size_t ZERO_BYTES = CTL_BYTES + SW_BYTES + RSS_BYTES;
constexpr size_t WS_W = 5 * MiB / 2;
static_assert(WS_CTL + ZERO_BYTES <= WS_W, "zeroed region");
constexpr size_t W1_BYTES = (size_t)2 * FF * DM * 2, W2_BYTES = (size_t)DM * FF * 2, WIN_BYTES = (size_t)INC * DM * 2, WOUT_BYTES = (size_t)DM * DM * 2;
constexpr size_t LW_W1 = 0, LW_WIN = 2 * NB * W1_BYTES, LW_W2 = LW_WIN + NB * WIN_BYTES, LW_WOUT = LW_W2 + 2 * W2_BYTES, LW_BYTES = LW_WOUT + WOUT_BYTES;
static_assert(WS_W + DEPTH * LW_BYTES <= 253 * MiB, "weights");
constexpr size_t WS_ACT = 253 * MiB;
constexpr size_t WS_QKV = WS_ACT + 96 * MiB;
constexpr size_t WS_XB = 445 * MiB;
constexpr size_t WS_LSE = 509 * MiB;
constexpr size_t WS_END = 511 * MiB;
constexpr size_t OUT_O23 = 0, OUT_YC = 64 * MiB;
constexpr int RING_BYTES = 131072, WSCR_OFF = RING_BYTES, MISC_OFF = RING_BYTES + NWAVES * 512, LDS_BYTES = MISC_OFF + 256;

__device__ __forceinline__ float bf_lo(unsigned u) { return __uint_as_float(u << 16); }
__device__ __forceinline__ float bf_hi(unsigned u) { return __uint_as_float(u & 0xffff0000u); }
__device__ __forceinline__ float wave_sum(float v) {
#pragma unroll
    for (int o = 1; o < 64; o <<= 1) v += __shfl_xor(v, o);
    return v;
}
using pg8::cvt_pk_bf16;

struct In { const float *x, *c, *w_ada, *b_ada, *norm_g, *w_in, *q_g, *k_g, *conv_w, *conv_b, *w_out, *w1, *w2; };

__device__ __forceinline__ void mod_phase(const In& I, unsigned char* ws, LAS unsigned char* lds, int tid, int lane, int wave) {
    LAS float* sc = (LAS float*)(lds + 69632);
    LAS float* red = (LAS float*)(lds + 69632 + 16384);
    float* mod = (float*)(ws + WS_MOD); float* ST = (float*)(ws + WS_ST); float* GT = (float*)(ws + WS_GT);
    for (int i = tid; i < NB * DM; i += NTHR) { const float v = I.c[i]; sc[i] = v / (1.0f + __expf(-v)); }
    __syncthreads();
    typedef float f32x2 __attribute__((ext_vector_type(2)));
    for (int it = blockIdx.x; it < DEPTH * (MODW / 72); it += gridDim.x) {
        const int l = it / (MODW / 72), j0 = (it % (MODW / 72)) * 72;
        const int ln = lane < 36 ? lane : 35;
        const float* wp = I.w_ada + (size_t)l * DM * MODW + j0 + 2 * ln;
        f32x2 a0 = {0.f, 0.f}, a1 = a0, a2 = a0, a3 = a0; const int k0 = wave * 128;
#pragma unroll 16
        for (int k = k0; k < k0 + 128; ++k) { const f32x2 w = __builtin_nontemporal_load((const f32x2*)(wp + (size_t)k * MODW)); a0 += w * sc[k]; a1 += w * sc[DM + k]; a2 += w * sc[2 * DM + k]; a3 += w * sc[3 * DM + k]; }
        if (lane < 36) { LAS float* rp = red + wave * 4 * 72 + 2 * lane; rp[0] = a0.x; rp[1] = a0.y; rp[72] = a1.x; rp[73] = a1.y; rp[144] = a2.x; rp[145] = a2.y; rp[216] = a3.x; rp[217] = a3.y; }
        __syncthreads();
        if (tid < 288) { const int b = tid / 72, cl = tid % 72; float s = 0.f;
#pragma unroll
            for (int w = 0; w < 8; ++w) s += red[(w * 4 + b) * 72 + cl];
            const int j = j0 + cl; const float v = s + I.b_ada[(size_t)l * MODW + j];
            mod[(size_t)(l * NB + b) * MODW + j] = v;
            const int sub = j / 3072, jj = j % 3072; if (jj < DM) ST[((size_t)(l * 3 + sub) * DM + jj) * NB + b] = v;
            else if (jj < 2 * DM) GT[((size_t)(l * 3 + sub) * DM + jj - DM) * NB + b] = I.norm_g[(size_t)(l * 3 + sub) * DM + jj - DM] * (1.0f + v); }
        __syncthreads();
    }
}
__device__ __forceinline__ void transpose_item(const float* W, int K, int N, bf16_t* WT, int k0, int src_n0, int dst_n0, LAS float* scr, int lane, const float* st, float* sw, const float* gt, size_t cstride) {
    { f32x4 v[8]; const int c4 = lane & 7, kr = lane >> 3;
#pragma unroll
        for (int i = 0; i < 8; ++i) v[i] = __builtin_nontemporal_load((const f32x4*)(W + (size_t)(k0 + 8 * i + kr) * N + src_n0 + 4 * c4));
#pragma unroll
        for (int i = 0; i < 8; ++i) { LAS float* d = scr + (8 * i + kr) * 33 + 4 * c4; d[0] = v[i].x; d[1] = v[i].y; d[2] = v[i].z; d[3] = v[i].w; } }
    asm volatile("s_waitcnt lgkmcnt(0)" ::: "memory");
    const int c = lane & 7;
    if (!gt) {
#pragma unroll
        for (int j = 0; j < 4; ++j) { const int n = (lane >> 3) + 8 * j; const LAS float* s = scr + (8 * c) * 33 + n;
            u32x4 o; o.x = cvt_pk_bf16(s[0 * 33], s[1 * 33]); o.y = cvt_pk_bf16(s[2 * 33], s[3 * 33]); o.z = cvt_pk_bf16(s[4 * 33], s[5 * 33]); o.w = cvt_pk_bf16(s[6 * 33], s[7 * 33]);
            *(u32x4*)(WT + (size_t)(dst_n0 + n) * K + k0 + 8 * c) = o; }
    } else {
        f32x4 gk[8];
#pragma unroll
        for (int i = 0; i < 8; ++i) gk[i] = *(const f32x4*)(gt + (size_t)(k0 + 8 * c + i) * NB);
#pragma unroll
        for (int j = 0; j < 4; ++j) { const int n = (lane >> 3) + 8 * j; const LAS float* s = scr + (8 * c) * 33 + n;
            float w[8];
#pragma unroll
            for (int i = 0; i < 8; ++i) w[i] = s[i * 33];
#pragma unroll
            for (int b = 0; b < NB; ++b) {
                u32x4 o; o.x = cvt_pk_bf16(w[0] * gk[0][b], w[1] * gk[1][b]); o.y = cvt_pk_bf16(w[2] * gk[2][b], w[3] * gk[3][b]); o.z = cvt_pk_bf16(w[4] * gk[4][b], w[5] * gk[5][b]); o.w = cvt_pk_bf16(w[6] * gk[6][b], w[7] * gk[7][b]);
                *(u32x4*)(WT + (size_t)b * cstride + (size_t)(dst_n0 + n) * K + k0 + 8 * c) = o; } }
    }
    if (st) { const int n = lane & 31, hf = lane >> 5; f32x4 a4 = {0.f, 0.f, 0.f, 0.f};
#pragma unroll 8
        for (int i = 0; i < 32; ++i) { const int kk = hf * 32 + i; a4 += *(const f32x4*)(st + (size_t)(k0 + kk) * NB) * scr[kk * 33 + n]; }
#pragma unroll
        for (int b = 0; b < 4; ++b) a4[b] += __shfl_xor(a4[b], 32);
        if (hf == 0) {
#pragma unroll
            for (int b = 0; b < 4; ++b) __hip_atomic_fetch_add(sw + (size_t)b * NSW + dst_n0 + n, a4[b], __ATOMIC_RELAXED, __HIP_MEMORY_SCOPE_AGENT); } }
    asm volatile("s_waitcnt lgkmcnt(0)" ::: "memory");
}
__device__ __forceinline__ void weights_phase(const In& I, unsigned char* ws, LAS unsigned char* lds, int tid, int lane, int wave, float* SW, int which) {
    LAS float* scr = (LAS float*)(lds + wave * 8448);
    const int gw = blockIdx.x * NWAVES + wave, NGW = gridDim.x * NWAVES;
    const float* ST = (const float*)(ws + WS_ST); const float* GT = (const float*)(ws + WS_GT);
    constexpr int I_W1 = (DM / 64) * (2 * FF / 32), I_W2 = (FF / 64) * (DM / 32), I_WIN = (DM / 64) * (INC / 32), I_WOUT = (DM / 64) * (DM / 32);
    constexpr int I_LAYER = 2 * I_W1 + 2 * I_W2 + I_WIN + I_WOUT;
    for (int it = gw; it < DEPTH * I_LAYER; it += NGW) {
        const int l = it / I_LAYER; int r = it % I_LAYER;
        { const bool gain_item = r < 2 * I_W1 || (r >= 2 * I_W1 + 2 * I_W2 && r < 2 * I_W1 + 2 * I_W2 + I_WIN); if ((gain_item ? 1 : 0) != which) continue; }
        unsigned char* lw = ws + WS_W + (size_t)l * LW_BYTES;
        if (r < 2 * I_W1) { const int f = r / I_W1; r %= I_W1; const int nblk = 2 * FF / 32, kb = r / nblk, nb = r % nblk, n0 = nb * 32;
            const int pn = n0 >> 8, bj = (n0 >> 7) & 1, i = n0 & 127, sub = 2 * f;
            transpose_item(I.w1 + (size_t)(l * 2 + f) * DM * 2 * FF, DM, 2 * FF, (bf16_t*)(lw + LW_W1 + (size_t)f * NB * W1_BYTES), kb * 64, bj * FF + 128 * pn + i, n0, scr, lane,
                           ST + (size_t)(l * 3 + sub) * DM * NB, SW + (size_t)(l * 3 + sub) * NB * NSW, GT + (size_t)(l * 3 + sub) * DM * NB, W1_BYTES / 2); continue; }
        r -= 2 * I_W1;
        if (r < 2 * I_W2) { const int f = r / I_W2; r %= I_W2; const int nblk = DM / 32, kb = r / nblk, nb = r % nblk;
            transpose_item(I.w2 + (size_t)(l * 2 + f) * FF * DM, FF, DM, (bf16_t*)(lw + LW_W2 + f * W2_BYTES), kb * 64, nb * 32, nb * 32, scr, lane, nullptr, nullptr, nullptr, 0); continue; }
        r -= 2 * I_W2;
        if (r < I_WIN) { const int nblk = INC / 32, kb = r / nblk, nb = r % nblk, n0 = nb * 32; const int pn = n0 >> 8, bj = (n0 >> 7) & 1, wc = (n0 >> 5) & 3;
            const int srcn = pn < 8 ? 256 * pn + 64 * wc + 32 * bj : (bj ? 2560 : 2048) + 128 * (pn - 8) + 32 * wc;
            transpose_item(I.w_in + (size_t)l * DM * INC, DM, INC, (bf16_t*)(lw + LW_WIN), kb * 64, srcn, n0, scr, lane,
                           ST + (size_t)(l * 3 + 1) * DM * NB, SW + (size_t)(l * 3 + 1) * NB * NSW, GT + (size_t)(l * 3 + 1) * DM * NB, WIN_BYTES / 2); continue; }
        r -= I_WIN;
        { const int nblk = DM / 32, kb = r / nblk, nb = r % nblk;
            transpose_item(I.w_out + (size_t)l * DM * DM, DM, DM, (bf16_t*)(lw + LW_WOUT), kb * 64, nb * 32, nb * 32, scr, lane, nullptr, nullptr, nullptr, 0); }
    }
    if (which == 0) return;
    bf16_t* XB = (bf16_t*)(ws + WS_XB); float* RSS = (float*)(ws + WS_RSS);
    for (int chunk = gw; chunk < M / 16; chunk += NGW) {
        const int row0 = chunk * 16;
        for (int r4 = 0; r4 < 16; r4 += 4) {
            f32x4 v[4][4];
#pragma unroll
            for (int q = 0; q < 4; ++q) { const f32x4* xr = (const f32x4*)(I.x + (size_t)(row0 + r4 + q) * DM) + lane;
#pragma unroll
                for (int j = 0; j < 4; ++j) v[q][j] = __builtin_nontemporal_load(xr + 64 * j); }
#pragma unroll
            for (int q = 0; q < 4; ++q) { float ssq = 0.f;
#pragma unroll
                for (int j = 0; j < 4; ++j) ssq += (v[q][j].x * v[q][j].x + v[q][j].y * v[q][j].y) + (v[q][j].z * v[q][j].z + v[q][j].w * v[q][j].w);
                ssq = wave_sum(ssq);
                if (lane == 0) RSS[row0 + r4 + q] = ssq;
                u32x2* x8 = (u32x2*)(XB + (size_t)(row0 + r4 + q) * DM) + lane;
#pragma unroll
                for (int j = 0; j < 4; ++j) { u32x2 xw; xw.x = cvt_pk_bf16(v[q][j].x, v[q][j].y); xw.y = cvt_pk_bf16(v[q][j].z, v[q][j].w); x8[64 * j] = xw; } }
        }
    }
}

__device__ __forceinline__ int crow(int i, int hi) { return (i & 3) + 8 * (i >> 2) + 4 * hi; }
__device__ __forceinline__ u32x4 pair16(u32x2 wa, u32x2 wb) {
    const auto r0 = __builtin_amdgcn_permlane32_swap(wa.x, wb.x, false, false);
    const auto r1 = __builtin_amdgcn_permlane32_swap(wa.y, wb.y, false, false);
    return (u32x4){r0[0], r1[0], r0[1], r1[1]};
}
__device__ __forceinline__ int tpos(int t) { return (t & ~2047) | ((t & 15) << 7) | ((t & 2047) >> 4); }
typedef short v4i16_t __attribute__((ext_vector_type(4)));
__device__ __forceinline__ s16x4 vtr(LAS const unsigned char* p) { return __builtin_bit_cast(s16x4, __builtin_amdgcn_ds_read_tr16_b64_v4i16((LAS v4i16_t*)p)); }

struct AttnItem { int dil, b, h, r, nb, br; };
template <bool FINAL> __device__ __forceinline__ AttnItem attn_decode(int R, int wid) {
    AttnItem t; const int it = 2 * R + (wid >> 2);
    if (!FINAL) { const int br = it >> 11, rem = it & 2047, bh = rem >> 6, rn = rem & 63; t.br = br; t.dil = br ? 16 : 4; const int nbc = 64 / t.dil; t.r = rn / nbc; t.nb = rn % nbc; t.b = bh >> 3; t.h = bh & 7; }
    else { const int bh = it >> 6; t.br = 0; t.dil = 1; t.r = 0; t.nb = it & 63; t.b = bh >> 3; t.h = bh & 7; }
    return t;
}
__device__ __forceinline__ void attn_load(const bf16_t* proj, const AttnItem& t, u32x4 (&kv)[6], u32x4 (&vv)[6], int tid) {
    const int nb0 = t.nb & ~1;
    const bf16_t* kb = proj + (size_t)NB * NH * SEQ * HD + (size_t)(t.b * NH + t.h) * SEQ * 2 * HD;
#pragma unroll
    for (int c = 0; c < 6; ++c) { const int idx = tid + 512 * c, j = idx >> 3, ch = idx & 7; const int sidx = (nb0 - 1) * 128 + j;
        const int sj = sidx >= 0 ? sidx : sidx + 128;
        const bf16_t* p = kb + (size_t)tpos(sj * t.dil + t.r) * 2 * HD + ch * 8; kv[c] = *(const u32x4*)p; vv[c] = *(const u32x4*)(p + HD); }
}
__device__ __forceinline__ void attn_load_q(const bf16_t* proj, const AttnItem& t, bf16x8 (&qf)[4], int lane, int wid) {
    const int w = wid & 3, r32 = lane & 31, hi = lane >> 5;
    const size_t qrow = (size_t)(t.b * NH + t.h) * SEQ + tpos((t.nb * 128 + 32 * w + r32) * t.dil + t.r);
#pragma unroll
    for (int ks = 0; ks < 4; ++ks) qf[ks] = *(const bf16x8*)(proj + qrow * HD + 16 * ks + 8 * hi);
}
__device__ __forceinline__ void attn_stage(LAS unsigned char* lds, const u32x4 (&kv)[6], const u32x4 (&vv)[6], int tid, int wid) {
    LAS unsigned char* Kl = lds; LAS unsigned char* Vl = lds + 49152;
#pragma unroll
    for (int c = 0; c < 6; ++c) { const int idx = tid + 512 * c, j = idx >> 3, ch = idx & 7;
        *(LAS u32x4*)(Kl + j * 128 + ((ch ^ ((j >> 1) & 7)) * 16)) = kv[c];
        *(LAS u32x4*)(Vl + j * 128 + (((ch >> 2) ^ ((j >> 1) & 1)) * 64) + (ch & 3) * 16) = vv[c]; }
}
template <int T0, int NT, bool FIRST>
__device__ __forceinline__ void attn_group(LAS const unsigned char* Kl, LAS const unsigned char* Vl, const bf16x8 (&qf)[4], f32x16 (&o)[2], float& mx, float& l, int nb, int w, int lane) {
    const int r32 = lane & 31, hi = lane >> 5;
    f32x16 s[NT];
#pragma unroll
    for (int t = 0; t < NT; ++t) { const float z = (T0 + t < 4 && nb == 0 && w + T0 + t < 4) ? NEGBIG : 0.f;
        s[t] = (f32x16){z, z, z, z, z, z, z, z, z, z, z, z, z, z, z, z}; }
    {
        LAS const unsigned char* kp = Kl + (32 * (w + T0) + r32) * 128;
        const int sw = (r32 >> 1) & 7;
#pragma unroll
        for (int ks = 0; ks < 4; ++ks) {
            bf16x8 kf[NT];
#pragma unroll
            for (int t = 0; t < NT; ++t) kf[t] = *(LAS const bf16x8*)(kp + t * 4096 + (((2 * ks + hi) ^ sw) * 16));
#pragma unroll
            for (int t = 0; t < NT; ++t) s[t] = __builtin_amdgcn_mfma_f32_32x32x16_bf16(kf[t], qf[ks], s[t], 0, 0, 0);
        }
    }
#pragma unroll
    for (int t = 0; t < NT; ++t) {
        const int tt = T0 + t;
        if (tt == 0) {
#pragma unroll
            for (int i = 0; i < 16; ++i) if (crow(i, hi) < r32) s[t][i] = NEGBIG; }
        if (tt == 4) {
#pragma unroll
            for (int i = 0; i < 16; ++i) if (crow(i, hi) > r32) s[t][i] = NEGBIG; }
    }
    float m0 = s[0][0], m1 = s[0][1], m2 = s[0][2], m3 = s[0][3];
#pragma unroll
    for (int t = 0; t < NT; ++t)
#pragma unroll
        for (int i = 0; i < 16; i += 4) { m0 = fmaxf(m0, s[t][i]); m1 = fmaxf(m1, s[t][i + 1]); m2 = fmaxf(m2, s[t][i + 2]); m3 = fmaxf(m3, s[t][i + 3]); }
    float gm = fmaxf(fmaxf(m0, m1), fmaxf(m2, m3));
    gm = fmaxf(gm, __shfl_xor(gm, 32));
    if (FIRST) mx = gm;
    else { const float mn = fmaxf(mx, gm); const float f = __builtin_amdgcn_exp2f(mx - mn); l *= f; mx = mn;
#pragma unroll
        for (int d = 0; d < 2; ++d)
#pragma unroll
            for (int i = 0; i < 16; ++i) o[d][i] *= f; }
    float l0 = 0.f, l1 = 0.f, l2 = 0.f, l3 = 0.f;
#pragma unroll
    for (int t = 0; t < NT; ++t)
#pragma unroll
        for (int i = 0; i < 16; i += 4) {
            const float p0 = __builtin_amdgcn_exp2f(s[t][i] - mx), p1 = __builtin_amdgcn_exp2f(s[t][i + 1] - mx), p2 = __builtin_amdgcn_exp2f(s[t][i + 2] - mx), p3 = __builtin_amdgcn_exp2f(s[t][i + 3] - mx);
            s[t][i] = p0; s[t][i + 1] = p1; s[t][i + 2] = p2; s[t][i + 3] = p3; l0 += p0; l1 += p1; l2 += p2; l3 += p3; }
    l += (l0 + l1) + (l2 + l3);
    const int i16 = lane & 15, q4 = i16 >> 2, p4 = i16 & 3, blk = (lane >> 4) & 1;
    LAS const unsigned char* vb = Vl + (32 * (w + T0) + 4 * hi + q4) * 128 + 32 * blk + 8 * p4;
    const int vsw = ((q4 >> 1) & 1) * 64;
#pragma unroll
    for (int t = 0; t < NT; ++t)
#pragma unroll
        for (int s2 = 0; s2 < 2; ++s2) {
            u32x4 pw; pw.x = cvt_pk_bf16(s[t][8 * s2 + 0], s[t][8 * s2 + 1]); pw.y = cvt_pk_bf16(s[t][8 * s2 + 2], s[t][8 * s2 + 3]);
            pw.z = cvt_pk_bf16(s[t][8 * s2 + 4], s[t][8 * s2 + 5]); pw.w = cvt_pk_bf16(s[t][8 * s2 + 6], s[t][8 * s2 + 7]);
            const bf16x8 pf = __builtin_bit_cast(bf16x8, pw);
#pragma unroll
            for (int d = 0; d < 2; ++d) {
                LAS const unsigned char* vp = vb + (t * 32 + s2 * 16) * 128 + ((d * 64) ^ vsw);
                const s16x4 lo = vtr(vp), hi4 = vtr(vp + 8 * 128);
                const bf16x8 vf = (bf16x8){lo[0], lo[1], lo[2], lo[3], hi4[0], hi4[1], hi4[2], hi4[3]};
                o[d] = __builtin_amdgcn_mfma_f32_32x32x16_bf16(vf, pf, o[d], 0, 0, 0);
            }
        }
}
template <bool FINAL>
__device__ __forceinline__ void attn_compute(LAS unsigned char* lds, const bf16_t* proj, const AttnItem& t, const AttnItem& nxt, bool more, bf16x8 (&qf)[4], bf16_t* o23, float* lse23, bf16_t* ycat, int lane, int wid) {
    const int w = wid & 3, r32 = lane & 31, hi = lane >> 5;
    LAS unsigned char* Kl = lds + (wid >> 2) * 16384; LAS unsigned char* Vl = Kl + 49152;
    const int nb = t.nb;
    const int tok = (nb * 128 + 32 * w + r32) * t.dil + t.r;
    const size_t qrow = (size_t)t.b * SEQ + tok, hrow = (size_t)(t.b * NH + t.h) * SEQ + tpos(tok);
    float l2 = 0.f, l3 = 0.f; u32x2 a2[8], a3[8];
    if (FINAL) { l2 = lse23[hrow]; l3 = lse23[(size_t)M * NH + hrow];
        const bf16_t* o2 = o23 + hrow * HD + 4 * hi; const bf16_t* o3 = o2 + (size_t)M * AW;
#pragma unroll
        for (int i = 0; i < 8; ++i) { a2[i] = *(const u32x2*)(o2 + 32 * (i >> 2) + 8 * (i & 3)); a3[i] = *(const u32x2*)(o3 + 32 * (i >> 2) + 8 * (i & 3)); } }
    f32x16 o[2];
#pragma unroll
    for (int d = 0; d < 2; ++d) o[d] = (f32x16){0.f, 0.f, 0.f, 0.f, 0.f, 0.f, 0.f, 0.f, 0.f, 0.f, 0.f, 0.f, 0.f, 0.f, 0.f, 0.f};
    float mx = NEGBIG, l = 0.f;
    attn_group<2, 3, true>(Kl, Vl, qf, o, mx, l, nb, w, lane);
    attn_group<0, 2, false>(Kl, Vl, qf, o, mx, l, nb, w, lane);
    l += __shfl_xor(l, 32);
    attn_load_q(proj, nxt, qf, lane, wid);
    const float lse = mx + __builtin_amdgcn_logf(l);
    if (!FINAL) {
        const float c1 = 1.0f / l;
        if (hi == 0) lse23[(size_t)t.br * M * NH + hrow] = lse;
        bf16_t* ob = o23 + ((size_t)t.br * M * NH + hrow) * HD + 8 * hi;
#pragma unroll
        for (int d = 0; d < 2; ++d)
#pragma unroll
            for (int g = 0; g < 4; g += 2) { u32x2 wa, wb;
                wa.x = cvt_pk_bf16(o[d][4 * g] * c1, o[d][4 * g + 1] * c1); wa.y = cvt_pk_bf16(o[d][4 * g + 2] * c1, o[d][4 * g + 3] * c1);
                wb.x = cvt_pk_bf16(o[d][4 * g + 4] * c1, o[d][4 * g + 5] * c1); wb.y = cvt_pk_bf16(o[d][4 * g + 6] * c1, o[d][4 * g + 7] * c1);
                *(u32x4*)(ob + 32 * d + 8 * g) = pair16(wa, wb); }
    } else {
        const float mm = fmaxf(lse, fmaxf(l2, l3));
        const float e1 = __builtin_amdgcn_exp2f(lse - mm), e2 = __builtin_amdgcn_exp2f(l2 - mm), e3 = __builtin_amdgcn_exp2f(l3 - mm);
        const float inv = 1.0f / (e1 + e2 + e3);
        const float c1 = e1 * inv / l, c2 = e2 * inv, c3 = e3 * inv;
        bf16_t* yo = ycat + qrow * DM + t.h * HD + 8 * hi;
#pragma unroll
        for (int d = 0; d < 2; ++d)
#pragma unroll
            for (int g = 0; g < 4; g += 2) { u32x2 wp[2];
#pragma unroll
                for (int e = 0; e < 2; ++e) { const int gg = g + e; const u32x2 b2 = a2[4 * d + gg], b3 = a3[4 * d + gg];
                    wp[e].x = cvt_pk_bf16(c1 * o[d][4 * gg] + c2 * bf_lo(b2.x) + c3 * bf_lo(b3.x), c1 * o[d][4 * gg + 1] + c2 * bf_hi(b2.x) + c3 * bf_hi(b3.x));
                    wp[e].y = cvt_pk_bf16(c1 * o[d][4 * gg + 2] + c2 * bf_lo(b2.y) + c3 * bf_lo(b3.y), c1 * o[d][4 * gg + 3] + c2 * bf_hi(b2.y) + c3 * bf_hi(b3.y)); }
                *(u32x4*)(yo + 32 * d + 8 * g) = pair16(wp[0], wp[1]); }
    }
}
template <bool FINAL>
__device__ __forceinline__ void attn_phase(LAS unsigned char* lds, const bf16_t* proj, bf16_t* o23, float* lse23, bf16_t* ycat, int tid, int lane, int wid) {
    constexpr int NR = FINAL ? 1024 : 2048, RB = FINAL ? 32 : 64;
    const int G = gridDim.x, J = G >> 3, xcd = blockIdx.x & 7, jj = blockIdx.x >> 3;
    const bool affine = (G & 7) == 0 && J > 0 && (RB % J) == 0;
    const int SPB = affine ? RB / J : 1, NS = affine ? 4 * SPB : (NR - (int)blockIdx.x + G - 1) / G;
    auto round_of = [&](int t) -> int {
        if (!affine) return (int)blockIdx.x + t * G;
        const int sidx = t / SPB, rr = jj + J * (t % SPB), bh = 4 * xcd + sidx;
        return FINAL ? bh * 32 + rr : (rr >> 5) * 1024 + bh * 32 + (rr & 31); };
    if (NS <= 0) return;
    int t = 0;
    u32x4 kv[6], vv[6]; bf16x8 qf[4];
    AttnItem cur = attn_decode<FINAL>(round_of(0), wid);
    attn_load(proj, cur, kv, vv, tid); attn_load_q(proj, cur, qf, lane, wid);
    for (;;) {
        attn_stage(lds, kv, vv, tid, wid);
        asm volatile("s_waitcnt lgkmcnt(0)\n\ts_barrier" ::: "memory");
        const bool more = t + 1 < NS;
        const AttnItem nxt = attn_decode<FINAL>(round_of(more ? t + 1 : t), wid);
        attn_load(proj, nxt, kv, vv, tid);
        attn_compute<FINAL>(lds, proj, cur, nxt, more, qf, o23, lse23, ycat, lane, wid);
        asm volatile("s_waitcnt lgkmcnt(0)\n\ts_barrier" ::: "memory");
        if (!more) break;
        cur = nxt; ++t;
    }
}
__device__ __forceinline__ void conv_phase(const bf16_t* proj, bf16_t* ycat, const float* cw, const float* cb, int tid) {
    const int c0 = (tid & 63) * 8;
    float w0[8], w1[8], w2[8], bb[8];
#pragma unroll
    for (int e = 0; e < 8; ++e) { w0[e] = cw[c0 + e]; w1[e] = cw[AW + c0 + e]; w2[e] = cw[2 * AW + c0 + e]; bb[e] = cb[c0 + e]; }
    for (int chunk = (blockIdx.x * NTHR + tid) >> 6; chunk < M / 16; chunk += (gridDim.x * NTHR) >> 6) {
        const int row0 = chunk * 16, t0 = row0 & (SEQ - 1);
        float p1[8], p2[8];
#pragma unroll
        for (int e = 0; e < 8; ++e) { p1[e] = 0.f; p2[e] = 0.f; }
        if (t0 >= 2) {
            const bf16_t* p = proj + (size_t)(row0 - 2) * 1024 + 512 + c0;
            const u32x4 pa = *(const u32x4*)p, pb = *(const u32x4*)(p + 1024);
#pragma unroll
            for (int e = 0; e < 4; ++e) { p2[2 * e] = bf_lo(pa[e]); p2[2 * e + 1] = bf_hi(pa[e]); p1[2 * e] = bf_lo(pb[e]); p1[2 * e + 1] = bf_hi(pb[e]); }
        }
#pragma unroll 4
        for (int rr = 0; rr < 16; ++rr) {
            const bf16_t* p = proj + (size_t)(row0 + rr) * 1024 + c0;
            const u32x4 gb = *(const u32x4*)p, pc = *(const u32x4*)(p + 512);
            float p0[8], y[8];
#pragma unroll
            for (int e = 0; e < 4; ++e) { p0[2 * e] = bf_lo(pc[e]); p0[2 * e + 1] = bf_hi(pc[e]); }
#pragma unroll
            for (int e = 0; e < 8; ++e) y[e] = w2[e] * p0[e] + w1[e] * p1[e] + w0[e] * p2[e] + bb[e];
            u32x4 o;
#pragma unroll
            for (int e = 0; e < 4; ++e) o[e] = cvt_pk_bf16(bf_lo(gb[e]) * y[2 * e], bf_hi(gb[e]) * y[2 * e + 1]);
            *(u32x4*)(ycat + (size_t)(row0 + rr) * DM + AW + c0) = o;
#pragma unroll
            for (int e = 0; e < 8; ++e) { p2[e] = p1[e]; p1[e] = p0[e]; }
        }
    }
}

#define XB_TMO      128
#define XB_XCNT(j)  (256  + 64 * (j))
#define XB_XSUB(j)  (1280 + 64 * (j))
#define XB_XGEN(j)  (2304 + 64 * (j))
#define XB_TOP      3328
#define XB_TOPGEN   3392
#define XCD_BAR_WORDS 3456
#define XB_SPIN_CAP (1u << 18)

__device__ __forceinline__ unsigned xb_ld(unsigned* p)              { return __hip_atomic_load(p, __ATOMIC_RELAXED, __HIP_MEMORY_SCOPE_AGENT); }
__device__ __forceinline__ unsigned xb_add(unsigned* p, unsigned v) { return __hip_atomic_fetch_add(p, v, __ATOMIC_RELAXED, __HIP_MEMORY_SCOPE_AGENT); }
__device__ __forceinline__ unsigned xb_xcc_id() { return (unsigned)__builtin_amdgcn_s_getreg((3 << 11) | 20) & 0xFu; }
#define XB_SPIN(cond, bar) do { unsigned _sp = 0; while (cond) { __builtin_amdgcn_s_sleep(1); \
    if ((++_sp & 255u) == 0u) { if (xb_ld(&(bar)[XB_TMO])) break; if (_sp > XB_SPIN_CAP) { atomicAdd(&(bar)[XB_TMO], 1u); break; } } } } while (0)

struct XcdBarrier {
    unsigned* bar; unsigned x;
    volatile LAS unsigned* st;
};

__device__ __forceinline__ XcdBarrier xcd_barrier_post(unsigned* bar, volatile LAS unsigned* st) {
    XcdBarrier b; b.bar = bar; b.x = xb_xcc_id(); b.st = st;
    if (threadIdx.x == 0) (void)xb_add(&bar[XB_XCNT(b.x)], 1u);
    return b;
}
__device__ __forceinline__ void xcd_barrier_complete(unsigned* bar, unsigned x, unsigned& nloc, unsigned& nx) {
    const unsigned G = gridDim.x * gridDim.y * gridDim.z;
    unsigned sum, cnt, mine, sp = 0u;
    for (;;) {
        sum = 0u; cnt = 0u; mine = 0u;
#pragma unroll
        for (unsigned j = 0; j < 16; ++j) { const unsigned c = xb_ld(&bar[XB_XCNT(j)]); sum += c; cnt += (c > 0u) ? 1u : 0u; mine = (j == x) ? c : mine; }
        if (sum == G) break;
        __builtin_amdgcn_s_sleep(1);
        if ((++sp & 255u) == 0u) { if (xb_ld(&bar[XB_TMO])) break; if (sp > XB_SPIN_CAP) { atomicAdd(&bar[XB_TMO], 1u); break; } }
    }
    nloc = mine > 0u ? mine : 1u; nx = cnt > 0u ? cnt : 1u;
}

__device__ __forceinline__ void xcd_barrier(const XcdBarrier& b) {
    asm volatile("s_waitcnt vmcnt(0)" ::: "memory");
    __syncthreads();
    if (threadIdx.x == 0) {
        unsigned* bar = b.bar;
        __builtin_amdgcn_s_waitcnt(0);
        unsigned nloc = b.st[0], nx = b.st[1];
        if (nloc == 0u) { xcd_barrier_complete(bar, b.x, nloc, nx); b.st[0] = nloc; b.st[1] = nx; }
        const unsigned old = xb_add(&bar[XB_XSUB(b.x)], 1u);
        const unsigned gen = old / nloc;
        if (old + 1u == (gen + 1u) * nloc) {
            __builtin_amdgcn_fence(__ATOMIC_RELEASE, "agent");
            asm volatile("s_waitcnt vmcnt(0)" ::: "memory");
            const unsigned og = xb_add(&bar[XB_TOP], 1u);
            const unsigned tg = og / nx;
            if (og + 1u == (tg + 1u) * nx) xb_add(&bar[XB_TOPGEN], 1u);
            else XB_SPIN(xb_ld(&bar[XB_TOPGEN]) == tg, bar);
            __builtin_amdgcn_fence(__ATOMIC_ACQUIRE, "agent");
            xb_add(&bar[XB_XGEN(b.x)], 1u);
            asm volatile("s_waitcnt vmcnt(0)" ::: "memory");
        } else {
            XB_SPIN(xb_ld(&bar[XB_XGEN(b.x)]) == gen, bar);
            __builtin_amdgcn_fence(__ATOMIC_ACQUIRE, "agent");
            asm volatile("s_waitcnt vmcnt(0)" ::: "memory");
        }
    }
    __syncthreads();
}

#ifndef MK_MULTI
#define MK_MULTI 0
#endif
constexpr int N_PHASES = 2 + 8 * DEPTH;
#ifndef PROBE_DUP_MASK
#define PROBE_DUP_MASK 0
#endif
struct Args { In in; float* out; unsigned char* ws; int ph_lo, ph_hi; };
static_assert(sizeof(Args) == 15 * 8 + 8, "Args has no padding");
template <class T> __device__ __forceinline__ T* uptr(T* p) {
    const unsigned long long v = (unsigned long long)p;
    const unsigned lo = __builtin_amdgcn_readfirstlane((unsigned)v), hi = __builtin_amdgcn_readfirstlane((unsigned)(v >> 32));
    return (T*)(((unsigned long long)hi << 32) | lo);
}

__global__ void __launch_bounds__(NTHR, 2) fwd_megakernel(Args a) {
    extern __shared__ __attribute__((aligned(16))) unsigned char lds_raw[];
    LAS unsigned char* lds = (LAS unsigned char*)lds_raw;
    cg::grid_group grid = cg::this_grid();
    const int wave0 = __builtin_amdgcn_readfirstlane(threadIdx.x >> 6);
    unsigned char* ws = a.ws;
    volatile LAS unsigned* MISC = (volatile LAS unsigned*)(lds + MISC_OFF);
    if (threadIdx.x < 16) MISC[threadIdx.x] = 0u;
    __syncthreads();
    XcdBarrier bar; bar.bar = (unsigned*)(ws + WS_CTL); bar.x = 0; bar.st = nullptr;
    if (a.ph_hi - a.ph_lo > 1 && a.ph_lo >= 0) bar = xcd_barrier_post((unsigned*)(ws + WS_CTL), MISC + 8);
    for (int ph_ = a.ph_lo < 0 ? 0 : a.ph_lo; ph_ < a.ph_hi; ++ph_) {
        int ph = ph_; asm volatile("" : "+s"(ph));
        int nrep = ph < 2 ? ((PROBE_DUP_MASK >> 8) & 1) + 1 : ((PROBE_DUP_MASK >> ((ph - 2) % 8)) & 1) + 1;
        if (ph == 3 && ((PROBE_DUP_MASK >> 9) & 1)) nrep = 2;
        asm volatile("" : "+s"(nrep));
        for (int rep = 0; rep < nrep; ++rep) {
        asm volatile("" : "+s"(ph));
        int wave = wave0; asm volatile("" : "+s"(wave));
        int lane = (int)__builtin_amdgcn_mbcnt_hi(~0u, __builtin_amdgcn_mbcnt_lo(~0u, 0u)); asm volatile("" : "+v"(lane));
        const int tid = wave * 64 + lane;
        size_t wz = 0; asm volatile("" : "+s"(wz));
        unsigned char* ws = a.ws + wz;
        float* mod = (float*)(ws + WS_MOD);
        unsigned char* ob = (unsigned char*)a.out + wz;
        bf16_t* YC = (bf16_t*)(ob + OUT_YC); bf16_t* ACT = (bf16_t*)(ws + WS_ACT);
        bf16_t* QKVb = (bf16_t*)(ws + WS_QKV); bf16_t* XB = (bf16_t*)(ws + WS_XB);
        bf16_t* O23 = (bf16_t*)(ob + OUT_O23); float* LSE = (float*)(ws + WS_LSE);
        float* SW = (float*)(ws + WS_SW); float* RSS = (float*)(ws + WS_RSS);
        if (ph == 0) { mod_phase(a.in, ws, lds, tid, lane, wave); weights_phase(a.in, ws, lds, tid, lane, wave, (float*)(ws + WS_SW), 0); }
        else if (ph == 1) { weights_phase(a.in, ws, lds, tid, lane, wave, (float*)(ws + WS_SW), 1); }
        else {
            const int q = ph - 2, L = q / 8, k = q % 8;
            unsigned char* lw = ws + WS_W + (size_t)L * LW_BYTES;
            const float* lmod = mod + (size_t)L * NB * MODW;
            if (k == 0 || k == 6) {
                const int f = k == 6, sub = 2 * f;
                pg8::Gemm g{XB, (const bf16_t*)(lw + LW_W1 + (size_t)f * NB * W1_BYTES), M, 2 * FF, DM, W1_BYTES}; pg8::StaticOrder S; S.init(M, 2 * FF, gridDim.x, blockIdx.x);
                pg8::EpiSwiglu E{ACT, FF, RSS + (size_t)(L * 3 + sub) * M, SW + (size_t)(L * 3 + sub) * NB * NSW};
                pg8::gemm_phase<pg8::EpiSwiglu, pg8::StaticOrder, true, true>(lds, tid, g, S, E);
            } else if (k == 1 || k == 7 || k == 5) {
                const int f = k == 7, sub = k == 1 ? 0 : (k == 5 ? 1 : 2);
                const bool last = (L == DEPTH - 1 && k == 7);
                const bf16_t* A = k == 5 ? YC : ACT; const bf16_t* Bt = k == 5 ? (const bf16_t*)(lw + LW_WOUT) : (const bf16_t*)(lw + LW_W2 + f * W2_BYTES);
                pg8::Gemm g{A, Bt, M, DM, k == 5 ? DM : FF, 0}; pg8::StaticOrder S; S.init(M, DM, gridDim.x, blockIdx.x);
                const int nn = L * 3 + sub + 1;
                const bool has = nn < DEPTH * 3; const int ni = has ? nn : 0;
                LAS pg8::EpiResid::P* pp = (LAS pg8::EpiResid::P*)(lds + MISC_OFF + 64);
                if (tid == 0) { pp->xinb = XB; pp->out = a.out; pp->outb = XB; pp->gate = lmod + sub * 3 * DM + 2 * DM; pp->rss = RSS + (size_t)ni * M;
                    pp->gs = k == 5 ? 1.0f : 0.5f; pp->flags = (has ? 1 : 0) | (last ? 4 : 0); }
                __syncthreads();
                pg8::EpiResid E{pp};
                pg8::gemm_phase<pg8::EpiResid, pg8::StaticOrder, true, true>(lds, tid, g, S, E);
            } else if (k == 2) {
                pg8::Gemm g{XB, (const bf16_t*)(lw + LW_WIN), M, INC, DM, WIN_BYTES}; pg8::StaticOrder S; S.init(M, INC, gridDim.x, blockIdx.x);
                pg8::EpiWin E{ACT, 1024, QKVb, a.in.q_g + L * HD, a.in.k_g + L * HD, QSCALE, RSS + (size_t)(L * 3 + 1) * M, SW + (size_t)(L * 3 + 1) * NB * NSW};
                pg8::gemm_phase<pg8::EpiWin, pg8::StaticOrder, true, true>(lds, tid, g, S, E);
            } else if (k == 3) {
                attn_phase<false>(lds, QKVb, O23, LSE, nullptr, tid, lane, wave);
            } else {
                attn_phase<true>(lds, QKVb, O23, LSE, YC, tid, lane, wave);
                conv_phase(ACT, YC, a.in.conv_w + (size_t)L * 3 * AW, a.in.conv_b + (size_t)L * AW, tid);
            }
        }
        __syncthreads(); }
        if (ph_ + 1 < a.ph_hi) { if (a.ph_lo < 0) grid.sync(); else xcd_barrier(bar); }
    }
}

extern "C" void kernel_launch(void* const* d_in, const int* in_sizes, int n_in, void* d_out, int out_size, void* d_ws, size_t ws_size, hipStream_t stream) {
    static int grid_blocks = 0;
    if (grid_blocks == 0) {
        if (n_in != 13 || in_sizes[0] != M * DM || out_size != M * DM || ws_size < WS_END) { fprintf(stderr, "kernel_launch: unexpected shapes (n_in %d, in0 %d, out %d, ws %zu)\n", n_in, n_in > 0 ? in_sizes[0] : -1, out_size, ws_size); grid_blocks = -1; return; }
        int dev = 0, cus = 0, per_cu = 0;
        hipGetDevice(&dev);
        hipDeviceGetAttribute(&cus, hipDeviceAttributeMultiprocessorCount, dev);
        if (hipFuncSetAttribute((const void*)fwd_megakernel, hipFuncAttributeMaxDynamicSharedMemorySize, LDS_BYTES) != hipSuccess) fprintf(stderr, "kernel_launch: hipFuncSetAttribute failed\n");
        if (hipOccupancyMaxActiveBlocksPerMultiprocessor(&per_cu, (const void*)fwd_megakernel, NTHR, LDS_BYTES) != hipSuccess || per_cu < 1) { fprintf(stderr, "kernel_launch: occupancy query says %d\n", per_cu); per_cu = 1; }
        (void)hipGetLastError();
        grid_blocks = cus * per_cu;
    }
    if (grid_blocks < 0) return;
    Args a{};
    const float** ip = (const float**)&a.in;
    for (int i = 0; i < 13; ++i) ip[i] = (const float*)d_in[i];
    a.out = (float*)d_out; a.ws = (unsigned char*)d_ws;
    if (hipMemsetAsync((char*)d_ws + WS_CTL, 0, ZERO_BYTES, stream) != hipSuccess) { fprintf(stderr, "kernel_launch: memset failed\n"); return; }
#if MK_MULTI
    for (int ph = 0; ph < N_PHASES; ++ph) { a.ph_lo = ph; a.ph_hi = ph + 1; hipLaunchKernelGGL(fwd_megakernel, dim3(grid_blocks), dim3(NTHR), LDS_BYTES, stream, a); }
#else
    a.ph_lo = 0; a.ph_hi = N_PHASES;
    void* args[] = {&a};
    hipError_t e = hipLaunchCooperativeKernel((const void*)fwd_megakernel, dim3(grid_blocks), dim3(NTHR), args, LDS_BYTES, stream);
    if (e != hipSuccess) fprintf(stderr, "cooperative launch failed: %s (grid %d)\n", hipGetErrorString(e), grid_blocks);
#endif
}
```

```cpp
#include <hip/hip_runtime.h>
#include <hip/hip_cooperative_groups.h>
#include <cstdio>
#include <cstdint>
namespace cg = cooperative_groups;
namespace pg8 {
#define PG8_LAS __attribute__((address_space(3)))
typedef unsigned short bf16_t;
typedef short bf16x8 __attribute__((ext_vector_type(8)));
typedef float f32x4 __attribute__((ext_vector_type(4)));
typedef unsigned u32x4 __attribute__((ext_vector_type(4)));
constexpr int BM = 256, BK = 64, HALF = 128, HTB = HALF * BK * 2  , STAGE_BYTES = 8 * HTB, NXCD = 8, WGM = 8;

__host__ __device__ __forceinline__ int lds_byte(int r, int c) { const int st = (r >> 4) * 2 + (c >> 5), rr = r & 15, cc = c & 31, ob = rr * 64 + cc * 2; return st * 1024 + (ob ^ (((ob >> 9) & 1) << 5)); }
__host__ __device__ __forceinline__ void stage_rc(int b, int& R, int& C) { const int st = b / 1024, sb = b % 1024, swz = sb ^ (((sb >> 9) & 1) << 5); R = (st >> 1) * 16 + swz / 64; C = (st & 1) * 32 + (swz % 64) / 2; }
__host__ __device__ __forceinline__ int perm32(int rho) { const int n = rho >> 4, i = rho & 15; return 8 * (i >> 2) + 4 * n + (i & 3); }

struct Unit { int pm, pn; };
struct Gemm { const bf16_t* A; const bf16_t* Bt; int M, N, K; size_t bstride; };

struct StaticOrder {
    int nM, nN, nwg, G, c;
    __host__ __device__ void init(int M, int N, int G_, int c_) { nM = M / BM; nN = N / BM; nwg = nM * nN; G = G_; c = c_; }
    __host__ __device__ bool next(int i, Unit& u) const {
        const long L = (long)i * G + c; if (L >= nwg) return false;
        int wgid = (int)L; { const int q = nwg / NXCD, r = nwg % NXCD, xcd = wgid % NXCD, off = wgid / NXCD; wgid = (xcd < r ? xcd * (q + 1) : r * (q + 1) + (xcd - r) * q) + off; }
        const int nig = WGM * nN, gid = wgid / nig, fm = gid * WGM, gsz = (nM - fm) < WGM ? (nM - fm) : WGM;
        u.pm = fm + ((wgid % nig) % gsz); u.pn = (wgid % nig) / gsz; return true;
    }
    __device__ __forceinline__ void a_ready(const Unit&) const {}
    __device__ __forceinline__ void done(const Unit&) const {}
};

typedef unsigned u32x2 __attribute__((ext_vector_type(2)));
__device__ __forceinline__ unsigned cvt_pk_bf16(float lo, float hi) { typedef float f2 __attribute__((ext_vector_type(2))); typedef __bf16 b2 __attribute__((ext_vector_type(2)));
    f2 v = {lo, hi}; b2 b = __builtin_convertvector(v, b2); return __builtin_bit_cast(unsigned, b); }
__device__ __forceinline__ float silu_f(float g) { return g * __builtin_amdgcn_rcpf(1.0f + __builtin_amdgcn_exp2f(-1.4426950408889634f * g)); }

struct EpiSwiglu {
    static constexpr bool PERM = true, AFTER_DRAIN = false;
    bf16_t* O; int ldc;
    const float* rss; const float* sw;
    __device__ __forceinline__ void operator()(const f32x4 (&acc)[2][2][4][2], const Unit& u, int wr, int wc, int fr, int fq) const {
        const int row0 = u.pm * BM + wr * 64 + fr, col0 = u.pn * HALF + wc * 32 + 8 * fq;
        const float* swp = sw + (size_t)((u.pm * BM) >> 13) * (2 * 2816) + u.pn * BM + wc * 32 + 8 * fq;
        f32x4 sv[2][2];
#pragma unroll
        for (int bj = 0; bj < 2; ++bj)
#pragma unroll
            for (int n = 0; n < 2; ++n) sv[bj][n] = *(const f32x4*)(swp + bj * HALF + 4 * n);
        float rsv[2][4];
#pragma unroll
        for (int ai = 0; ai < 2; ++ai)
#pragma unroll
            for (int m = 0; m < 4; ++m) rsv[ai][m] = rss[row0 + ai * HALF + m * 16];
#pragma unroll
        for (int ai = 0; ai < 2; ++ai)
#pragma unroll
            for (int m = 0; m < 4; ++m) {
                const float rs = __builtin_amdgcn_rsqf(rsv[ai][m] * (1.0f / 1024.0f) + 1e-6f);
                const f32x4 g0 = acc[ai][0][m][0] * rs + sv[0][0], g1 = acc[ai][0][m][1] * rs + sv[0][1], u0 = acc[ai][1][m][0] * rs + sv[1][0], u1 = acc[ai][1][m][1] * rs + sv[1][1];
                u32x4 w;
                w.x = cvt_pk_bf16(silu_f(g0[0]) * u0[0], silu_f(g0[1]) * u0[1]); w.y = cvt_pk_bf16(silu_f(g0[2]) * u0[2], silu_f(g0[3]) * u0[3]);
                w.z = cvt_pk_bf16(silu_f(g1[0]) * u1[0], silu_f(g1[1]) * u1[1]); w.w = cvt_pk_bf16(silu_f(g1[2]) * u1[2], silu_f(g1[3]) * u1[3]);
                *(u32x4*)(O + (size_t)(row0 + ai * HALF + m * 16) * ldc + col0) = w;
            }
    }
};
struct EpiWin {
    static constexpr bool PERM = true, AFTER_DRAIN = false;
    bf16_t* O; int ldc; bf16_t* QKV; const float* qg; const float* kg; float qscale; const float* rss; const float* sw;
    __device__ __forceinline__ void operator()(const f32x4 (&acc)[2][2][4][2], const Unit& u, int wr, int wc, int fr, int fq) const {
        const int row0 = u.pm * BM + wr * 64 + fr, col0 = u.pn * BM + wc * 64 + 8 * fq;
        const int kind = u.pn < 2 ? 1 : (u.pn < 4 ? 2 : 0);
        f32x4 gv[2][2];
#pragma unroll
        for (int bj = 0; bj < 2; ++bj)
#pragma unroll
            for (int n = 0; n < 2; ++n) gv[bj][n] = kind ? *(const f32x4*)((kind == 1 ? qg : kg) + 32 * bj + 8 * fq + 4 * n) : (f32x4){1.f, 1.f, 1.f, 1.f};
        const float ks = kind == 1 ? qscale : 1.0f;
        const float* swp = sw + (size_t)((u.pm * BM) >> 13) * (2 * 2816) + u.pn * BM + wc * 32 + 8 * fq;
        f32x4 sv[2][2];
#pragma unroll
        for (int bj = 0; bj < 2; ++bj)
#pragma unroll
            for (int n = 0; n < 2; ++n) sv[bj][n] = *(const f32x4*)(swp + bj * HALF + 4 * n);
        float rsv[2][4];
#pragma unroll
        for (int ai = 0; ai < 2; ++ai)
#pragma unroll
            for (int m = 0; m < 4; ++m) rsv[ai][m] = rss[row0 + ai * HALF + m * 16];
#pragma unroll
        for (int ai = 0; ai < 2; ++ai)
#pragma unroll
            for (int m = 0; m < 4; ++m) {
                const float rn = __builtin_amdgcn_rsqf(rsv[ai][m] * (1.0f / 1024.0f) + 1e-6f);
                f32x4 hv[2][2];
#pragma unroll
                for (int bj = 0; bj < 2; ++bj)
#pragma unroll
                    for (int n = 0; n < 2; ++n) hv[bj][n] = acc[ai][bj][m][n] * rn + sv[bj][n];
                float rs = 1.0f;
                if (kind) {
                    float ss = 0.f;
#pragma unroll
                    for (int bj = 0; bj < 2; ++bj)
#pragma unroll
                        for (int n = 0; n < 2; ++n) { const f32x4 x = hv[bj][n]; ss += (x[0] * x[0] + x[1] * x[1]) + (x[2] * x[2] + x[3] * x[3]); }
                    ss += __shfl_xor(ss, 16); ss += __shfl_xor(ss, 32);
                    rs = ks * __builtin_amdgcn_rsqf(ss * (1.0f / 64.0f) + 1e-6f);
                }
                const int row = row0 + ai * HALF + m * 16;
                const int tk = row & 8191, tp = (tk & ~2047) | ((tk & 15) << 7) | ((tk & 2047) >> 4);
                if (u.pn >= 8) {
                    const f32x4 p0 = hv[0][0] * hv[1][0], p1 = hv[0][1] * hv[1][1];
                    u32x4 w; w.x = cvt_pk_bf16(p0[0], p0[1]); w.y = cvt_pk_bf16(p0[2], p0[3]); w.z = cvt_pk_bf16(p1[0], p1[1]); w.w = cvt_pk_bf16(p1[2], p1[3]);
                    *(u32x4*)(O + (size_t)row * ldc + 512 + 128 * (u.pn - 8) + 32 * wc + 8 * fq) = w;
                    continue;
                }
                const size_t hrow = (size_t)((row >> 13) * 8 + (u.pn & 1) * 4 + wc) * 8192 + tp;
                bf16_t* rowp = u.pn < 2 ? QKV + hrow * 64 + 8 * fq : u.pn < 6 ? QKV + (size_t)4 * 8 * 8192 * 64 + hrow * 128 + ((u.pn >> 1) - 1) * 64 + 8 * fq
                                        : O + (size_t)row * ldc + (col0 - 1536);
#pragma unroll
                for (int bj = 0; bj < 2; ++bj) {
                    const f32x4 v0 = hv[bj][0] * (gv[bj][0] * rs), v1 = hv[bj][1] * (gv[bj][1] * rs);
                    u32x4 w; w.x = cvt_pk_bf16(v0[0], v0[1]); w.y = cvt_pk_bf16(v0[2], v0[3]); w.z = cvt_pk_bf16(v1[0], v1[1]); w.w = cvt_pk_bf16(v1[2], v1[3]);
                    *(u32x4*)(rowp + 32 * bj) = w;
                }
            }
    }
};
struct EpiResid {
    static constexpr bool PERM = true, AFTER_DRAIN = false;
    struct P { const bf16_t* xinb; float* out; bf16_t* outb; const float* gate; float* rss; float gs; int flags; };
    const PG8_LAS P* pp;
    __device__ __forceinline__ void operator()(const f32x4 (&acc)[2][2][4][2], const Unit& u, int wr, int wc, int fr, int fq) const {
#define PG8_GAS __attribute__((address_space(1)))
        const PG8_GAS bf16_t* xinb = (const PG8_GAS bf16_t*)pp->xinb; PG8_GAS float* out = (PG8_GAS float*)pp->out; PG8_GAS bf16_t* outb = (PG8_GAS bf16_t*)pp->outb; const PG8_GAS float* gate = (const PG8_GAS float*)pp->gate;
        PG8_GAS float* rss = (PG8_GAS float*)pp->rss; const float gs = pp->gs; const int flags = pp->flags; const bool has = flags & 1, outf = flags & 4;
        const int b = (u.pm * BM) >> 13;
        const PG8_GAS float* gp = gate + (size_t)b * 9216;
        const int row0 = u.pm * BM + wr * 64 + fr, col0 = u.pn * BM + wc * 32 + 8 * fq;
        f32x4 gv[2][2];
#pragma unroll
        for (int bj = 0; bj < 2; ++bj)
#pragma unroll
            for (int n = 0; n < 2; ++n) gv[bj][n] = *(const PG8_GAS f32x4*)(gp + col0 + bj * HALF + n * 4) * gs;
#pragma unroll
        for (int ai = 0; ai < 2; ++ai) {
            u32x4 xa[2][4][2];
#pragma unroll
            for (int m = 0; m < 4; ++m)
#pragma unroll
                for (int bj = 0; bj < 2; ++bj) xa[ai][m][bj] = *(const PG8_GAS u32x4*)(xinb + (size_t)(row0 + ai * HALF + m * 16) * 1024 + col0 + bj * HALF);
#pragma unroll
            for (int m = 0; m < 4; ++m) { const int row = row0 + ai * HALF + m * 16; const size_t off = (size_t)row * 1024 + col0; float ss = 0.f;
#pragma unroll
                for (int bj = 0; bj < 2; ++bj) {
                    const u32x4 t = xa[ai][m][bj];
                    const f32x4 x0 = (f32x4){__uint_as_float(t.x << 16), __uint_as_float(t.x & 0xffff0000u), __uint_as_float(t.y << 16), __uint_as_float(t.y & 0xffff0000u)};
                    const f32x4 x1 = (f32x4){__uint_as_float(t.z << 16), __uint_as_float(t.z & 0xffff0000u), __uint_as_float(t.w << 16), __uint_as_float(t.w & 0xffff0000u)};
                    const f32x4 o0 = x0 + gv[bj][0] * acc[ai][bj][m][0], o1 = x1 + gv[bj][1] * acc[ai][bj][m][1];
                    if (outf) { *(PG8_GAS f32x4*)(out + off + bj * HALF) = o0; *(PG8_GAS f32x4*)(out + off + bj * HALF + 4) = o1; }
                    else { u32x4 w; w.x = cvt_pk_bf16(o0[0], o0[1]); w.y = cvt_pk_bf16(o0[2], o0[3]); w.z = cvt_pk_bf16(o1[0], o1[1]); w.w = cvt_pk_bf16(o1[2], o1[3]); *(PG8_GAS u32x4*)(outb + off + bj * HALF) = w; }
                    if (has) { ss += ((o0[0] * o0[0] + o0[1] * o0[1]) + (o0[2] * o0[2] + o0[3] * o0[3])) + ((o1[0] * o1[0] + o1[1] * o1[1]) + (o1[2] * o1[2] + o1[3] * o1[3])); } }
                if (has) { ss += __shfl_xor(ss, 16); ss += __shfl_xor(ss, 32);
                    if (fq == 0) __hip_atomic_fetch_add((float*)(rss + row), ss, __ATOMIC_RELAXED, __HIP_MEMORY_SCOPE_AGENT); } }
            asm volatile("" ::: "memory"); }
    }
};
template <class Epi, class Sched, bool ALIGN_EPI = false, bool SP2 = false>
__device__ __forceinline__ void gemm_phase(PG8_LAS unsigned char* lds, const int tid, const Gemm g, const Sched& S, const Epi& E) {
    const int wid = __builtin_amdgcn_readfirstlane(tid >> 6), lane = tid & 63, wr = wid >> 2, wc = wid & 3, fr = lane & 15, fq = lane >> 4;
    const int K = g.K, nt = K / BK;
    unsigned voffA[2], voffB[2];
#pragma unroll
    for (int i = 0; i < 2; ++i) { int R, C; stage_rc(tid * 16 + i * 8192, R, C); const int Rb = Epi::PERM ? ((R & ~31) + perm32(R & 31)) : R;
        voffA[i] = (unsigned)(R * K + C) * 2u; voffB[i] = (unsigned)(Rb * K + C) * 2u; }
    const size_t kstep = (size_t)(BK * 2);
    const size_t hstep = (size_t)HALF * K * 2;
    const size_t tstep = 2 * hstep;
    const unsigned ldsw = (unsigned)wid * 1024u;
    const int aoff = lds_byte(wr * 64 + fr, fq * 8), boff = lds_byte(wc * 32 + fr, fq * 8);
#define PG8_SA(b, h) (((b) * 2 + (h)) * HTB)
#define PG8_SB(b, h) ((4 + (b) * 2 + (h)) * HTB)
#define PG8_STAGE(bufoff, gbase, voff) do { _Pragma("unroll") for (int _i = 0; _i < 2; ++_i) \
        __builtin_amdgcn_global_load_lds((const unsigned*)((const char*)(gbase) + (voff)[_i]), (PG8_LAS unsigned*)(lds + (bufoff) + ldsw + _i * 8192), 16, 0, 0); } while (0)
#define PG8_LDA(dst, b, h) do { _Pragma("unroll") for (int m = 0; m < 4; ++m) _Pragma("unroll") for (int k = 0; k < 2; ++k) dst[m][k] = *(const PG8_LAS bf16x8*)(lds + PG8_SA(b, h) + aoff + m * 2048 + k * 1024); } while (0)
#define PG8_LDB(dst, b, h) do { _Pragma("unroll") for (int n = 0; n < 2; ++n) _Pragma("unroll") for (int k = 0; k < 2; ++k) dst[n][k] = *(const PG8_LAS bf16x8*)(lds + PG8_SB(b, h) + boff + n * 2048 + k * 1024); } while (0)
#define PG8_MMA(ai, bj, At, Bt) do { __builtin_amdgcn_s_setprio(1); _Pragma("unroll") for (int m = 0; m < 4; ++m) _Pragma("unroll") for (int n = 0; n < 2; ++n) _Pragma("unroll") for (int k = 0; k < 2; ++k) \
        acc[ai][bj][m][n] = __builtin_amdgcn_mfma_f32_16x16x32_bf16(Bt[n][k], At[m][k], acc[ai][bj][m][n], 0, 0, 0); __builtin_amdgcn_s_setprio(0); } while (0)
#define PG8_WAIT_V(n) asm volatile("s_waitcnt vmcnt(" #n ")" ::: "memory")
#define PG8_WAIT_L(n) asm volatile("s_waitcnt lgkmcnt(" #n ")" ::: "memory")
#define PG8_BAR __builtin_amdgcn_s_barrier()
#define PG8_SCHED __builtin_amdgcn_sched_barrier(0)
    Unit cur, nxt; int ui = 0;
    if (!S.next(0, cur)) return;
    f32x4 acc[2][2][4][2];
#pragma unroll
    for (int a = 0; a < 2; ++a)
#pragma unroll
        for (int b = 0; b < 2; ++b)
#pragma unroll
            for (int m = 0; m < 4; ++m)
#pragma unroll
                for (int n = 0; n < 2; ++n) acc[a][b][m][n] = (f32x4){0.f, 0.f, 0.f, 0.f};
    bf16x8 At[4][2], B0[2][2], B1[2][2];
    const char* cA = (const char*)g.A + (size_t)cur.pm * tstep; const char* cB = (const char*)g.Bt + (size_t)cur.pn * tstep + (size_t)(cur.pm >> 5) * g.bstride;
    S.a_ready(cur);
    if constexpr (SP2) {
        PG8_STAGE(PG8_SB(0, 0), cB, voffB); PG8_STAGE(PG8_SB(0, 1), cB + hstep, voffB); PG8_STAGE(PG8_SA(0, 0), cA, voffA); PG8_STAGE(PG8_SA(0, 1), cA + hstep, voffA);
        if (wr == 1) PG8_BAR;
        PG8_WAIT_V(2); PG8_BAR;
        PG8_STAGE(PG8_SB(1, 0), cB + kstep, voffB); PG8_STAGE(PG8_SA(1, 0), cA + kstep, voffA); PG8_STAGE(PG8_SB(1, 1), cB + hstep + kstep, voffB);
        PG8_WAIT_V(6); PG8_BAR;
    } else {
        PG8_STAGE(PG8_SB(0, 0), cB, voffB); PG8_STAGE(PG8_SA(0, 0), cA, voffA); PG8_STAGE(PG8_SB(0, 1), cB + hstep, voffB); PG8_STAGE(PG8_SA(0, 1), cA + hstep, voffA);
        if (wr == 1) PG8_BAR;
        PG8_WAIT_V(4); PG8_BAR;
        PG8_STAGE(PG8_SB(1, 0), cB + kstep, voffB); PG8_STAGE(PG8_SA(1, 0), cA + kstep, voffA); PG8_STAGE(PG8_SB(1, 1), cB + hstep + kstep, voffB);
        PG8_WAIT_V(6); PG8_BAR;
    }
    for (;;) {
        const bool has_next = S.next(ui + 1, nxt);
        const char* nA = has_next ? (const char*)g.A + (size_t)nxt.pm * tstep : cA; const char* nB = has_next ? (const char*)g.Bt + (size_t)nxt.pn * tstep + (size_t)(nxt.pm >> 5) * g.bstride : cB;
        for (int t = 0; t < nt; t += 2) {
            const bool last = (t == nt - 2);
            const char* a1 = cA + (size_t)(t + 1) * kstep;
            const char* a2 = last ? nA : cA + (size_t)(t + 2) * kstep; const char* b2 = last ? nB : cB + (size_t)(t + 2) * kstep;
            const char* a3 = a2 + kstep; const char* b3 = b2 + kstep;
            if (last && has_next) S.a_ready(nxt);
            if constexpr (SP2) {
            PG8_LDB(B0, 0, 0); PG8_LDB(B1, 0, 1); PG8_SCHED; PG8_LDA(At, 0, 0); PG8_STAGE(PG8_SA(1, 1), a1 + hstep, voffA);
            PG8_WAIT_V(8); PG8_WAIT_L(0); PG8_BAR; PG8_MMA(0, 0, At, B0); PG8_MMA(0, 1, At, B1); PG8_BAR; PG8_SCHED;
            PG8_LDA(At, 0, 1); PG8_STAGE(PG8_SB(0, 0), b2, voffB); PG8_STAGE(PG8_SB(0, 1), b2 + hstep, voffB); PG8_STAGE(PG8_SA(0, 0), a2, voffA);
            PG8_WAIT_V(8); PG8_WAIT_L(0); PG8_BAR; PG8_MMA(1, 0, At, B0); PG8_MMA(1, 1, At, B1); PG8_BAR; PG8_SCHED;
            PG8_LDB(B0, 1, 0); PG8_LDB(B1, 1, 1); PG8_SCHED; PG8_LDA(At, 1, 0); PG8_STAGE(PG8_SA(0, 1), a2 + hstep, voffA);
            PG8_WAIT_V(8); PG8_WAIT_L(0); PG8_BAR; PG8_MMA(0, 0, At, B0); PG8_MMA(0, 1, At, B1); PG8_BAR; PG8_SCHED;
            PG8_LDA(At, 1, 1); PG8_STAGE(PG8_SB(1, 0), b3, voffB); PG8_STAGE(PG8_SB(1, 1), b3 + hstep, voffB); PG8_STAGE(PG8_SA(1, 0), a3, voffA);
            PG8_WAIT_V(8); PG8_WAIT_L(0); PG8_BAR; PG8_MMA(1, 0, At, B0); PG8_MMA(1, 1, At, B1); PG8_BAR; PG8_SCHED;
            } else {
            PG8_LDB(B0, 0, 0); PG8_SCHED; PG8_LDA(At, 0, 0); PG8_STAGE(PG8_SA(1, 1), a1 + hstep, voffA);
            PG8_WAIT_L(8); PG8_BAR; PG8_WAIT_L(0); PG8_MMA(0, 0, At, B0); PG8_BAR; PG8_SCHED;
            PG8_LDB(B1, 0, 1); PG8_STAGE(PG8_SB(0, 0), b2, voffB);
            PG8_BAR; PG8_WAIT_L(0); PG8_MMA(0, 1, At, B1); PG8_BAR;
            PG8_LDA(At, 0, 1); PG8_STAGE(PG8_SA(0, 0), a2, voffA);
            PG8_BAR; PG8_WAIT_L(0); PG8_MMA(1, 0, At, B0); PG8_BAR; PG8_SCHED;
            PG8_STAGE(PG8_SB(0, 1), b2 + hstep, voffB);
            PG8_WAIT_V(6); PG8_BAR; PG8_MMA(1, 1, At, B1); PG8_BAR;
            PG8_LDB(B0, 1, 0); PG8_SCHED; PG8_LDA(At, 1, 0); PG8_STAGE(PG8_SA(0, 1), a2 + hstep, voffA);
            PG8_WAIT_L(8); PG8_BAR; PG8_WAIT_L(0); PG8_MMA(0, 0, At, B0); PG8_BAR; PG8_SCHED;
            PG8_LDB(B1, 1, 1); PG8_STAGE(PG8_SB(1, 0), b3, voffB);
            PG8_BAR; PG8_WAIT_L(0); PG8_MMA(0, 1, At, B1); PG8_BAR;
            PG8_LDA(At, 1, 1); PG8_STAGE(PG8_SA(1, 0), a3, voffA);
            PG8_BAR; PG8_WAIT_L(0); PG8_MMA(1, 0, At, B0); PG8_BAR; PG8_SCHED;
            PG8_STAGE(PG8_SB(1, 1), b3 + hstep, voffB);
            PG8_WAIT_V(6); PG8_BAR; PG8_MMA(1, 1, At, B1); PG8_BAR;
            }
        }
        if constexpr (ALIGN_EPI) { if (wr == 0) PG8_BAR; }
        if constexpr (!Epi::AFTER_DRAIN) { E(acc, cur, wr, wc, fr, fq); S.done(cur); }
        if (!has_next) break;
#pragma unroll
        for (int a = 0; a < 2; ++a)
#pragma unroll
            for (int b = 0; b < 2; ++b)
#pragma unroll
                for (int m = 0; m < 4; ++m)
#pragma unroll
                    for (int n = 0; n < 2; ++n) acc[a][b][m][n] = (f32x4){0.f, 0.f, 0.f, 0.f};
        cur = nxt; cA = nA; cB = nB; ++ui;
        if constexpr (ALIGN_EPI) { if (wr == 1) PG8_BAR; }
    }
    PG8_WAIT_V(0);
    if constexpr (!ALIGN_EPI) { if (wr == 0) PG8_BAR; }
    PG8_BAR;
    if constexpr (Epi::AFTER_DRAIN) { E.fused(acc, cur, wr, wc, fr, fq, lds, wid, lane); S.done(cur); }
#undef PG8_SA
#undef PG8_SB
#undef PG8_STAGE
#undef PG8_LDA
#undef PG8_LDB
#undef PG8_MMA
#undef PG8_WAIT_V
#undef PG8_WAIT_L
#undef PG8_BAR
#undef PG8_SCHED
}
}

#define LAS __attribute__((address_space(3)))
typedef unsigned short bf16_t;
typedef short bf16x8 __attribute__((ext_vector_type(8)));
typedef short s16x4 __attribute__((ext_vector_type(4)));
typedef float f32x4 __attribute__((ext_vector_type(4)));
typedef float f32x16 __attribute__((ext_vector_type(16)));
typedef unsigned u32x4 __attribute__((ext_vector_type(4)));
typedef unsigned u32x2 __attribute__((ext_vector_type(2)));
constexpr int DM = 1024, NB = 4, SEQ = 8192, DEPTH = 2, FF = 2816, NH = 8, HD = 64, AW = 512, INC = 3072, MODW = 9216;
constexpr int M = NB * SEQ;
constexpr float EPS = 1e-6f;
constexpr float QSCALE = 0.125f * 1.4426950408889634f;
constexpr float NEGBIG = -1e30f;
constexpr int NWAVES = 8, NTHR = 512;
constexpr size_t MiB = 1u << 20;
constexpr size_t WS_MOD = 0;
constexpr size_t WS_ST = MiB / 2;
constexpr size_t WS_GT = 3 * MiB / 4;
constexpr size_t WS_CTL = 1 * MiB, CTL_BYTES = 16384;
constexpr int NSW = 2 * FF;
constexpr size_t WS_SW = WS_CTL + CTL_BYTES, SW_BYTES = (size_t)DEPTH * 3 * NB * NSW * 4;
constexpr size_t WS_RSS = WS_SW + SW_BYTES, RSS_BYTES = (size_t)DEPTH * 3 * M * 4;
constexpr size_t ZERO_BYTES = CTL_BYTES + SW_BYTES + RSS_BYTES;
constexpr size_t WS_W = 5 * MiB / 2;
static_assert(WS_CTL + ZERO_BYTES <= WS_W, "zeroed region");
constexpr size_t W1_BYTES = (size_t)2 * FF * DM * 2, W2_BYTES = (size_t)DM * FF * 2, WIN_BYTES = (size_t)INC * DM * 2, WOUT_BYTES = (size_t)DM * DM * 2;
constexpr size_t LW_W1 = 0, LW_WIN = 2 * NB * W1_BYTES, LW_W2 = LW_WIN + NB * WIN_BYTES, LW_WOUT = LW_W2 + 2 * W2_BYTES, LW_BYTES = LW_WOUT + WOUT_BYTES;
static_assert(WS_W + DEPTH * LW_BYTES <= 253 * MiB, "weights");
constexpr size_t WS_ACT = 253 * MiB;
constexpr size_t WS_QKV = WS_ACT + 96 * MiB;
constexpr size_t WS_XB = 445 * MiB;
constexpr size_t WS_LSE = 509 * MiB;
constexpr size_t WS_END = 511 * MiB;
constexpr size_t OUT_O23 = 0, OUT_YC = 64 * MiB;
constexpr int RING_BYTES = 131072, WSCR_OFF = RING_BYTES, MISC_OFF = RING_BYTES + NWAVES * 512, LDS_BYTES = MISC_OFF + 256;

__device__ __forceinline__ float bf_lo(unsigned u) { return __uint_as_float(u << 16); }
__device__ __forceinline__ float bf_hi(unsigned u) { return __uint_as_float(u & 0xffff0000u); }
__device__ __forceinline__ float wave_sum(float v) {
#pragma unroll
    for (int o = 1; o < 64; o <<= 1) v += __shfl_xor(v, o);
    return v;
}
using pg8::cvt_pk_bf16;

struct In { const float *x, *c, *w_ada, *b_ada, *norm_g, *w_in, *q_g, *k_g, *conv_w, *conv_b, *w_out, *w1, *w2; };

__device__ __forceinline__ void mod_phase(const In& I, unsigned char* ws, LAS unsigned char* lds, int tid, int lane, int wave) {
    LAS float* sc = (LAS float*)(lds + 69632);
    LAS float* red = (LAS float*)(lds + 69632 + 16384);
    float* mod = (float*)(ws + WS_MOD); float* ST = (float*)(ws + WS_ST); float* GT = (float*)(ws + WS_GT);
    for (int i = tid; i < NB * DM; i += NTHR) { const float v = I.c[i]; sc[i] = v / (1.0f + __expf(-v)); }
    __syncthreads();
    typedef float f32x2 __attribute__((ext_vector_type(2)));
    for (int it = blockIdx.x; it < DEPTH * (MODW / 72); it += gridDim.x) {
        const int l = it / (MODW / 72), j0 = (it % (MODW / 72)) * 72;
        const int ln = lane < 36 ? lane : 35;
        const float* wp = I.w_ada + (size_t)l * DM * MODW + j0 + 2 * ln;
        f32x2 a0 = {0.f, 0.f}, a1 = a0, a2 = a0, a3 = a0; const int k0 = wave * 128;
#pragma unroll 16
        for (int k = k0; k < k0 + 128; ++k) { const f32x2 w = __builtin_nontemporal_load((const f32x2*)(wp + (size_t)k * MODW)); a0 += w * sc[k]; a1 += w * sc[DM + k]; a2 += w * sc[2 * DM + k]; a3 += w * sc[3 * DM + k]; }
        if (lane < 36) { LAS float* rp = red + wave * 4 * 72 + 2 * lane; rp[0] = a0.x; rp[1] = a0.y; rp[72] = a1.x; rp[73] = a1.y; rp[144] = a2.x; rp[145] = a2.y; rp[216] = a3.x; rp[217] = a3.y; }
        __syncthreads();
        if (tid < 288) { const int b = tid / 72, cl = tid % 72; float s = 0.f;
#pragma unroll
            for (int w = 0; w < 8; ++w) s += red[(w * 4 + b) * 72 + cl];
            const int j = j0 + cl; const float v = s + I.b_ada[(size_t)l * MODW + j];
            mod[(size_t)(l * NB + b) * MODW + j] = v;
            const int sub = j / 3072, jj = j % 3072; if (jj < DM) ST[((size_t)(l * 3 + sub) * DM + jj) * NB + b] = v;
            else if (jj < 2 * DM) GT[((size_t)(l * 3 + sub) * DM + jj - DM) * NB + b] = I.norm_g[(size_t)(l * 3 + sub) * DM + jj - DM] * (1.0f + v); }
        __syncthreads();
    }
}
__device__ __forceinline__ void transpose_item(const float* W, int K, int N, bf16_t* WT, int k0, int src_n0, int dst_n0, LAS float* scr, int lane, const float* st, float* sw, const float* gt, size_t cstride) {
    { f32x4 v[8]; const int c4 = lane & 7, kr = lane >> 3;
#pragma unroll
        for (int i = 0; i < 8; ++i) v[i] = __builtin_nontemporal_load((const f32x4*)(W + (size_t)(k0 + 8 * i + kr) * N + src_n0 + 4 * c4));
#pragma unroll
        for (int i = 0; i < 8; ++i) { LAS float* d = scr + (8 * i + kr) * 33 + 4 * c4; d[0] = v[i].x; d[1] = v[i].y; d[2] = v[i].z; d[3] = v[i].w; } }
    asm volatile("s_waitcnt lgkmcnt(0)" ::: "memory");
    const int c = lane & 7;
    if (!gt) {
#pragma unroll
        for (int j = 0; j < 4; ++j) { const int n = (lane >> 3) + 8 * j; const LAS float* s = scr + (8 * c) * 33 + n;
            u32x4 o; o.x = cvt_pk_bf16(s[0 * 33], s[1 * 33]); o.y = cvt_pk_bf16(s[2 * 33], s[3 * 33]); o.z = cvt_pk_bf16(s[4 * 33], s[5 * 33]); o.w = cvt_pk_bf16(s[6 * 33], s[7 * 33]);
            __builtin_nontemporal_store(o, (u32x4*)(WT + (size_t)(dst_n0 + n) * K + k0 + 8 * c)); }
    } else {
        f32x4 gk[8];
#pragma unroll
        for (int i = 0; i < 8; ++i) gk[i] = *(const f32x4*)(gt + (size_t)(k0 + 8 * c + i) * NB);
#pragma unroll
        for (int j = 0; j < 4; ++j) { const int n = (lane >> 3) + 8 * j; const LAS float* s = scr + (8 * c) * 33 + n;
            float w[8];
#pragma unroll
            for (int i = 0; i < 8; ++i) w[i] = s[i * 33];
#pragma unroll
            for (int b = 0; b < NB; ++b) {
                u32x4 o; o.x = cvt_pk_bf16(w[0] * gk[0][b], w[1] * gk[1][b]); o.y = cvt_pk_bf16(w[2] * gk[2][b], w[3] * gk[3][b]); o.z = cvt_pk_bf16(w[4] * gk[4][b], w[5] * gk[5][b]); o.w = cvt_pk_bf16(w[6] * gk[6][b], w[7] * gk[7][b]);
                __builtin_nontemporal_store(o, (u32x4*)(WT + (size_t)b * cstride + (size_t)(dst_n0 + n) * K + k0 + 8 * c)); } }
    }
    if (st) { const int n = lane & 31, hf = lane >> 5; f32x4 a4 = {0.f, 0.f, 0.f, 0.f};
#pragma unroll 8
        for (int i = 0; i < 32; ++i) { const int kk = hf * 32 + i; a4 += *(const f32x4*)(st + (size_t)(k0 + kk) * NB) * scr[kk * 33 + n]; }
#pragma unroll
        for (int b = 0; b < 4; ++b) a4[b] += __shfl_xor(a4[b], 32);
        if (hf == 0) {
#pragma unroll
            for (int b = 0; b < 4; ++b) __hip_atomic_fetch_add(sw + (size_t)b * NSW + dst_n0 + n, a4[b], __ATOMIC_RELAXED, __HIP_MEMORY_SCOPE_AGENT); } }
    asm volatile("s_waitcnt lgkmcnt(0)" ::: "memory");
}
__device__ __forceinline__ void weights_phase(const In& I, unsigned char* ws, LAS unsigned char* lds, int tid, int lane, int wave, float* SW, int which) {
    LAS float* scr = (LAS float*)(lds + wave * 8448);
    const int gw = blockIdx.x * NWAVES + wave, NGW = gridDim.x * NWAVES;
    const float* ST = (const float*)(ws + WS_ST); const float* GT = (const float*)(ws + WS_GT);
    constexpr int I_W1 = (DM / 64) * (2 * FF / 32), I_W2 = (FF / 64) * (DM / 32), I_WIN = (DM / 64) * (INC / 32), I_WOUT = (DM / 64) * (DM / 32);
    constexpr int I_LAYER = 2 * I_W1 + 2 * I_W2 + I_WIN + I_WOUT;
    for (int it = gw; it < DEPTH * I_LAYER; it += NGW) {
        const int l = it / I_LAYER; int r = it % I_LAYER;
        { const bool gain_item = r < 2 * I_W1 || (r >= 2 * I_W1 + 2 * I_W2 && r < 2 * I_W1 + 2 * I_W2 + I_WIN); if ((gain_item ? 1 : 0) != which) continue; }
        unsigned char* lw = ws + WS_W + (size_t)l * LW_BYTES;
        if (r < 2 * I_W1) { const int f = r / I_W1; r %= I_W1; const int nblk = 2 * FF / 32, kb = r / nblk, nb = r % nblk, n0 = nb * 32;
            const int pn = n0 >> 8, bj = (n0 >> 7) & 1, i = n0 & 127, sub = 2 * f;
            transpose_item(I.w1 + (size_t)(l * 2 + f) * DM * 2 * FF, DM, 2 * FF, (bf16_t*)(lw + LW_W1 + (size_t)f * NB * W1_BYTES), kb * 64, bj * FF + 128 * pn + i, n0, scr, lane,
                           ST + (size_t)(l * 3 + sub) * DM * NB, SW + (size_t)(l * 3 + sub) * NB * NSW, GT + (size_t)(l * 3 + sub) * DM * NB, W1_BYTES / 2); continue; }
        r -= 2 * I_W1;
        if (r < 2 * I_W2) { const int f = r / I_W2; r %= I_W2; const int nblk = DM / 32, kb = r / nblk, nb = r % nblk;
            transpose_item(I.w2 + (size_t)(l * 2 + f) * FF * DM, FF, DM, (bf16_t*)(lw + LW_W2 + f * W2_BYTES), kb * 64, nb * 32, nb * 32, scr, lane, nullptr, nullptr, nullptr, 0); continue; }
        r -= 2 * I_W2;
        if (r < I_WIN) { const int nblk = INC / 32, kb = r / nblk, nb = r % nblk, n0 = nb * 32; const int pn = n0 >> 8, bj = (n0 >> 7) & 1, wc = (n0 >> 5) & 3;
            const int srcn = pn < 8 ? 256 * pn + 64 * wc + 32 * bj : (bj ? 2560 : 2048) + 128 * (pn - 8) + 32 * wc;
            transpose_item(I.w_in + (size_t)l * DM * INC, DM, INC, (bf16_t*)(lw + LW_WIN), kb * 64, srcn, n0, scr, lane,
                           ST + (size_t)(l * 3 + 1) * DM * NB, SW + (size_t)(l * 3 + 1) * NB * NSW, GT + (size_t)(l * 3 + 1) * DM * NB, WIN_BYTES / 2); continue; }
        r -= I_WIN;
        { const int nblk = DM / 32, kb = r / nblk, nb = r % nblk;
            transpose_item(I.w_out + (size_t)l * DM * DM, DM, DM, (bf16_t*)(lw + LW_WOUT), kb * 64, nb * 32, nb * 32, scr, lane, nullptr, nullptr, nullptr, 0); }
    }
    if (which == 0) return;
    bf16_t* XB = (bf16_t*)(ws + WS_XB); float* RSS = (float*)(ws + WS_RSS);
    for (int chunk = gw; chunk < M / 16; chunk += NGW) {
        const int row0 = chunk * 16;
        for (int r4 = 0; r4 < 16; r4 += 4) {
            f32x4 v[4][4];
#pragma unroll
            for (int q = 0; q < 4; ++q) { const f32x4* xr = (const f32x4*)(I.x + (size_t)(row0 + r4 + q) * DM) + lane;
#pragma unroll
                for (int j = 0; j < 4; ++j) v[q][j] = __builtin_nontemporal_load(xr + 64 * j); }
#pragma unroll
            for (int q = 0; q < 4; ++q) { float ssq = 0.f;
#pragma unroll
                for (int j = 0; j < 4; ++j) ssq += (v[q][j].x * v[q][j].x + v[q][j].y * v[q][j].y) + (v[q][j].z * v[q][j].z + v[q][j].w * v[q][j].w);
                ssq = wave_sum(ssq);
                if (lane == 0) RSS[row0 + r4 + q] = ssq;
                u32x2* x8 = (u32x2*)(XB + (size_t)(row0 + r4 + q) * DM) + lane;
#pragma unroll
                for (int j = 0; j < 4; ++j) { u32x2 xw; xw.x = cvt_pk_bf16(v[q][j].x, v[q][j].y); xw.y = cvt_pk_bf16(v[q][j].z, v[q][j].w); x8[64 * j] = xw; } }
        }
    }
}

__device__ __forceinline__ int crow(int i, int hi) { return (i & 3) + 8 * (i >> 2) + 4 * hi; }
__device__ __forceinline__ u32x4 pair16(u32x2 wa, u32x2 wb) {
    const auto r0 = __builtin_amdgcn_permlane32_swap(wa.x, wb.x, false, false);
    const auto r1 = __builtin_amdgcn_permlane32_swap(wa.y, wb.y, false, false);
    return (u32x4){r0[0], r1[0], r0[1], r1[1]};
}
__device__ __forceinline__ int tpos(int t) { return (t & ~2047) | ((t & 15) << 7) | ((t & 2047) >> 4); }
typedef short v4i16_t __attribute__((ext_vector_type(4)));
__device__ __forceinline__ s16x4 vtr(LAS const unsigned char* p) { return __builtin_bit_cast(s16x4, __builtin_amdgcn_ds_read_tr16_b64_v4i16((LAS v4i16_t*)p)); }

struct AttnItem { int dil, b, h, r, nb, br; };
template <bool FINAL> __device__ __forceinline__ AttnItem attn_decode(int R, int wid) {
    AttnItem t; const int it = 2 * R + (wid >> 2);
    if (!FINAL) { const int br = it >> 11, rem = it & 2047, bh = rem >> 6, rn = rem & 63; t.br = br; t.dil = br ? 16 : 4; const int nbc = 64 / t.dil; t.r = rn / nbc; t.nb = rn % nbc; t.b = bh >> 3; t.h = bh & 7; }
    else { const int bh = it >> 6; t.br = 0; t.dil = 1; t.r = 0; t.nb = it & 63; t.b = bh >> 3; t.h = bh & 7; }
    return t;
}
__device__ __forceinline__ void attn_load(const bf16_t* proj, const AttnItem& t, u32x4 (&kv)[6], u32x4 (&vv)[6], int tid) {
    const int nb0 = t.nb & ~1;
    const bf16_t* kb = proj + (size_t)NB * NH * SEQ * HD + (size_t)(t.b * NH + t.h) * SEQ * 2 * HD;
#pragma unroll
    for (int c = 0; c < 6; ++c) { const int idx = tid + 512 * c, j = idx >> 3, ch = idx & 7; const int sidx = (nb0 - 1) * 128 + j;
        const int sj = sidx >= 0 ? sidx : sidx + 128;
        const bf16_t* p = kb + (size_t)tpos(sj * t.dil + t.r) * 2 * HD + ch * 8; kv[c] = *(const u32x4*)p; vv[c] = *(const u32x4*)(p + HD); }
}
__device__ __forceinline__ void attn_load_q(const bf16_t* proj, const AttnItem& t, bf16x8 (&qf)[4], int lane, int wid) {
    const int w = wid & 3, r32 = lane & 31, hi = lane >> 5;
    const size_t qrow = (size_t)(t.b * NH + t.h) * SEQ + tpos((t.nb * 128 + 32 * w + r32) * t.dil + t.r);
#pragma unroll
    for (int ks = 0; ks < 4; ++ks) qf[ks] = *(const bf16x8*)(proj + qrow * HD + 16 * ks + 8 * hi);
}
__device__ __forceinline__ void attn_stage(LAS unsigned char* lds, const u32x4 (&kv)[6], const u32x4 (&vv)[6], int tid, int wid) {
    LAS unsigned char* Kl = lds; LAS unsigned char* Vl = lds + 49152;
#pragma unroll
    for (int c = 0; c < 6; ++c) { const int idx = tid + 512 * c, j = idx >> 3, ch = idx & 7;
        *(LAS u32x4*)(Kl + j * 128 + ((ch ^ ((j >> 1) & 7)) * 16)) = kv[c];
        *(LAS u32x4*)(Vl + j * 128 + (((ch >> 2) ^ ((j >> 1) & 1)) * 64) + (ch & 3) * 16) = vv[c]; }
}
template <int T0, int NT, bool FIRST>
__device__ __forceinline__ void attn_group(LAS const unsigned char* Kl, LAS const unsigned char* Vl, const bf16x8 (&qf)[4], f32x16 (&o)[2], float& mx, float& l, int nb, int w, int lane) {
    const int r32 = lane & 31, hi = lane >> 5;
    f32x16 s[NT];
#pragma unroll
    for (int t = 0; t < NT; ++t) { const float z = (T0 + t < 4 && nb == 0 && w + T0 + t < 4) ? NEGBIG : 0.f;
        s[t] = (f32x16){z, z, z, z, z, z, z, z, z, z, z, z, z, z, z, z}; }
    {
        LAS const unsigned char* kp = Kl + (32 * (w + T0) + r32) * 128;
        const int sw = (r32 >> 1) & 7;
#pragma unroll
        for (int ks = 0; ks < 4; ++ks) {
            bf16x8 kf[NT];
#pragma unroll
            for (int t = 0; t < NT; ++t) kf[t] = *(LAS const bf16x8*)(kp + t * 4096 + (((2 * ks + hi) ^ sw) * 16));
#pragma unroll
            for (int t = 0; t < NT; ++t) s[t] = __builtin_amdgcn_mfma_f32_32x32x16_bf16(kf[t], qf[ks], s[t], 0, 0, 0);
        }
    }
#pragma unroll
    for (int t = 0; t < NT; ++t) {
        const int tt = T0 + t;
        if (tt == 0) {
#pragma unroll
            for (int i = 0; i < 16; ++i) if (crow(i, hi) < r32) s[t][i] = NEGBIG; }
        if (tt == 4) {
#pragma unroll
            for (int i = 0; i < 16; ++i) if (crow(i, hi) > r32) s[t][i] = NEGBIG; }
    }
    float m0 = s[0][0], m1 = s[0][1], m2 = s[0][2], m3 = s[0][3];
#pragma unroll
    for (int t = 0; t < NT; ++t)
#pragma unroll
        for (int i = 0; i < 16; i += 4) { m0 = fmaxf(m0, s[t][i]); m1 = fmaxf(m1, s[t][i + 1]); m2 = fmaxf(m2, s[t][i + 2]); m3 = fmaxf(m3, s[t][i + 3]); }
    float gm = fmaxf(fmaxf(m0, m1), fmaxf(m2, m3));
    gm = fmaxf(gm, __shfl_xor(gm, 32));
    if (FIRST) mx = gm;
    else { const float mn = fmaxf(mx, gm); const float f = __builtin_amdgcn_exp2f(mx - mn); l *= f; mx = mn;
#pragma unroll
        for (int d = 0; d < 2; ++d)
#pragma unroll
            for (int i = 0; i < 16; ++i) o[d][i] *= f; }
    float l0 = 0.f, l1 = 0.f, l2 = 0.f, l3 = 0.f;
#pragma unroll
    for (int t = 0; t < NT; ++t)
#pragma unroll
        for (int i = 0; i < 16; i += 4) {
            const float p0 = __builtin_amdgcn_exp2f(s[t][i] - mx), p1 = __builtin_amdgcn_exp2f(s[t][i + 1] - mx), p2 = __builtin_amdgcn_exp2f(s[t][i + 2] - mx), p3 = __builtin_amdgcn_exp2f(s[t][i + 3] - mx);
            s[t][i] = p0; s[t][i + 1] = p1; s[t][i + 2] = p2; s[t][i + 3] = p3; l0 += p0; l1 += p1; l2 += p2; l3 += p3; }
    l += (l0 + l1) + (l2 + l3);
    const int i16 = lane & 15, q4 = i16 >> 2, p4 = i16 & 3, blk = (lane >> 4) & 1;
    LAS const unsigned char* vb = Vl + (32 * (w + T0) + 4 * hi + q4) * 128 + 32 * blk + 8 * p4;
    const int vsw = ((q4 >> 1) & 1) * 64;
#pragma unroll
    for (int t = 0; t < NT; ++t)
#pragma unroll
        for (int s2 = 0; s2 < 2; ++s2) {
            u32x4 pw; pw.x = cvt_pk_bf16(s[t][8 * s2 + 0], s[t][8 * s2 + 1]); pw.y = cvt_pk_bf16(s[t][8 * s2 + 2], s[t][8 * s2 + 3]);
            pw.z = cvt_pk_bf16(s[t][8 * s2 + 4], s[t][8 * s2 + 5]); pw.w = cvt_pk_bf16(s[t][8 * s2 + 6], s[t][8 * s2 + 7]);
            const bf16x8 pf = __builtin_bit_cast(bf16x8, pw);
#pragma unroll
            for (int d = 0; d < 2; ++d) {
                LAS const unsigned char* vp = vb + (t * 32 + s2 * 16) * 128 + ((d * 64) ^ vsw);
                const s16x4 lo = vtr(vp), hi4 = vtr(vp + 8 * 128);
                const bf16x8 vf = (bf16x8){lo[0], lo[1], lo[2], lo[3], hi4[0], hi4[1], hi4[2], hi4[3]};
                o[d] = __builtin_amdgcn_mfma_f32_32x32x16_bf16(vf, pf, o[d], 0, 0, 0);
            }
        }
}
template <bool FINAL>
__device__ __forceinline__ void attn_compute(LAS unsigned char* lds, const bf16_t* proj, const AttnItem& t, const AttnItem& nxt, bool more, bf16x8 (&qf)[4], bf16_t* o23, float* lse23, bf16_t* ycat, int lane, int wid) {
    const int w = wid & 3, r32 = lane & 31, hi = lane >> 5;
    LAS unsigned char* Kl = lds + (wid >> 2) * 16384; LAS unsigned char* Vl = Kl + 49152;
    const int nb = t.nb;
    const int tok = (nb * 128 + 32 * w + r32) * t.dil + t.r;
    const size_t qrow = (size_t)t.b * SEQ + tok, hrow = (size_t)(t.b * NH + t.h) * SEQ + tpos(tok);
    float l2 = 0.f, l3 = 0.f; u32x2 a2[8], a3[8];
    if (FINAL) { l2 = lse23[hrow]; l3 = lse23[(size_t)M * NH + hrow];
        const bf16_t* o2 = o23 + hrow * HD + 4 * hi; const bf16_t* o3 = o2 + (size_t)M * AW;
#pragma unroll
        for (int i = 0; i < 8; ++i) { a2[i] = *(const u32x2*)(o2 + 32 * (i >> 2) + 8 * (i & 3)); a3[i] = *(const u32x2*)(o3 + 32 * (i >> 2) + 8 * (i & 3)); } }
    f32x16 o[2];
#pragma unroll
    for (int d = 0; d < 2; ++d) o[d] = (f32x16){0.f, 0.f, 0.f, 0.f, 0.f, 0.f, 0.f, 0.f, 0.f, 0.f, 0.f, 0.f, 0.f, 0.f, 0.f, 0.f};
    float mx = NEGBIG, l = 0.f;
    attn_group<2, 3, true>(Kl, Vl, qf, o, mx, l, nb, w, lane);
    attn_group<0, 2, false>(Kl, Vl, qf, o, mx, l, nb, w, lane);
    l += __shfl_xor(l, 32);
    attn_load_q(proj, nxt, qf, lane, wid);
    const float lse = mx + __builtin_amdgcn_logf(l);
    if (!FINAL) {
        const float c1 = 1.0f / l;
        if (hi == 0) lse23[(size_t)t.br * M * NH + hrow] = lse;
        bf16_t* ob = o23 + ((size_t)t.br * M * NH + hrow) * HD + 8 * hi;
#pragma unroll
        for (int d = 0; d < 2; ++d)
#pragma unroll
            for (int g = 0; g < 4; g += 2) { u32x2 wa, wb;
                wa.x = cvt_pk_bf16(o[d][4 * g] * c1, o[d][4 * g + 1] * c1); wa.y = cvt_pk_bf16(o[d][4 * g + 2] * c1, o[d][4 * g + 3] * c1);
                wb.x = cvt_pk_bf16(o[d][4 * g + 4] * c1, o[d][4 * g + 5] * c1); wb.y = cvt_pk_bf16(o[d][4 * g + 6] * c1, o[d][4 * g + 7] * c1);
                *(u32x4*)(ob + 32 * d + 8 * g) = pair16(wa, wb); }
    } else {
        const float mm = fmaxf(lse, fmaxf(l2, l3));
        const float e1 = __builtin_amdgcn_exp2f(lse - mm), e2 = __builtin_amdgcn_exp2f(l2 - mm), e3 = __builtin_amdgcn_exp2f(l3 - mm);
        const float inv = 1.0f / (e1 + e2 + e3);
        const float c1 = e1 * inv / l, c2 = e2 * inv, c3 = e3 * inv;
        bf16_t* yo = ycat + qrow * DM + t.h * HD + 8 * hi;
#pragma unroll
        for (int d = 0; d < 2; ++d)
#pragma unroll
            for (int g = 0; g < 4; g += 2) { u32x2 wp[2];
#pragma unroll
                for (int e = 0; e < 2; ++e) { const int gg = g + e; const u32x2 b2 = a2[4 * d + gg], b3 = a3[4 * d + gg];
                    wp[e].x = cvt_pk_bf16(c1 * o[d][4 * gg] + c2 * bf_lo(b2.x) + c3 * bf_lo(b3.x), c1 * o[d][4 * gg + 1] + c2 * bf_hi(b2.x) + c3 * bf_hi(b3.x));
                    wp[e].y = cvt_pk_bf16(c1 * o[d][4 * gg + 2] + c2 * bf_lo(b2.y) + c3 * bf_lo(b3.y), c1 * o[d][4 * gg + 3] + c2 * bf_hi(b2.y) + c3 * bf_hi(b3.y)); }
                *(u32x4*)(yo + 32 * d + 8 * g) = pair16(wp[0], wp[1]); }
    }
}
template <bool FINAL>
__device__ __forceinline__ void attn_phase(LAS unsigned char* lds, const bf16_t* proj, bf16_t* o23, float* lse23, bf16_t* ycat, int tid, int lane, int wid) {
    constexpr int NR = FINAL ? 1024 : 2048, RB = FINAL ? 32 : 64;
    const int G = gridDim.x, J = G >> 3, xcd = blockIdx.x & 7, jj = blockIdx.x >> 3;
    const bool affine = (G & 7) == 0 && J > 0 && (RB % J) == 0;
    const int SPB = affine ? RB / J : 1, NS = affine ? 4 * SPB : (NR - (int)blockIdx.x + G - 1) / G;
    auto round_of = [&](int t) -> int {
        if (!affine) return (int)blockIdx.x + t * G;
        const int sidx = t / SPB, rr = jj + J * (t % SPB), bh = 4 * xcd + sidx;
        return FINAL ? bh * 32 + rr : (rr >> 5) * 1024 + bh * 32 + (rr & 31); };
    if (NS <= 0) return;
    int t = 0;
    u32x4 kv[6], vv[6]; bf16x8 qf[4];
    AttnItem cur = attn_decode<FINAL>(round_of(0), wid);
    attn_load(proj, cur, kv, vv, tid); attn_load_q(proj, cur, qf, lane, wid);
    for (;;) {
        attn_stage(lds, kv, vv, tid, wid);
        asm volatile("s_waitcnt lgkmcnt(0)\n\ts_barrier" ::: "memory");
        const bool more = t + 1 < NS;
        const AttnItem nxt = attn_decode<FINAL>(round_of(more ? t + 1 : t), wid);
        attn_load(proj, nxt, kv, vv, tid);
        attn_compute<FINAL>(lds, proj, cur, nxt, more, qf, o23, lse23, ycat, lane, wid);
        asm volatile("s_waitcnt lgkmcnt(0)\n\ts_barrier" ::: "memory");
        if (!more) break;
        cur = nxt; ++t;
    }
}
__device__ __forceinline__ void conv_phase(const bf16_t* proj, bf16_t* ycat, const float* cw, const float* cb, int tid) {
    const int c0 = (tid & 63) * 8;
    float w0[8], w1[8], w2[8], bb[8];
#pragma unroll
    for (int e = 0; e < 8; ++e) { w0[e] = cw[c0 + e]; w1[e] = cw[AW + c0 + e]; w2[e] = cw[2 * AW + c0 + e]; bb[e] = cb[c0 + e]; }
    for (int chunk = (blockIdx.x * NTHR + tid) >> 6; chunk < M / 16; chunk += (gridDim.x * NTHR) >> 6) {
        const int row0 = chunk * 16, t0 = row0 & (SEQ - 1);
        float p1[8], p2[8];
#pragma unroll
        for (int e = 0; e < 8; ++e) { p1[e] = 0.f; p2[e] = 0.f; }
        if (t0 >= 2) {
            const bf16_t* p = proj + (size_t)(row0 - 2) * 1024 + 512 + c0;
            const u32x4 pa = *(const u32x4*)p, pb = *(const u32x4*)(p + 1024);
#pragma unroll
            for (int e = 0; e < 4; ++e) { p2[2 * e] = bf_lo(pa[e]); p2[2 * e + 1] = bf_hi(pa[e]); p1[2 * e] = bf_lo(pb[e]); p1[2 * e + 1] = bf_hi(pb[e]); }
        }
#pragma unroll 4
        for (int rr = 0; rr < 16; ++rr) {
            const bf16_t* p = proj + (size_t)(row0 + rr) * 1024 + c0;
            const u32x4 gb = *(const u32x4*)p, pc = *(const u32x4*)(p + 512);
            float p0[8], y[8];
#pragma unroll
            for (int e = 0; e < 4; ++e) { p0[2 * e] = bf_lo(pc[e]); p0[2 * e + 1] = bf_hi(pc[e]); }
#pragma unroll
            for (int e = 0; e < 8; ++e) y[e] = w2[e] * p0[e] + w1[e] * p1[e] + w0[e] * p2[e] + bb[e];
            u32x4 o;
#pragma unroll
            for (int e = 0; e < 4; ++e) o[e] = cvt_pk_bf16(bf_lo(gb[e]) * y[2 * e], bf_hi(gb[e]) * y[2 * e + 1]);
            *(u32x4*)(ycat + (size_t)(row0 + rr) * DM + AW + c0) = o;
#pragma unroll
            for (int e = 0; e < 8; ++e) { p2[e] = p1[e]; p1[e] = p0[e]; }
        }
    }
}

#define XB_TMO      128
#define XB_XCNT(j)  (256  + 64 * (j))
#define XB_XSUB(j)  (1280 + 64 * (j))
#define XB_XGEN(j)  (2304 + 64 * (j))
#define XB_TOP      3328
#define XB_TOPGEN   3392
#define XCD_BAR_WORDS 3456
#define XB_SPIN_CAP (1u << 18)

__device__ __forceinline__ unsigned xb_ld(unsigned* p)              { return __hip_atomic_load(p, __ATOMIC_RELAXED, __HIP_MEMORY_SCOPE_AGENT); }
__device__ __forceinline__ unsigned xb_add(unsigned* p, unsigned v) { return __hip_atomic_fetch_add(p, v, __ATOMIC_RELAXED, __HIP_MEMORY_SCOPE_AGENT); }
__device__ __forceinline__ unsigned xb_xcc_id() { return (unsigned)__builtin_amdgcn_s_getreg((3 << 11) | 20) & 0xFu; }
#define XB_SPIN(cond, bar) do { unsigned _sp = 0; while (cond) { __builtin_amdgcn_s_sleep(1); \
    if ((++_sp & 255u) == 0u) { if (xb_ld(&(bar)[XB_TMO])) break; if (_sp > XB_SPIN_CAP) { atomicAdd(&(bar)[XB_TMO], 1u); break; } } } } while (0)

struct XcdBarrier {
    unsigned* bar; unsigned x;
    volatile LAS unsigned* st;
};

__device__ __forceinline__ XcdBarrier xcd_barrier_post(unsigned* bar, volatile LAS unsigned* st) {
    XcdBarrier b; b.bar = bar; b.x = xb_xcc_id(); b.st = st;
    if (threadIdx.x == 0) (void)xb_add(&bar[XB_XCNT(b.x)], 1u);
    return b;
}
__device__ __forceinline__ void xcd_barrier_complete(unsigned* bar, unsigned x, unsigned& nloc, unsigned& nx) {
    const unsigned G = gridDim.x * gridDim.y * gridDim.z;
    unsigned sum, cnt, mine, sp = 0u;
    for (;;) {
        sum = 0u; cnt = 0u; mine = 0u;
#pragma unroll
        for (unsigned j = 0; j < 16; ++j) { const unsigned c = xb_ld(&bar[XB_XCNT(j)]); sum += c; cnt += (c > 0u) ? 1u : 0u; mine = (j == x) ? c : mine; }
        if (sum == G) break;
        __builtin_amdgcn_s_sleep(1);
        if ((++sp & 255u) == 0u) { if (xb_ld(&bar[XB_TMO])) break; if (sp > XB_SPIN_CAP) { atomicAdd(&bar[XB_TMO], 1u); break; } }
    }
    nloc = mine > 0u ? mine : 1u; nx = cnt > 0u ? cnt : 1u;
}

__device__ __forceinline__ void xcd_barrier(const XcdBarrier& b) {
    asm volatile("s_waitcnt vmcnt(0)" ::: "memory");
    __syncthreads();
    if (threadIdx.x == 0) {
        unsigned* bar = b.bar;
        __builtin_amdgcn_s_waitcnt(0);
        unsigned nloc = b.st[0], nx = b.st[1];
        if (nloc == 0u) { xcd_barrier_complete(bar, b.x, nloc, nx); b.st[0] = nloc; b.st[1] = nx; }
        const unsigned old = xb_add(&bar[XB_XSUB(b.x)], 1u);
        const unsigned gen = old / nloc;
        if (old + 1u == (gen + 1u) * nloc) {
            __builtin_amdgcn_fence(__ATOMIC_RELEASE, "agent");
            asm volatile("s_waitcnt vmcnt(0)" ::: "memory");
            const unsigned og = xb_add(&bar[XB_TOP], 1u);
            const unsigned tg = og / nx;
            if (og + 1u == (tg + 1u) * nx) xb_add(&bar[XB_TOPGEN], 1u);
            else XB_SPIN(xb_ld(&bar[XB_TOPGEN]) == tg, bar);
            __builtin_amdgcn_fence(__ATOMIC_ACQUIRE, "agent");
            xb_add(&bar[XB_XGEN(b.x)], 1u);
            asm volatile("s_waitcnt vmcnt(0)" ::: "memory");
        } else {
            XB_SPIN(xb_ld(&bar[XB_XGEN(b.x)]) == gen, bar);
            __builtin_amdgcn_fence(__ATOMIC_ACQUIRE, "agent");
            asm volatile("s_waitcnt vmcnt(0)" ::: "memory");
        }
    }
    __syncthreads();
}

#ifndef MK_MULTI
#define MK_MULTI 0
#endif
constexpr int N_PHASES = 2 + 8 * DEPTH;
#ifndef PROBE_DUP_MASK
#define PROBE_DUP_MASK 0
#endif
struct Args { In in; float* out; unsigned char* ws; int ph_lo, ph_hi; };
static_assert(sizeof(Args) == 15 * 8 + 8, "Args has no padding");
template <class T> __device__ __forceinline__ T* uptr(T* p) {
    const unsigned long long v = (unsigned long long)p;
    const unsigned lo = __builtin_amdgcn_readfirstlane((unsigned)v), hi = __builtin_amdgcn_readfirstlane((unsigned)(v >> 32));
    return (T*)(((unsigned long long)hi << 32) | lo);
}

__global__ void __launch_bounds__(NTHR, 2) fwd_megakernel(Args a) {
    extern __shared__ __attribute__((aligned(16))) unsigned char lds_raw[];
    LAS unsigned char* lds = (LAS unsigned char*)lds_raw;
    cg::grid_group grid = cg::this_grid();
    const int wave0 = __builtin_amdgcn_readfirstlane(threadIdx.x >> 6);
    unsigned char* ws = a.ws;
    volatile LAS unsigned* MISC = (volatile LAS unsigned*)(lds + MISC_OFF);
    if (threadIdx.x < 16) MISC[threadIdx.x] = 0u;
    __syncthreads();
    XcdBarrier bar; bar.bar = (unsigned*)(ws + WS_CTL); bar.x = 0; bar.st = nullptr;
    if (a.ph_hi - a.ph_lo > 1 && a.ph_lo >= 0) bar = xcd_barrier_post((unsigned*)(ws + WS_CTL), MISC + 8);
    for (int ph_ = a.ph_lo < 0 ? 0 : a.ph_lo; ph_ < a.ph_hi; ++ph_) {
        int ph = ph_; asm volatile("" : "+s"(ph));
        int nrep = ph < 2 ? ((PROBE_DUP_MASK >> 8) & 1) + 1 : ((PROBE_DUP_MASK >> ((ph - 2) % 8)) & 1) + 1;
        if (ph == 3 && ((PROBE_DUP_MASK >> 9) & 1)) nrep = 2;
        asm volatile("" : "+s"(nrep));
        for (int rep = 0; rep < nrep; ++rep) {
        asm volatile("" : "+s"(ph));
        int wave = wave0; asm volatile("" : "+s"(wave));
        int lane = (int)__builtin_amdgcn_mbcnt_hi(~0u, __builtin_amdgcn_mbcnt_lo(~0u, 0u)); asm volatile("" : "+v"(lane));
        const int tid = wave * 64 + lane;
        size_t wz = 0; asm volatile("" : "+s"(wz));
        unsigned char* ws = a.ws + wz;
        float* mod = (float*)(ws + WS_MOD);
        unsigned char* ob = (unsigned char*)a.out + wz;
        bf16_t* YC = (bf16_t*)(ob + OUT_YC); bf16_t* ACT = (bf16_t*)(ws + WS_ACT);
        bf16_t* QKVb = (bf16_t*)(ws + WS_QKV); bf16_t* XB = (bf16_t*)(ws + WS_XB);
        bf16_t* O23 = (bf16_t*)(ob + OUT_O23); float* LSE = (float*)(ws + WS_LSE);
        float* SW = (float*)(ws + WS_SW); float* RSS = (float*)(ws + WS_RSS);
        if (ph == 0) { mod_phase(a.in, ws, lds, tid, lane, wave); weights_phase(a.in, ws, lds, tid, lane, wave, (float*)(ws + WS_SW), 0); }
        else if (ph == 1) { weights_phase(a.in, ws, lds, tid, lane, wave, (float*)(ws + WS_SW), 1); }
        else {
            const int q = ph - 2, L = q / 8, k = q % 8;
            unsigned char* lw = ws + WS_W + (size_t)L * LW_BYTES;
            const float* lmod = mod + (size_t)L * NB * MODW;
            if (k == 0 || k == 6) {
                const int f = k == 6, sub = 2 * f;
                pg8::Gemm g{XB, (const bf16_t*)(lw + LW_W1 + (size_t)f * NB * W1_BYTES), M, 2 * FF, DM, W1_BYTES}; pg8::StaticOrder S; S.init(M, 2 * FF, gridDim.x, blockIdx.x);
                pg8::EpiSwiglu E{ACT, FF, RSS + (size_t)(L * 3 + sub) * M, SW + (size_t)(L * 3 + sub) * NB * NSW};
                pg8::gemm_phase<pg8::EpiSwiglu, pg8::StaticOrder, true, true>(lds, tid, g, S, E);
            } else if (k == 1 || k == 7 || k == 5) {
                const int f = k == 7, sub = k == 1 ? 0 : (k == 5 ? 1 : 2);
                const bool last = (L == DEPTH - 1 && k == 7);
                const bf16_t* A = k == 5 ? YC : ACT; const bf16_t* Bt = k == 5 ? (const bf16_t*)(lw + LW_WOUT) : (const bf16_t*)(lw + LW_W2 + f * W2_BYTES);
                pg8::Gemm g{A, Bt, M, DM, k == 5 ? DM : FF, 0}; pg8::StaticOrder S; S.init(M, DM, gridDim.x, blockIdx.x);
                const int nn = L * 3 + sub + 1;
                const bool has = nn < DEPTH * 3; const int ni = has ? nn : 0;
                LAS pg8::EpiResid::P* pp = (LAS pg8::EpiResid::P*)(lds + MISC_OFF + 64);
                if (tid == 0) { pp->xinb = XB; pp->out = a.out; pp->outb = XB; pp->gate = lmod + sub * 3 * DM + 2 * DM; pp->rss = RSS + (size_t)ni * M;
                    pp->gs = k == 5 ? 1.0f : 0.5f; pp->flags = (has ? 1 : 0) | (last ? 4 : 0); }
                __syncthreads();
                pg8::EpiResid E{pp};
                pg8::gemm_phase<pg8::EpiResid, pg8::StaticOrder, true, true>(lds, tid, g, S, E);
            } else if (k == 2) {
                pg8::Gemm g{XB, (const bf16_t*)(lw + LW_WIN), M, INC, DM, WIN_BYTES}; pg8::StaticOrder S; S.init(M, INC, gridDim.x, blockIdx.x);
                pg8::EpiWin E{ACT, 1024, QKVb, a.in.q_g + L * HD, a.in.k_g + L * HD, QSCALE, RSS + (size_t)(L * 3 + 1) * M, SW + (size_t)(L * 3 + 1) * NB * NSW};
                pg8::gemm_phase<pg8::EpiWin, pg8::StaticOrder, true, true>(lds, tid, g, S, E);
            } else if (k == 3) {
                attn_phase<false>(lds, QKVb, O23, LSE, nullptr, tid, lane, wave);
            } else {
                attn_phase<true>(lds, QKVb, O23, LSE, YC, tid, lane, wave);
                conv_phase(ACT, YC, a.in.conv_w + (size_t)L * 3 * AW, a.in.conv_b + (size_t)L * AW, tid);
            }
        }
        __syncthreads(); }
        if (ph_ + 1 < a.ph_hi) { if (a.ph_lo < 0) grid.sync(); else xcd_barrier(bar); }
    }
}

extern "C" void kernel_launch(void* const* d_in, const int* in_sizes, int n_in, void* d_out, int out_size, void* d_ws, size_t ws_size, hipStream_t stream) {
    static int grid_blocks = 0;
    if (grid_blocks == 0) {
        if (n_in != 13 || in_sizes[0] != M * DM || out_size != M * DM || ws_size < WS_END) { fprintf(stderr, "kernel_launch: unexpected shapes (n_in %d, in0 %d, out %d, ws %zu)\n", n_in, n_in > 0 ? in_sizes[0] : -1, out_size, ws_size); grid_blocks = -1; return; }
        int dev = 0, cus = 0, per_cu = 0;
        hipGetDevice(&dev);
        hipDeviceGetAttribute(&cus, hipDeviceAttributeMultiprocessorCount, dev);
        if (hipFuncSetAttribute((const void*)fwd_megakernel, hipFuncAttributeMaxDynamicSharedMemorySize, LDS_BYTES) != hipSuccess) fprintf(stderr, "kernel_launch: hipFuncSetAttribute failed\n");
        if (hipOccupancyMaxActiveBlocksPerMultiprocessor(&per_cu, (const void*)fwd_megakernel, NTHR, LDS_BYTES) != hipSuccess || per_cu < 1) { fprintf(stderr, "kernel_launch: occupancy query says %d\n", per_cu); per_cu = 1; }
        (void)hipGetLastError();
        grid_blocks = cus * per_cu;
    }
    if (grid_blocks < 0) return;
    Args a{};
    const float** ip = (const float**)&a.in;
    for (int i = 0; i < 13; ++i) ip[i] = (const float*)d_in[i];
    a.out = (float*)d_out; a.ws = (unsigned char*)d_ws;
    if (hipMemsetAsync((char*)d_ws + WS_CTL, 0, ZERO_BYTES, stream) != hipSuccess) { fprintf(stderr, "kernel_launch: memset failed\n"); return; }
#if MK_MULTI
    for (int ph = 0; ph < N_PHASES; ++ph) { a.ph_lo = ph; a.ph_hi = ph + 1; hipLaunchKernelGGL(fwd_megakernel, dim3(grid_blocks), dim3(NTHR), LDS_BYTES, stream, a); }
#else
    a.ph_lo = 0; a.ph_hi = N_PHASES;
    void* args[] = {&a};
    hipError_t e = hipLaunchCooperativeKernel((const void*)fwd_megakernel, dim3(grid_blocks), dim3(NTHR), args, LDS_BYTES, stream);
    if (e != hipSuccess) fprintf(stderr, "cooperative launch failed: %s (grid %d)\n", hipGetErrorString(e), grid_blocks);
#endif
}
```

```cpp
#include <hip/hip_runtime.h>
#include <hip/hip_cooperative_groups.h>
#include <cstdio>
#include <cstdint>
namespace cg = cooperative_groups;
namespace pg8 {
#define PG8_LAS __attribute__((address_space(3)))
typedef unsigned short bf16_t;
typedef short bf16x8 __attribute__((ext_vector_type(8)));
typedef float f32x4 __attribute__((ext_vector_type(4)));
typedef unsigned u32x4 __attribute__((ext_vector_type(4)));
constexpr int BM = 256, BK = 64, HALF = 128, HTB = HALF * BK * 2  , STAGE_BYTES = 8 * HTB, NXCD = 8, WGM = 8;

__host__ __device__ __forceinline__ int lds_byte(int r, int c) { const int st = (r >> 4) * 2 + (c >> 5), rr = r & 15, cc = c & 31, ob = rr * 64 + cc * 2; return st * 1024 + (ob ^ (((ob >> 9) & 1) << 5)); }
__host__ __device__ __forceinline__ void stage_rc(int b, int& R, int& C) { const int st = b / 1024, sb = b % 1024, swz = sb ^ (((sb >> 9) & 1) << 5); R = (st >> 1) * 16 + swz / 64; C = (st & 1) * 32 + (swz % 64) / 2; }
__host__ __device__ __forceinline__ int perm32(int rho) { const int n = rho >> 4, i = rho & 15; return 8 * (i >> 2) + 4 * n + (i & 3); }

struct Unit { int pm, pn; };
struct Gemm { const bf16_t* A; const bf16_t* Bt; int M, N, K; size_t bstride; };

struct StaticOrder {
    int nM, nN, nwg, G, c;
    __host__ __device__ void init(int M, int N, int G_, int c_) { nM = M / BM; nN = N / BM; nwg = nM * nN; G = G_; c = c_; }
    __host__ __device__ bool next(int i, Unit& u) const {
        const long L = (long)i * G + c; if (L >= nwg) return false;
        int wgid = (int)L; { const int q = nwg / NXCD, r = nwg % NXCD, xcd = wgid % NXCD, off = wgid / NXCD; wgid = (xcd < r ? xcd * (q + 1) : r * (q + 1) + (xcd - r) * q) + off; }
        const int nig = WGM * nN, gid = wgid / nig, fm = gid * WGM, gsz = (nM - fm) < WGM ? (nM - fm) : WGM;
        u.pm = fm + ((wgid % nig) % gsz); u.pn = (wgid % nig) / gsz; return true;
    }
    __device__ __forceinline__ void a_ready(const Unit&) const {}
    __device__ __forceinline__ void done(const Unit&) const {}
};

typedef unsigned u32x2 __attribute__((ext_vector_type(2)));
__device__ __forceinline__ unsigned cvt_pk_bf16(float lo, float hi) { typedef float f2 __attribute__((ext_vector_type(2))); typedef __bf16 b2 __attribute__((ext_vector_type(2)));
    f2 v = {lo, hi}; b2 b = __builtin_convertvector(v, b2); return __builtin_bit_cast(unsigned, b); }
__device__ __forceinline__ float silu_f(float g) { return g * __builtin_amdgcn_rcpf(1.0f + __builtin_amdgcn_exp2f(-1.4426950408889634f * g)); }

struct EpiSwiglu {
    static constexpr bool PERM = true, AFTER_DRAIN = false;
    bf16_t* O; int ldc;
    const float* rss; const float* sw;
    __device__ __forceinline__ void operator()(const f32x4 (&acc)[2][2][4][2], const Unit& u, int wr, int wc, int fr, int fq) const {
        const int row0 = u.pm * BM + wr * 64 + fr, col0 = u.pn * HALF + wc * 32 + 8 * fq;
        const float* swp = sw + (size_t)((u.pm * BM) >> 13) * (2 * 2816) + u.pn * BM + wc * 32 + 8 * fq;
        f32x4 sv[2][2];
#pragma unroll
        for (int bj = 0; bj < 2; ++bj)
#pragma unroll
            for (int n = 0; n < 2; ++n) sv[bj][n] = *(const f32x4*)(swp + bj * HALF + 4 * n);
        float rsv[2][4];
#pragma unroll
        for (int ai = 0; ai < 2; ++ai)
#pragma unroll
            for (int m = 0; m < 4; ++m) rsv[ai][m] = rss[row0 + ai * HALF + m * 16];
#pragma unroll
        for (int ai = 0; ai < 2; ++ai)
#pragma unroll
            for (int m = 0; m < 4; ++m) {
                const float rs = __builtin_amdgcn_rsqf(rsv[ai][m] * (1.0f / 1024.0f) + 1e-6f);
                const f32x4 g0 = acc[ai][0][m][0] * rs + sv[0][0], g1 = acc[ai][0][m][1] * rs + sv[0][1], u0 = acc[ai][1][m][0] * rs + sv[1][0], u1 = acc[ai][1][m][1] * rs + sv[1][1];
                u32x4 w;
                w.x = cvt_pk_bf16(silu_f(g0[0]) * u0[0], silu_f(g0[1]) * u0[1]); w.y = cvt_pk_bf16(silu_f(g0[2]) * u0[2], silu_f(g0[3]) * u0[3]);
                w.z = cvt_pk_bf16(silu_f(g1[0]) * u1[0], silu_f(g1[1]) * u1[1]); w.w = cvt_pk_bf16(silu_f(g1[2]) * u1[2], silu_f(g1[3]) * u1[3]);
                __builtin_nontemporal_store(w, (u32x4*)(O + (size_t)(row0 + ai * HALF + m * 16) * ldc + col0));
            }
    }
};
struct EpiWin {
    static constexpr bool PERM = true, AFTER_DRAIN = false;
    bf16_t* O; int ldc; bf16_t* QKV; const float* qg; const float* kg; float qscale; const float* rss; const float* sw;
    __device__ __forceinline__ void operator()(const f32x4 (&acc)[2][2][4][2], const Unit& u, int wr, int wc, int fr, int fq) const {
        const int row0 = u.pm * BM + wr * 64 + fr, col0 = u.pn * BM + wc * 64 + 8 * fq;
        const int kind = u.pn < 2 ? 1 : (u.pn < 4 ? 2 : 0);
        f32x4 gv[2][2];
#pragma unroll
        for (int bj = 0; bj < 2; ++bj)
#pragma unroll
            for (int n = 0; n < 2; ++n) gv[bj][n] = kind ? *(const f32x4*)((kind == 1 ? qg : kg) + 32 * bj + 8 * fq + 4 * n) : (f32x4){1.f, 1.f, 1.f, 1.f};
        const float ks = kind == 1 ? qscale : 1.0f;
        const float* swp = sw + (size_t)((u.pm * BM) >> 13) * (2 * 2816) + u.pn * BM + wc * 32 + 8 * fq;
        f32x4 sv[2][2];
#pragma unroll
        for (int bj = 0; bj < 2; ++bj)
#pragma unroll
            for (int n = 0; n < 2; ++n) sv[bj][n] = *(const f32x4*)(swp + bj * HALF + 4 * n);
        float rsv[2][4];
#pragma unroll
        for (int ai = 0; ai < 2; ++ai)
#pragma unroll
            for (int m = 0; m < 4; ++m) rsv[ai][m] = rss[row0 + ai * HALF + m * 16];
#pragma unroll
        for (int ai = 0; ai < 2; ++ai)
#pragma unroll
            for (int m = 0; m < 4; ++m) {
                const float rn = __builtin_amdgcn_rsqf(rsv[ai][m] * (1.0f / 1024.0f) + 1e-6f);
                f32x4 hv[2][2];
#pragma unroll
                for (int bj = 0; bj < 2; ++bj)
#pragma unroll
                    for (int n = 0; n < 2; ++n) hv[bj][n] = acc[ai][bj][m][n] * rn + sv[bj][n];
                float rs = 1.0f;
                if (kind) {
                    float ss = 0.f;
#pragma unroll
                    for (int bj = 0; bj < 2; ++bj)
#pragma unroll
                        for (int n = 0; n < 2; ++n) { const f32x4 x = hv[bj][n]; ss += (x[0] * x[0] + x[1] * x[1]) + (x[2] * x[2] + x[3] * x[3]); }
                    ss += __shfl_xor(ss, 16); ss += __shfl_xor(ss, 32);
                    rs = ks * __builtin_amdgcn_rsqf(ss * (1.0f / 64.0f) + 1e-6f);
                }
                const int row = row0 + ai * HALF + m * 16;
                const int tk = row & 8191, tp = (tk & ~2047) | ((tk & 15) << 7) | ((tk & 2047) >> 4);
                if (u.pn >= 8) {
                    const f32x4 p0 = hv[0][0] * hv[1][0], p1 = hv[0][1] * hv[1][1];
                    u32x4 w; w.x = cvt_pk_bf16(p0[0], p0[1]); w.y = cvt_pk_bf16(p0[2], p0[3]); w.z = cvt_pk_bf16(p1[0], p1[1]); w.w = cvt_pk_bf16(p1[2], p1[3]);
                    *(u32x4*)(O + (size_t)row * ldc + 512 + 128 * (u.pn - 8) + 32 * wc + 8 * fq) = w;
                    continue;
                }
                const size_t hrow = (size_t)((row >> 13) * 8 + (u.pn & 1) * 4 + wc) * 8192 + tp;
                bf16_t* rowp = u.pn < 2 ? QKV + hrow * 64 + 8 * fq : u.pn < 6 ? QKV + (size_t)4 * 8 * 8192 * 64 + hrow * 128 + ((u.pn >> 1) - 1) * 64 + 8 * fq
                                        : O + (size_t)row * ldc + (col0 - 1536);
#pragma unroll
                for (int bj = 0; bj < 2; ++bj) {
                    const f32x4 v0 = hv[bj][0] * (gv[bj][0] * rs), v1 = hv[bj][1] * (gv[bj][1] * rs);
                    u32x4 w; w.x = cvt_pk_bf16(v0[0], v0[1]); w.y = cvt_pk_bf16(v0[2], v0[3]); w.z = cvt_pk_bf16(v1[0], v1[1]); w.w = cvt_pk_bf16(v1[2], v1[3]);
                    *(u32x4*)(rowp + 32 * bj) = w;
                }
            }
    }
};
struct EpiResid {
    static constexpr bool PERM = true, AFTER_DRAIN = false;
    struct P { const bf16_t* xinb; float* out; bf16_t* outb; const float* gate; float* rss; float gs; int flags; };
    const PG8_LAS P* pp;
    __device__ __forceinline__ void operator()(const f32x4 (&acc)[2][2][4][2], const Unit& u, int wr, int wc, int fr, int fq) const {
#define PG8_GAS __attribute__((address_space(1)))
        const PG8_GAS bf16_t* xinb = (const PG8_GAS bf16_t*)pp->xinb; PG8_GAS float* out = (PG8_GAS float*)pp->out; PG8_GAS bf16_t* outb = (PG8_GAS bf16_t*)pp->outb; const PG8_GAS float* gate = (const PG8_GAS float*)pp->gate;
        PG8_GAS float* rss = (PG8_GAS float*)pp->rss; const float gs = pp->gs; const int flags = pp->flags; const bool has = flags & 1, outf = flags & 4;
        const int b = (u.pm * BM) >> 13;
        const PG8_GAS float* gp = gate + (size_t)b * 9216;
        const int row0 = u.pm * BM + wr * 64 + fr, col0 = u.pn * BM + wc * 32 + 8 * fq;
        f32x4 gv[2][2];
#pragma unroll
        for (int bj = 0; bj < 2; ++bj)
#pragma unroll
            for (int n = 0; n < 2; ++n) gv[bj][n] = *(const PG8_GAS f32x4*)(gp + col0 + bj * HALF + n * 4) * gs;
#pragma unroll
        for (int ai = 0; ai < 2; ++ai) {
            u32x4 xa[2][4][2];
#pragma unroll
            for (int m = 0; m < 4; ++m)
#pragma unroll
                for (int bj = 0; bj < 2; ++bj) xa[ai][m][bj] = *(const PG8_GAS u32x4*)(xinb + (size_t)(row0 + ai * HALF + m * 16) * 1024 + col0 + bj * HALF);
#pragma unroll
            for (int m = 0; m < 4; ++m) { const int row = row0 + ai * HALF + m * 16; const size_t off = (size_t)row * 1024 + col0; float ss = 0.f;
#pragma unroll
                for (int bj = 0; bj < 2; ++bj) {
                    const u32x4 t = xa[ai][m][bj];
                    const f32x4 x0 = (f32x4){__uint_as_float(t.x << 16), __uint_as_float(t.x & 0xffff0000u), __uint_as_float(t.y << 16), __uint_as_float(t.y & 0xffff0000u)};
                    const f32x4 x1 = (f32x4){__uint_as_float(t.z << 16), __uint_as_float(t.z & 0xffff0000u), __uint_as_float(t.w << 16), __uint_as_float(t.w & 0xffff0000u)};
                    const f32x4 o0 = x0 + gv[bj][0] * acc[ai][bj][m][0], o1 = x1 + gv[bj][1] * acc[ai][bj][m][1];
                    if (outf) { *(PG8_GAS f32x4*)(out + off + bj * HALF) = o0; *(PG8_GAS f32x4*)(out + off + bj * HALF + 4) = o1; }
                    else { u32x4 w; w.x = cvt_pk_bf16(o0[0], o0[1]); w.y = cvt_pk_bf16(o0[2], o0[3]); w.z = cvt_pk_bf16(o1[0], o1[1]); w.w = cvt_pk_bf16(o1[2], o1[3]); *(PG8_GAS u32x4*)(outb + off + bj * HALF) = w; }
                    if (has) { ss += ((o0[0] * o0[0] + o0[1] * o0[1]) + (o0[2] * o0[2] + o0[3] * o0[3])) + ((o1[0] * o1[0] + o1[1] * o1[1]) + (o1[2] * o1[2] + o1[3] * o1[3])); } }
                if (has) { ss += __shfl_xor(ss, 16); ss += __shfl_xor(ss, 32);
                    if (fq == 0) __hip_atomic_fetch_add((float*)(rss + row), ss, __ATOMIC_RELAXED, __HIP_MEMORY_SCOPE_AGENT); } }
            asm volatile("" ::: "memory"); }
    }
};
template <class Epi, class Sched, bool ALIGN_EPI = false, bool SP2 = false>
__device__ __forceinline__ void gemm_phase(PG8_LAS unsigned char* lds, const int tid, const Gemm g, const Sched& S, const Epi& E) {
    const int wid = __builtin_amdgcn_readfirstlane(tid >> 6), lane = tid & 63, wr = wid >> 2, wc = wid & 3, fr = lane & 15, fq = lane >> 4;
    const int K = g.K, nt = K / BK;
    unsigned voffA[2], voffB[2];
#pragma unroll
    for (int i = 0; i < 2; ++i) { int R, C; stage_rc(tid * 16 + i * 8192, R, C); const int Rb = Epi::PERM ? ((R & ~31) + perm32(R & 31)) : R;
        voffA[i] = (unsigned)(R * K + C) * 2u; voffB[i] = (unsigned)(Rb * K + C) * 2u; }
    const size_t kstep = (size_t)(BK * 2);
    const size_t hstep = (size_t)HALF * K * 2;
    const size_t tstep = 2 * hstep;
    const unsigned ldsw = (unsigned)wid * 1024u;
    const int aoff = lds_byte(wr * 64 + fr, fq * 8), boff = lds_byte(wc * 32 + fr, fq * 8);
#define PG8_SA(b, h) (((b) * 2 + (h)) * HTB)
#define PG8_SB(b, h) ((4 + (b) * 2 + (h)) * HTB)
#define PG8_STAGE(bufoff, gbase, voff) do { _Pragma("unroll") for (int _i = 0; _i < 2; ++_i) \
        __builtin_amdgcn_global_load_lds((const unsigned*)((const char*)(gbase) + (voff)[_i]), (PG8_LAS unsigned*)(lds + (bufoff) + ldsw + _i * 8192), 16, 0, 0); } while (0)
#define PG8_LDA(dst, b, h) do { _Pragma("unroll") for (int m = 0; m < 4; ++m) _Pragma("unroll") for (int k = 0; k < 2; ++k) dst[m][k] = *(const PG8_LAS bf16x8*)(lds + PG8_SA(b, h) + aoff + m * 2048 + k * 1024); } while (0)
#define PG8_LDB(dst, b, h) do { _Pragma("unroll") for (int n = 0; n < 2; ++n) _Pragma("unroll") for (int k = 0; k < 2; ++k) dst[n][k] = *(const PG8_LAS bf16x8*)(lds + PG8_SB(b, h) + boff + n * 2048 + k * 1024); } while (0)
#define PG8_MMA(ai, bj, At, Bt) do { __builtin_amdgcn_s_setprio(1); _Pragma("unroll") for (int m = 0; m < 4; ++m) _Pragma("unroll") for (int n = 0; n < 2; ++n) _Pragma("unroll") for (int k = 0; k < 2; ++k) \
        acc[ai][bj][m][n] = __builtin_amdgcn_mfma_f32_16x16x32_bf16(Bt[n][k], At[m][k], acc[ai][bj][m][n], 0, 0, 0); __builtin_amdgcn_s_setprio(0); } while (0)
#define PG8_WAIT_V(n) asm volatile("s_waitcnt vmcnt(" #n ")" ::: "memory")
#define PG8_WAIT_L(n) asm volatile("s_waitcnt lgkmcnt(" #n ")" ::: "memory")
#define PG8_BAR __builtin_amdgcn_s_barrier()
#define PG8_SCHED __builtin_amdgcn_sched_barrier(0)
    Unit cur, nxt; int ui = 0;
    if (!S.next(0, cur)) return;
    f32x4 acc[2][2][4][2];
#pragma unroll
    for (int a = 0; a < 2; ++a)
#pragma unroll
        for (int b = 0; b < 2; ++b)
#pragma unroll
            for (int m = 0; m < 4; ++m)
#pragma unroll
                for (int n = 0; n < 2; ++n) acc[a][b][m][n] = (f32x4){0.f, 0.f, 0.f, 0.f};
    bf16x8 At[4][2], B0[2][2], B1[2][2];
    const char* cA = (const char*)g.A + (size_t)cur.pm * tstep; const char* cB = (const char*)g.Bt + (size_t)cur.pn * tstep + (size_t)(cur.pm >> 5) * g.bstride;
    S.a_ready(cur);
    if constexpr (SP2) {
        PG8_STAGE(PG8_SB(0, 0), cB, voffB); PG8_STAGE(PG8_SB(0, 1), cB + hstep, voffB); PG8_STAGE(PG8_SA(0, 0), cA, voffA); PG8_STAGE(PG8_SA(0, 1), cA + hstep, voffA);
        if (wr == 1) PG8_BAR;
        PG8_WAIT_V(2); PG8_BAR;
        PG8_STAGE(PG8_SB(1, 0), cB + kstep, voffB); PG8_STAGE(PG8_SA(1, 0), cA + kstep, voffA); PG8_STAGE(PG8_SB(1, 1), cB + hstep + kstep, voffB);
        PG8_WAIT_V(6); PG8_BAR;
    } else {
        PG8_STAGE(PG8_SB(0, 0), cB, voffB); PG8_STAGE(PG8_SA(0, 0), cA, voffA); PG8_STAGE(PG8_SB(0, 1), cB + hstep, voffB); PG8_STAGE(PG8_SA(0, 1), cA + hstep, voffA);
        if (wr == 1) PG8_BAR;
        PG8_WAIT_V(4); PG8_BAR;
        PG8_STAGE(PG8_SB(1, 0), cB + kstep, voffB); PG8_STAGE(PG8_SA(1, 0), cA + kstep, voffA); PG8_STAGE(PG8_SB(1, 1), cB + hstep + kstep, voffB);
        PG8_WAIT_V(6); PG8_BAR;
    }
    for (;;) {
        const bool has_next = S.next(ui + 1, nxt);
        const char* nA = has_next ? (const char*)g.A + (size_t)nxt.pm * tstep : cA; const char* nB = has_next ? (const char*)g.Bt + (size_t)nxt.pn * tstep + (size_t)(nxt.pm >> 5) * g.bstride : cB;
        for (int t = 0; t < nt; t += 2) {
            const bool last = (t == nt - 2);
            const char* a1 = cA + (size_t)(t + 1) * kstep;
            const char* a2 = last ? nA : cA + (size_t)(t + 2) * kstep; const char* b2 = last ? nB : cB + (size_t)(t + 2) * kstep;
            const char* a3 = a2 + kstep; const char* b3 = b2 + kstep;
            if (last && has_next) S.a_ready(nxt);
            if constexpr (SP2) {
            PG8_LDB(B0, 0, 0); PG8_LDB(B1, 0, 1); PG8_SCHED; PG8_LDA(At, 0, 0); PG8_STAGE(PG8_SA(1, 1), a1 + hstep, voffA);
            PG8_WAIT_V(8); PG8_WAIT_L(0); PG8_BAR; PG8_MMA(0, 0, At, B0); PG8_MMA(0, 1, At, B1); PG8_BAR; PG8_SCHED;
            PG8_LDA(At, 0, 1); PG8_STAGE(PG8_SB(0, 0), b2, voffB); PG8_STAGE(PG8_SB(0, 1), b2 + hstep, voffB); PG8_STAGE(PG8_SA(0, 0), a2, voffA);
            PG8_WAIT_V(8); PG8_WAIT_L(0); PG8_BAR; PG8_MMA(1, 0, At, B0); PG8_MMA(1, 1, At, B1); PG8_BAR; PG8_SCHED;
            PG8_LDB(B0, 1, 0); PG8_LDB(B1, 1, 1); PG8_SCHED; PG8_LDA(At, 1, 0); PG8_STAGE(PG8_SA(0, 1), a2 + hstep, voffA);
            PG8_WAIT_V(8); PG8_WAIT_L(0); PG8_BAR; PG8_MMA(0, 0, At, B0); PG8_MMA(0, 1, At, B1); PG8_BAR; PG8_SCHED;
            PG8_LDA(At, 1, 1); PG8_STAGE(PG8_SB(1, 0), b3, voffB); PG8_STAGE(PG8_SB(1, 1), b3 + hstep, voffB); PG8_STAGE(PG8_SA(1, 0), a3, voffA);
            PG8_WAIT_V(8); PG8_WAIT_L(0); PG8_BAR; PG8_MMA(1, 0, At, B0); PG8_MMA(1, 1, At, B1); PG8_BAR; PG8_SCHED;
            } else {
            PG8_LDB(B0, 0, 0); PG8_SCHED; PG8_LDA(At, 0, 0); PG8_STAGE(PG8_SA(1, 1), a1 + hstep, voffA);
            PG8_WAIT_L(8); PG8_BAR; PG8_WAIT_L(0); PG8_MMA(0, 0, At, B0); PG8_BAR; PG8_SCHED;
            PG8_LDB(B1, 0, 1); PG8_STAGE(PG8_SB(0, 0), b2, voffB);
            PG8_BAR; PG8_WAIT_L(0); PG8_MMA(0, 1, At, B1); PG8_BAR;
            PG8_LDA(At, 0, 1); PG8_STAGE(PG8_SA(0, 0), a2, voffA);
            PG8_BAR; PG8_WAIT_L(0); PG8_MMA(1, 0, At, B0); PG8_BAR; PG8_SCHED;
            PG8_STAGE(PG8_SB(0, 1), b2 + hstep, voffB);
            PG8_WAIT_V(6); PG8_BAR; PG8_MMA(1, 1, At, B1); PG8_BAR;
            PG8_LDB(B0, 1, 0); PG8_SCHED; PG8_LDA(At, 1, 0); PG8_STAGE(PG8_SA(0, 1), a2 + hstep, voffA);
            PG8_WAIT_L(8); PG8_BAR; PG8_WAIT_L(0); PG8_MMA(0, 0, At, B0); PG8_BAR; PG8_SCHED;
            PG8_LDB(B1, 1, 1); PG8_STAGE(PG8_SB(1, 0), b3, voffB);
            PG8_BAR; PG8_WAIT_L(0); PG8_MMA(0, 1, At, B1); PG8_BAR;
            PG8_LDA(At, 1, 1); PG8_STAGE(PG8_SA(1, 0), a3, voffA);
            PG8_BAR; PG8_WAIT_L(0); PG8_MMA(1, 0, At, B0); PG8_BAR; PG8_SCHED;
            PG8_STAGE(PG8_SB(1, 1), b3 + hstep, voffB);
            PG8_WAIT_V(6); PG8_BAR; PG8_MMA(1, 1, At, B1); PG8_BAR;
            }
        }
        if constexpr (ALIGN_EPI) { if (wr == 0) PG8_BAR; }
        if constexpr (!Epi::AFTER_DRAIN) { E(acc, cur, wr, wc, fr, fq); S.done(cur); }
        if (!has_next) break;
#pragma unroll
        for (int a = 0; a < 2; ++a)
#pragma unroll
            for (int b = 0; b < 2; ++b)
#pragma unroll
                for (int m = 0; m < 4; ++m)
#pragma unroll
                    for (int n = 0; n < 2; ++n) acc[a][b][m][n] = (f32x4){0.f, 0.f, 0.f, 0.f};
        cur = nxt; cA = nA; cB = nB; ++ui;
        if constexpr (ALIGN_EPI) { if (wr == 1) PG8_BAR; }
    }
    PG8_WAIT_V(0);
    if constexpr (!ALIGN_EPI) { if (wr == 0) PG8_BAR; }
    PG8_BAR;
    if constexpr (Epi::AFTER_DRAIN) { E.fused(acc, cur, wr, wc, fr, fq, lds, wid, lane); S.done(cur); }
#undef PG8_SA
#undef PG8_SB
#undef PG8_STAGE
#undef PG8_LDA
#undef PG8_LDB
#undef PG8_MMA
#undef PG8_WAIT_V
#undef PG8_WAIT_L
#undef PG8_BAR
#undef PG8_SCHED
}
}

#define LAS __attribute__((address_space(3)))
typedef unsigned short bf16_t;
typedef short bf16x8 __attribute__((ext_vector_type(8)));
typedef short s16x4 __attribute__((ext_vector_type(4)));
typedef float f32x4 __attribute__((ext_vector_type(4)));
typedef float f32x16 __attribute__((ext_vector_type(16)));
typedef unsigned u32x4 __attribute__((ext_vector_type(4)));
typedef unsigned u32x2 __attribute__((ext_vector_type(2)));
constexpr int DM = 1024, NB = 4, SEQ = 8192, DEPTH = 2, FF = 2816, NH = 8, HD = 64, AW = 512, INC = 3072, MODW = 9216;
constexpr int M = NB * SEQ;
constexpr float EPS = 1e-6f;
constexpr float QSCALE = 0.125f * 1.4426950408889634f;
constexpr float NEGBIG = -1e30f;
constexpr int NWAVES = 8, NTHR = 512;
constexpr size_t MiB = 1u << 20;
constexpr size_t WS_MOD = 0;
constexpr size_t WS_ST = MiB / 2;
constexpr size_t WS_GT = 3 * MiB / 4;
constexpr size_t WS_CTL = 1 * MiB, CTL_BYTES = 16384;
constexpr int NSW = 2 * FF;
constexpr size_t WS_SW = WS_CTL + CTL_BYTES, SW_BYTES = (size_t)DEPTH * 3 * NB * NSW * 4;
constexpr size_t WS_RSS = WS_SW + SW_BYTES, RSS_BYTES = (size_t)DEPTH * 3 * M * 4;
constexpr size_t ZERO_BYTES = CTL_BYTES + SW_BYTES + RSS_BYTES;
constexpr size_t WS_W = 5 * MiB / 2;
static_assert(WS_CTL + ZERO_BYTES <= WS_W, "zeroed region");
constexpr size_t W1_BYTES = (size_t)2 * FF * DM * 2, W2_BYTES = (size_t)DM * FF * 2, WIN_BYTES = (size_t)INC * DM * 2, WOUT_BYTES = (size_t)DM * DM * 2;
constexpr size_t LW_W1 = 0, LW_WIN = 2 * NB * W1_BYTES, LW_W2 = LW_WIN + NB * WIN_BYTES, LW_WOUT = LW_W2 + 2 * W2_BYTES, LW_BYTES = LW_WOUT + WOUT_BYTES;
static_assert(WS_W + DEPTH * LW_BYTES <= 253 * MiB, "weights");
constexpr size_t WS_ACT = 253 * MiB;
constexpr size_t WS_QKV = WS_ACT + 96 * MiB;
constexpr size_t WS_XB = 445 * MiB;
constexpr size_t WS_LSE = 509 * MiB;
constexpr size_t WS_END = 511 * MiB;
constexpr size_t OUT_O23 = 0, OUT_YC = 64 * MiB;
constexpr int RING_BYTES = 131072, WSCR_OFF = RING_BYTES, MISC_OFF = RING_BYTES + NWAVES * 512, LDS_BYTES = MISC_OFF + 256;

__device__ __forceinline__ float bf_lo(unsigned u) { return __uint_as_float(u << 16); }
__device__ __forceinline__ float bf_hi(unsigned u) { return __uint_as_float(u & 0xffff0000u); }
__device__ __forceinline__ float wave_sum(float v) {
#pragma unroll
    for (int o = 1; o < 64; o <<= 1) v += __shfl_xor(v, o);
    return v;
}
using pg8::cvt_pk_bf16;

struct In { const float *x, *c, *w_ada, *b_ada, *norm_g, *w_in, *q_g, *k_g, *conv_w, *conv_b, *w_out, *w1, *w2; };

__device__ __forceinline__ void mod_phase(const In& I, unsigned char* ws, LAS unsigned char* lds, int tid, int lane, int wave) {
    LAS float* sc = (LAS float*)(lds + 69632);
    LAS float* red = (LAS float*)(lds + 69632 + 16384);
    float* mod = (float*)(ws + WS_MOD); float* ST = (float*)(ws + WS_ST); float* GT = (float*)(ws + WS_GT);
    for (int i = tid; i < NB * DM; i += NTHR) { const float v = I.c[i]; sc[i] = v / (1.0f + __expf(-v)); }
    __syncthreads();
    typedef float f32x2 __attribute__((ext_vector_type(2)));
    for (int it = blockIdx.x; it < DEPTH * (MODW / 72); it += gridDim.x) {
        const int l = it / (MODW / 72), j0 = (it % (MODW / 72)) * 72;
        const int ln = lane < 36 ? lane : 35;
        const float* wp = I.w_ada + (size_t)l * DM * MODW + j0 + 2 * ln;
        f32x2 a0 = {0.f, 0.f}, a1 = a0, a2 = a0, a3 = a0; const int k0 = wave * 128;
#pragma unroll 16
        for (int k = k0; k < k0 + 128; ++k) { const f32x2 w = __builtin_nontemporal_load((const f32x2*)(wp + (size_t)k * MODW)); a0 += w * sc[k]; a1 += w * sc[DM + k]; a2 += w * sc[2 * DM + k]; a3 += w * sc[3 * DM + k]; }
        if (lane < 36) { LAS float* rp = red + wave * 4 * 72 + 2 * lane; rp[0] = a0.x; rp[1] = a0.y; rp[72] = a1.x; rp[73] = a1.y; rp[144] = a2.x; rp[145] = a2.y; rp[216] = a3.x; rp[217] = a3.y; }
        __syncthreads();
        if (tid < 288) { const int b = tid / 72, cl = tid % 72; float s = 0.f;
#pragma unroll
            for (int w = 0; w < 8; ++w) s += red[(w * 4 + b) * 72 + cl];
            const int j = j0 + cl; const float v = s + I.b_ada[(size_t)l * MODW + j];
            mod[(size_t)(l * NB + b) * MODW + j] = v;
            const int sub = j / 3072, jj = j % 3072; if (jj < DM) ST[((size_t)(l * 3 + sub) * DM + jj) * NB + b] = v;
            else if (jj < 2 * DM) GT[((size_t)(l * 3 + sub) * DM + jj - DM) * NB + b] = I.norm_g[(size_t)(l * 3 + sub) * DM + jj - DM] * (1.0f + v); }
        __syncthreads();
    }
}
__device__ __forceinline__ void transpose_item(const float* W, int K, int N, bf16_t* WT, int k0, int src_n0, int dst_n0, LAS float* scr, int lane, const float* st, float* sw, const float* gt, size_t cstride) {
    { f32x4 v[8]; const int c4 = lane & 7, kr = lane >> 3;
#pragma unroll
        for (int i = 0; i < 8; ++i) v[i] = __builtin_nontemporal_load((const f32x4*)(W + (size_t)(k0 + 8 * i + kr) * N + src_n0 + 4 * c4));
#pragma unroll
        for (int i = 0; i < 8; ++i) { LAS float* d = scr + (8 * i + kr) * 33 + 4 * c4; d[0] = v[i].x; d[1] = v[i].y; d[2] = v[i].z; d[3] = v[i].w; } }
    asm volatile("s_waitcnt lgkmcnt(0)" ::: "memory");
    const int c = lane & 7;
    if (!gt) {
#pragma unroll
        for (int j = 0; j < 4; ++j) { const int n = (lane >> 3) + 8 * j; const LAS float* s = scr + (8 * c) * 33 + n;
            u32x4 o; o.x = cvt_pk_bf16(s[0 * 33], s[1 * 33]); o.y = cvt_pk_bf16(s[2 * 33], s[3 * 33]); o.z = cvt_pk_bf16(s[4 * 33], s[5 * 33]); o.w = cvt_pk_bf16(s[6 * 33], s[7 * 33]);
            __builtin_nontemporal_store(o, (u32x4*)(WT + (size_t)(dst_n0 + n) * K + k0 + 8 * c)); }
    } else {
        f32x4 gk[8];
#pragma unroll
        for (int i = 0; i < 8; ++i) gk[i] = *(const f32x4*)(gt + (size_t)(k0 + 8 * c + i) * NB);
#pragma unroll
        for (int j = 0; j < 4; ++j) { const int n = (lane >> 3) + 8 * j; const LAS float* s = scr + (8 * c) * 33 + n;
            float w[8];
#pragma unroll
            for (int i = 0; i < 8; ++i) w[i] = s[i * 33];
#pragma unroll
            for (int b = 0; b < NB; ++b) {
                u32x4 o; o.x = cvt_pk_bf16(w[0] * gk[0][b], w[1] * gk[1][b]); o.y = cvt_pk_bf16(w[2] * gk[2][b], w[3] * gk[3][b]); o.z = cvt_pk_bf16(w[4] * gk[4][b], w[5] * gk[5][b]); o.w = cvt_pk_bf16(w[6] * gk[6][b], w[7] * gk[7][b]);
                __builtin_nontemporal_store(o, (u32x4*)(WT + (size_t)b * cstride + (size_t)(dst_n0 + n) * K + k0 + 8 * c)); } }
    }
    if (st) { const int n = lane & 31, hf = lane >> 5; f32x4 a4 = {0.f, 0.f, 0.f, 0.f};
#pragma unroll 8
        for (int i = 0; i < 32; ++i) { const int kk = hf * 32 + i; a4 += *(const f32x4*)(st + (size_t)(k0 + kk) * NB) * scr[kk * 33 + n]; }
#pragma unroll
        for (int b = 0; b < 4; ++b) a4[b] += __shfl_xor(a4[b], 32);
        if (hf == 0) {
#pragma unroll
            for (int b = 0; b < 4; ++b) __hip_atomic_fetch_add(sw + (size_t)b * NSW + dst_n0 + n, a4[b], __ATOMIC_RELAXED, __HIP_MEMORY_SCOPE_AGENT); } }
    asm volatile("s_waitcnt lgkmcnt(0)" ::: "memory");
}
__device__ __forceinline__ void weights_phase(const In& I, unsigned char* ws, LAS unsigned char* lds, int tid, int lane, int wave, float* SW, int which) {
    LAS float* scr = (LAS float*)(lds + wave * 8448);
    const int gw = blockIdx.x * NWAVES + wave, NGW = gridDim.x * NWAVES;
    const float* ST = (const float*)(ws + WS_ST); const float* GT = (const float*)(ws + WS_GT);
    constexpr int I_W1 = (DM / 64) * (2 * FF / 32), I_W2 = (FF / 64) * (DM / 32), I_WIN = (DM / 64) * (INC / 32), I_WOUT = (DM / 64) * (DM / 32);
    constexpr int I_LAYER = 2 * I_W1 + 2 * I_W2 + I_WIN + I_WOUT;
    for (int it = gw; it < DEPTH * I_LAYER; it += NGW) {
        const int l = it / I_LAYER; int r = it % I_LAYER;
        { const bool gain_item = r < 2 * I_W1 || (r >= 2 * I_W1 + 2 * I_W2 && r < 2 * I_W1 + 2 * I_W2 + I_WIN); if ((gain_item ? 1 : 0) != which) continue; }
        unsigned char* lw = ws + WS_W + (size_t)l * LW_BYTES;
        if (r < 2 * I_W1) { const int f = r / I_W1; r %= I_W1; const int nblk = 2 * FF / 32, kb = r / nblk, nb = r % nblk, n0 = nb * 32;
            const int pn = n0 >> 8, bj = (n0 >> 7) & 1, i = n0 & 127, sub = 2 * f;
            transpose_item(I.w1 + (size_t)(l * 2 + f) * DM * 2 * FF, DM, 2 * FF, (bf16_t*)(lw + LW_W1 + (size_t)f * NB * W1_BYTES), kb * 64, bj * FF + 128 * pn + i, n0, scr, lane,
                           ST + (size_t)(l * 3 + sub) * DM * NB, SW + (size_t)(l * 3 + sub) * NB * NSW, GT + (size_t)(l * 3 + sub) * DM * NB, W1_BYTES / 2); continue; }
        r -= 2 * I_W1;
        if (r < 2 * I_W2) { const int f = r / I_W2; r %= I_W2; const int nblk = DM / 32, kb = r / nblk, nb = r % nblk;
            transpose_item(I.w2 + (size_t)(l * 2 + f) * FF * DM, FF, DM, (bf16_t*)(lw + LW_W2 + f * W2_BYTES), kb * 64, nb * 32, nb * 32, scr, lane, nullptr, nullptr, nullptr, 0); continue; }
        r -= 2 * I_W2;
        if (r < I_WIN) { const int nblk = INC / 32, kb = r / nblk, nb = r % nblk, n0 = nb * 32; const int pn = n0 >> 8, bj = (n0 >> 7) & 1, wc = (n0 >> 5) & 3;
            const int srcn = pn < 8 ? 256 * pn + 64 * wc + 32 * bj : (bj ? 2560 : 2048) + 128 * (pn - 8) + 32 * wc;
            transpose_item(I.w_in + (size_t)l * DM * INC, DM, INC, (bf16_t*)(lw + LW_WIN), kb * 64, srcn, n0, scr, lane,
                           ST + (size_t)(l * 3 + 1) * DM * NB, SW + (size_t)(l * 3 + 1) * NB * NSW, GT + (size_t)(l * 3 + 1) * DM * NB, WIN_BYTES / 2); continue; }
        r -= I_WIN;
        { const int nblk = DM / 32, kb = r / nblk, nb = r % nblk;
            transpose_item(I.w_out + (size_t)l * DM * DM, DM, DM, (bf16_t*)(lw + LW_WOUT), kb * 64, nb * 32, nb * 32, scr, lane, nullptr, nullptr, nullptr, 0); }
    }
    if (which == 0) return;
    bf16_t* XB = (bf16_t*)(ws + WS_XB); float* RSS = (float*)(ws + WS_RSS);
    for (int chunk = gw; chunk < M / 16; chunk += NGW) {
        const int row0 = chunk * 16;
        for (int r4 = 0; r4 < 16; r4 += 4) {
            f32x4 v[4][4];
#pragma unroll
            for (int q = 0; q < 4; ++q) { const f32x4* xr = (const f32x4*)(I.x + (size_t)(row0 + r4 + q) * DM) + lane;
#pragma unroll
                for (int j = 0; j < 4; ++j) v[q][j] = __builtin_nontemporal_load(xr + 64 * j); }
#pragma unroll
            for (int q = 0; q < 4; ++q) { float ssq = 0.f;
#pragma unroll
                for (int j = 0; j < 4; ++j) ssq += (v[q][j].x * v[q][j].x + v[q][j].y * v[q][j].y) + (v[q][j].z * v[q][j].z + v[q][j].w * v[q][j].w);
                ssq = wave_sum(ssq);
                if (lane == 0) RSS[row0 + r4 + q] = ssq;
                u32x2* x8 = (u32x2*)(XB + (size_t)(row0 + r4 + q) * DM) + lane;
#pragma unroll
                for (int j = 0; j < 4; ++j) { u32x2 xw; xw.x = cvt_pk_bf16(v[q][j].x, v[q][j].y); xw.y = cvt_pk_bf16(v[q][j].z, v[q][j].w); x8[64 * j] = xw; } }
        }
    }
}

__device__ __forceinline__ int crow(int i, int hi) { return (i & 3) + 8 * (i >> 2) + 4 * hi; }
__device__ __forceinline__ u32x4 pair16(u32x2 wa, u32x2 wb) {
    const auto r0 = __builtin_amdgcn_permlane32_swap(wa.x, wb.x, false, false);
    const auto r1 = __builtin_amdgcn_permlane32_swap(wa.y, wb.y, false, false);
    return (u32x4){r0[0], r1[0], r0[1], r1[1]};
}
__device__ __forceinline__ int tpos(int t) { return (t & ~2047) | ((t & 15) << 7) | ((t & 2047) >> 4); }
typedef short v4i16_t __attribute__((ext_vector_type(4)));
__device__ __forceinline__ s16x4 vtr(LAS const unsigned char* p) { return __builtin_bit_cast(s16x4, __builtin_amdgcn_ds_read_tr16_b64_v4i16((LAS v4i16_t*)p)); }

struct AttnItem { int dil, b, h, r, nb, br; };
template <bool FINAL> __device__ __forceinline__ AttnItem attn_decode(int R, int wid) {
    AttnItem t; const int it = 2 * R + (wid >> 2);
    if (!FINAL) { const int br = it >> 11, rem = it & 2047, bh = rem >> 6, rn = rem & 63; t.br = br; t.dil = br ? 16 : 4; const int nbc = 64 / t.dil; t.r = rn / nbc; t.nb = rn % nbc; t.b = bh >> 3; t.h = bh & 7; }
    else { const int bh = it >> 6; t.br = 0; t.dil = 1; t.r = 0; t.nb = it & 63; t.b = bh >> 3; t.h = bh & 7; }
    return t;
}
__device__ __forceinline__ void attn_load(const bf16_t* proj, const AttnItem& t, u32x4 (&kv)[6], u32x4 (&vv)[6], int tid) {
    const int nb0 = t.nb & ~1;
    const bf16_t* kb = proj + (size_t)NB * NH * SEQ * HD + (size_t)(t.b * NH + t.h) * SEQ * 2 * HD;
#pragma unroll
    for (int c = 0; c < 6; ++c) { const int idx = tid + 512 * c, j = idx >> 3, ch = idx & 7; const int sidx = (nb0 - 1) * 128 + j;
        const int sj = sidx >= 0 ? sidx : sidx + 128;
        const bf16_t* p = kb + (size_t)tpos(sj * t.dil + t.r) * 2 * HD + ch * 8; kv[c] = *(const u32x4*)p; vv[c] = *(const u32x4*)(p + HD); }
}
__device__ __forceinline__ void attn_load_q(const bf16_t* proj, const AttnItem& t, bf16x8 (&qf)[4], int lane, int wid) {
    const int w = wid & 3, r32 = lane & 31, hi = lane >> 5;
    const size_t qrow = (size_t)(t.b * NH + t.h) * SEQ + tpos((t.nb * 128 + 32 * w + r32) * t.dil + t.r);
#pragma unroll
    for (int ks = 0; ks < 4; ++ks) qf[ks] = *(const bf16x8*)(proj + qrow * HD + 16 * ks + 8 * hi);
}
__device__ __forceinline__ void attn_stage(LAS unsigned char* lds, const u32x4 (&kv)[6], const u32x4 (&vv)[6], int tid, int wid) {
    LAS unsigned char* Kl = lds; LAS unsigned char* Vl = lds + 49152;
#pragma unroll
    for (int c = 0; c < 6; ++c) { const int idx = tid + 512 * c, j = idx >> 3, ch = idx & 7;
        *(LAS u32x4*)(Kl + j * 128 + ((ch ^ ((j >> 1) & 7)) * 16)) = kv[c];
        *(LAS u32x4*)(Vl + j * 128 + (((ch >> 2) ^ ((j >> 1) & 1)) * 64) + (ch & 3) * 16) = vv[c]; }
}
template <int T0, int NT, bool FIRST>
__device__ __forceinline__ void attn_group(LAS const unsigned char* Kl, LAS const unsigned char* Vl, const bf16x8 (&qf)[4], f32x16 (&o)[2], float& mx, float& l, int nb, int w, int lane) {
    const int r32 = lane & 31, hi = lane >> 5;
    f32x16 s[NT];
#pragma unroll
    for (int t = 0; t < NT; ++t) { const float z = (T0 + t < 4 && nb == 0 && w + T0 + t < 4) ? NEGBIG : 0.f;
        s[t] = (f32x16){z, z, z, z, z, z, z, z, z, z, z, z, z, z, z, z}; }
    {
        LAS const unsigned char* kp = Kl + (32 * (w + T0) + r32) * 128;
        const int sw = (r32 >> 1) & 7;
#pragma unroll
        for (int ks = 0; ks < 4; ++ks) {
            bf16x8 kf[NT];
#pragma unroll
            for (int t = 0; t < NT; ++t) kf[t] = *(LAS const bf16x8*)(kp + t * 4096 + (((2 * ks + hi) ^ sw) * 16));
#pragma unroll
            for (int t = 0; t < NT; ++t) s[t] = __builtin_amdgcn_mfma_f32_32x32x16_bf16(kf[t], qf[ks], s[t], 0, 0, 0);
        }
    }
#pragma unroll
    for (int t = 0; t < NT; ++t) {
        const int tt = T0 + t;
        if (tt == 0) {
#pragma unroll
            for (int i = 0; i < 16; ++i) if (crow(i, hi) < r32) s[t][i] = NEGBIG; }
        if (tt == 4) {
#pragma unroll
            for (int i = 0; i < 16; ++i) if (crow(i, hi) > r32) s[t][i] = NEGBIG; }
    }
    float m0 = s[0][0], m1 = s[0][1], m2 = s[0][2], m3 = s[0][3];
#pragma unroll
    for (int t = 0; t < NT; ++t)
#pragma unroll
        for (int i = 0; i < 16; i += 4) { m0 = fmaxf(m0, s[t][i]); m1 = fmaxf(m1, s[t][i + 1]); m2 = fmaxf(m2, s[t][i + 2]); m3 = fmaxf(m3, s[t][i + 3]); }
    float gm = fmaxf(fmaxf(m0, m1), fmaxf(m2, m3));
    gm = fmaxf(gm, __shfl_xor(gm, 32));
    if (FIRST) mx = gm;
    else { const float mn = fmaxf(mx, gm); const float f = __builtin_amdgcn_exp2f(mx - mn); l *= f; mx = mn;
#pragma unroll
        for (int d = 0; d < 2; ++d)
#pragma unroll
            for (int i = 0; i < 16; ++i) o[d][i] *= f; }
    float l0 = 0.f, l1 = 0.f, l2 = 0.f, l3 = 0.f;
#pragma unroll
    for (int t = 0; t < NT; ++t)
#pragma unroll
        for (int i = 0; i < 16; i += 4) {
            const float p0 = __builtin_amdgcn_exp2f(s[t][i] - mx), p1 = __builtin_amdgcn_exp2f(s[t][i + 1] - mx), p2 = __builtin_amdgcn_exp2f(s[t][i + 2] - mx), p3 = __builtin_amdgcn_exp2f(s[t][i + 3] - mx);
            s[t][i] = p0; s[t][i + 1] = p1; s[t][i + 2] = p2; s[t][i + 3] = p3; l0 += p0; l1 += p1; l2 += p2; l3 += p3; }
    l += (l0 + l1) + (l2 + l3);
    const int i16 = lane & 15, q4 = i16 >> 2, p4 = i16 & 3, blk = (lane >> 4) & 1;
    LAS const unsigned char* vb = Vl + (32 * (w + T0) + 4 * hi + q4) * 128 + 32 * blk + 8 * p4;
    const int vsw = ((q4 >> 1) & 1) * 64;
#pragma unroll
    for (int t = 0; t < NT; ++t)
#pragma unroll
        for (int s2 = 0; s2 < 2; ++s2) {
            u32x4 pw; pw.x = cvt_pk_bf16(s[t][8 * s2 + 0], s[t][8 * s2 + 1]); pw.y = cvt_pk_bf16(s[t][8 * s2 + 2], s[t][8 * s2 + 3]);
            pw.z = cvt_pk_bf16(s[t][8 * s2 + 4], s[t][8 * s2 + 5]); pw.w = cvt_pk_bf16(s[t][8 * s2 + 6], s[t][8 * s2 + 7]);
            const bf16x8 pf = __builtin_bit_cast(bf16x8, pw);
#pragma unroll
            for (int d = 0; d < 2; ++d) {
                LAS const unsigned char* vp = vb + (t * 32 + s2 * 16) * 128 + ((d * 64) ^ vsw);
                const s16x4 lo = vtr(vp), hi4 = vtr(vp + 8 * 128);
                const bf16x8 vf = (bf16x8){lo[0], lo[1], lo[2], lo[3], hi4[0], hi4[1], hi4[2], hi4[3]};
                o[d] = __builtin_amdgcn_mfma_f32_32x32x16_bf16(vf, pf, o[d], 0, 0, 0);
            }
        }
}
template <bool FINAL>
__device__ __forceinline__ void attn_compute(LAS unsigned char* lds, const bf16_t* proj, const AttnItem& t, const AttnItem& nxt, bool more, bf16x8 (&qf)[4], bf16_t* o23, float* lse23, bf16_t* ycat, int lane, int wid) {
    const int w = wid & 3, r32 = lane & 31, hi = lane >> 5;
    LAS unsigned char* Kl = lds + (wid >> 2) * 16384; LAS unsigned char* Vl = Kl + 49152;
    const int nb = t.nb;
    const int tok = (nb * 128 + 32 * w + r32) * t.dil + t.r;
    const size_t qrow = (size_t)t.b * SEQ + tok, hrow = (size_t)(t.b * NH + t.h) * SEQ + tpos(tok);
    float l2 = 0.f, l3 = 0.f; u32x2 a2[8], a3[8];
    if (FINAL) { l2 = lse23[hrow]; l3 = lse23[(size_t)M * NH + hrow];
        const bf16_t* o2 = o23 + hrow * HD + 4 * hi; const bf16_t* o3 = o2 + (size_t)M * AW;
#pragma unroll
        for (int i = 0; i < 8; ++i) { a2[i] = *(const u32x2*)(o2 + 32 * (i >> 2) + 8 * (i & 3)); a3[i] = *(const u32x2*)(o3 + 32 * (i >> 2) + 8 * (i & 3)); } }
    f32x16 o[2];
#pragma unroll
    for (int d = 0; d < 2; ++d) o[d] = (f32x16){0.f, 0.f, 0.f, 0.f, 0.f, 0.f, 0.f, 0.f, 0.f, 0.f, 0.f, 0.f, 0.f, 0.f, 0.f, 0.f};
    float mx = NEGBIG, l = 0.f;
    attn_group<2, 3, true>(Kl, Vl, qf, o, mx, l, nb, w, lane);
    attn_group<0, 2, false>(Kl, Vl, qf, o, mx, l, nb, w, lane);
    l += __shfl_xor(l, 32);
    attn_load_q(proj, nxt, qf, lane, wid);
    const float lse = mx + __builtin_amdgcn_logf(l);
    if (!FINAL) {
        const float c1 = 1.0f / l;
        if (hi == 0) lse23[(size_t)t.br * M * NH + hrow] = lse;
        bf16_t* ob = o23 + ((size_t)t.br * M * NH + hrow) * HD + 8 * hi;
#pragma unroll
        for (int d = 0; d < 2; ++d)
#pragma unroll
            for (int g = 0; g < 4; g += 2) { u32x2 wa, wb;
                wa.x = cvt_pk_bf16(o[d][4 * g] * c1, o[d][4 * g + 1] * c1); wa.y = cvt_pk_bf16(o[d][4 * g + 2] * c1, o[d][4 * g + 3] * c1);
                wb.x = cvt_pk_bf16(o[d][4 * g + 4] * c1, o[d][4 * g + 5] * c1); wb.y = cvt_pk_bf16(o[d][4 * g + 6] * c1, o[d][4 * g + 7] * c1);
                *(u32x4*)(ob + 32 * d + 8 * g) = pair16(wa, wb); }
    } else {
        const float mm = fmaxf(lse, fmaxf(l2, l3));
        const float e1 = __builtin_amdgcn_exp2f(lse - mm), e2 = __builtin_amdgcn_exp2f(l2 - mm), e3 = __builtin_amdgcn_exp2f(l3 - mm);
        const float inv = 1.0f / (e1 + e2 + e3);
        const float c1 = e1 * inv / l, c2 = e2 * inv, c3 = e3 * inv;
        bf16_t* yo = ycat + qrow * DM + t.h * HD + 8 * hi;
#pragma unroll
        for (int d = 0; d < 2; ++d)
#pragma unroll
            for (int g = 0; g < 4; g += 2) { u32x2 wp[2];
#pragma unroll
                for (int e = 0; e < 2; ++e) { const int gg = g + e; const u32x2 b2 = a2[4 * d + gg], b3 = a3[4 * d + gg];
                    wp[e].x = cvt_pk_bf16(c1 * o[d][4 * gg] + c2 * bf_lo(b2.x) + c3 * bf_lo(b3.x), c1 * o[d][4 * gg + 1] + c2 * bf_hi(b2.x) + c3 * bf_hi(b3.x));
                    wp[e].y = cvt_pk_bf16(c1 * o[d][4 * gg + 2] + c2 * bf_lo(b2.y) + c3 * bf_lo(b3.y), c1 * o[d][4 * gg + 3] + c2 * bf_hi(b2.y) + c3 * bf_hi(b3.y)); }
                *(u32x4*)(yo + 32 * d + 8 * g) = pair16(wp[0], wp[1]); }
    }
}
template <bool FINAL>
__device__ __forceinline__ void attn_phase(LAS unsigned char* lds, const bf16_t* proj, bf16_t* o23, float* lse23, bf16_t* ycat, int tid, int lane, int wid) {
    constexpr int NR = FINAL ? 1024 : 2048, RB = FINAL ? 32 : 64;
    const int G = gridDim.x, J = G >> 3, xcd = blockIdx.x & 7, jj = blockIdx.x >> 3;
    const bool affine = (G & 7) == 0 && J > 0 && (RB % J) == 0;
    const int SPB = affine ? RB / J : 1, NS = affine ? 4 * SPB : (NR - (int)blockIdx.x + G - 1) / G;
    auto round_of = [&](int t) -> int {
        if (!affine) return (int)blockIdx.x + t * G;
        const int sidx = t / SPB, rr = jj + J * (t % SPB), bh = 4 * xcd + sidx;
        return FINAL ? bh * 32 + rr : (rr >> 5) * 1024 + bh * 32 + (rr & 31); };
    if (NS <= 0) return;
    int t = 0;
    u32x4 kv[6], vv[6]; bf16x8 qf[4];
    AttnItem cur = attn_decode<FINAL>(round_of(0), wid);
    attn_load(proj, cur, kv, vv, tid); attn_load_q(proj, cur, qf, lane, wid);
    for (;;) {
        attn_stage(lds, kv, vv, tid, wid);
        asm volatile("s_waitcnt lgkmcnt(0)\n\ts_barrier" ::: "memory");
        const bool more = t + 1 < NS;
        const AttnItem nxt = attn_decode<FINAL>(round_of(more ? t + 1 : t), wid);
        attn_load(proj, nxt, kv, vv, tid);
        attn_compute<FINAL>(lds, proj, cur, nxt, more, qf, o23, lse23, ycat, lane, wid);
        asm volatile("s_waitcnt lgkmcnt(0)\n\ts_barrier" ::: "memory");
        if (!more) break;
        cur = nxt; ++t;
    }
}
__device__ __forceinline__ void conv_phase(const bf16_t* proj, bf16_t* ycat, const float* cw, const float* cb, int tid) {
    const int c0 = (tid & 63) * 8;
    float w0[8], w1[8], w2[8], bb[8];
#pragma unroll
    for (int e = 0; e < 8; ++e) { w0[e] = cw[c0 + e]; w1[e] = cw[AW + c0 + e]; w2[e] = cw[2 * AW + c0 + e]; bb[e] = cb[c0 + e]; }
    for (int chunk = (blockIdx.x * NTHR + tid) >> 6; chunk < M / 16; chunk += (gridDim.x * NTHR) >> 6) {
        const int row0 = chunk * 16, t0 = row0 & (SEQ - 1);
        float p1[8], p2[8];
#pragma unroll
        for (int e = 0; e < 8; ++e) { p1[e] = 0.f; p2[e] = 0.f; }
        if (t0 >= 2) {
            const bf16_t* p = proj + (size_t)(row0 - 2) * 1024 + 512 + c0;
            const u32x4 pa = *(const u32x4*)p, pb = *(const u32x4*)(p + 1024);
#pragma unroll
            for (int e = 0; e < 4; ++e) { p2[2 * e] = bf_lo(pa[e]); p2[2 * e + 1] = bf_hi(pa[e]); p1[2 * e] = bf_lo(pb[e]); p1[2 * e + 1] = bf_hi(pb[e]); }
        }
#pragma unroll 4
        for (int rr = 0; rr < 16; ++rr) {
            const bf16_t* p = proj + (size_t)(row0 + rr) * 1024 + c0;
            const u32x4 gb = *(const u32x4*)p, pc = *(const u32x4*)(p + 512);
            float p0[8], y[8];
#pragma unroll
            for (int e = 0; e < 4; ++e) { p0[2 * e] = bf_lo(pc[e]); p0[2 * e + 1] = bf_hi(pc[e]); }
#pragma unroll
            for (int e = 0; e < 8; ++e) y[e] = w2[e] * p0[e] + w1[e] * p1[e] + w0[e] * p2[e] + bb[e];
            u32x4 o;
#pragma unroll
            for (int e = 0; e < 4; ++e) o[e] = cvt_pk_bf16(bf_lo(gb[e]) * y[2 * e], bf_hi(gb[e]) * y[2 * e + 1]);
            *(u32x4*)(ycat + (size_t)(row0 + rr) * DM + AW + c0) = o;
#pragma unroll
            for (int e = 0; e < 8; ++e) { p2[e] = p1[e]; p1[e] = p0[e]; }
        }
    }
}

#define XB_TMO      128
#define XB_XCNT(j)  (256  + 64 * (j))
#define XB_XSUB(j)  (1280 + 64 * (j))
#define XB_XGEN(j)  (2304 + 64 * (j))
#define XB_TOP      3328
#define XB_TOPGEN   3392
#define XCD_BAR_WORDS 3456
#define XB_SPIN_CAP (1u << 18)

__device__ __forceinline__ unsigned xb_ld(unsigned* p)              { return __hip_atomic_load(p, __ATOMIC_RELAXED, __HIP_MEMORY_SCOPE_AGENT); }
__device__ __forceinline__ unsigned xb_add(unsigned* p, unsigned v) { return __hip_atomic_fetch_add(p, v, __ATOMIC_RELAXED, __HIP_MEMORY_SCOPE_AGENT); }
__device__ __forceinline__ unsigned xb_xcc_id() { return (unsigned)__builtin_amdgcn_s_getreg((3 << 11) | 20) & 0xFu; }
#define XB_SPIN(cond, bar) do { unsigned _sp = 0; while (cond) { __builtin_amdgcn_s_sleep(1); \
    if ((++_sp & 255u) == 0u) { if (xb_ld(&(bar)[XB_TMO])) break; if (_sp > XB_SPIN_CAP) { atomicAdd(&(bar)[XB_TMO], 1u); break; } } } } while (0)

struct XcdBarrier {
    unsigned* bar; unsigned x;
    volatile LAS unsigned* st;
};

__device__ __forceinline__ XcdBarrier xcd_barrier_post(unsigned* bar, volatile LAS unsigned* st) {
    XcdBarrier b; b.bar = bar; b.x = xb_xcc_id(); b.st = st;
    if (threadIdx.x == 0) (void)xb_add(&bar[XB_XCNT(b.x)], 1u);
    return b;
}
__device__ __forceinline__ void xcd_barrier_complete(unsigned* bar, unsigned x, unsigned& nloc, unsigned& nx) {
    const unsigned G = gridDim.x * gridDim.y * gridDim.z;
    unsigned sum, cnt, mine, sp = 0u;
    for (;;) {
        sum = 0u; cnt = 0u; mine = 0u;
#pragma unroll
        for (unsigned j = 0; j < 16; ++j) { const unsigned c = xb_ld(&bar[XB_XCNT(j)]); sum += c; cnt += (c > 0u) ? 1u : 0u; mine = (j == x) ? c : mine; }
        if (sum == G) break;
        __builtin_amdgcn_s_sleep(1);
        if ((++sp & 255u) == 0u) { if (xb_ld(&bar[XB_TMO])) break; if (sp > XB_SPIN_CAP) { atomicAdd(&bar[XB_TMO], 1u); break; } }
    }
    nloc = mine > 0u ? mine : 1u; nx = cnt > 0u ? cnt : 1u;
}

__device__ __forceinline__ void xcd_barrier(const XcdBarrier& b) {
    asm volatile("s_waitcnt vmcnt(0)" ::: "memory");
    __syncthreads();
    if (threadIdx.x == 0) {
        unsigned* bar = b.bar;
        __builtin_amdgcn_s_waitcnt(0);
        unsigned nloc = b.st[0], nx = b.st[1];
        if (nloc == 0u) { xcd_barrier_complete(bar, b.x, nloc, nx); b.st[0] = nloc; b.st[1] = nx; }
        const unsigned old = xb_add(&bar[XB_XSUB(b.x)], 1u);
        const unsigned gen = old / nloc;
        if (old + 1u == (gen + 1u) * nloc) {
            __builtin_amdgcn_fence(__ATOMIC_RELEASE, "agent");
            asm volatile("s_waitcnt vmcnt(0)" ::: "memory");
            const unsigned og = xb_add(&bar[XB_TOP], 1u);
            const unsigned tg = og / nx;
            if (og + 1u == (tg + 1u) * nx) xb_add(&bar[XB_TOPGEN], 1u);
            else XB_SPIN(xb_ld(&bar[XB_TOPGEN]) == tg, bar);
            __builtin_amdgcn_fence(__ATOMIC_ACQUIRE, "agent");
            xb_add(&bar[XB_XGEN(b.x)], 1u);
            asm volatile("s_waitcnt vmcnt(0)" ::: "memory");
        } else {
            XB_SPIN(xb_ld(&bar[XB_XGEN(b.x)]) == gen, bar);
            __builtin_amdgcn_fence(__ATOMIC_ACQUIRE, "agent");
            asm volatile("s_waitcnt vmcnt(0)" ::: "memory");
        }
    }
    __syncthreads();
}

#ifndef MK_MULTI
#define MK_MULTI 0
#endif
constexpr int N_PHASES = 2 + 8 * DEPTH;
#ifndef PROBE_DUP_MASK
#define PROBE_DUP_MASK 0
#endif
struct Args { In in; float* out; unsigned char* ws; int ph_lo, ph_hi; };
static_assert(sizeof(Args) == 15 * 8 + 8, "Args has no padding");
template <class T> __device__ __forceinline__ T* uptr(T* p) {
    const unsigned long long v = (unsigned long long)p;
    const unsigned lo = __builtin_amdgcn_readfirstlane((unsigned)v), hi = __builtin_amdgcn_readfirstlane((unsigned)(v >> 32));
    return (T*)(((unsigned long long)hi << 32) | lo);
}

__global__ void __launch_bounds__(NTHR, 2) fwd_megakernel(Args a) {
    extern __shared__ __attribute__((aligned(16))) unsigned char lds_raw[];
    LAS unsigned char* lds = (LAS unsigned char*)lds_raw;
    cg::grid_group grid = cg::this_grid();
    const int wave0 = __builtin_amdgcn_readfirstlane(threadIdx.x >> 6);
    unsigned char* ws = a.ws;
    volatile LAS unsigned* MISC = (volatile LAS unsigned*)(lds + MISC_OFF);
    if (threadIdx.x < 16) MISC[threadIdx.x] = 0u;
    __syncthreads();
    XcdBarrier bar; bar.bar = (unsigned*)(ws + WS_CTL); bar.x = 0; bar.st = nullptr;
    if (a.ph_hi - a.ph_lo > 1 && a.ph_lo >= 0) bar = xcd_barrier_post((unsigned*)(ws + WS_CTL), MISC + 8);
    for (int ph_ = a.ph_lo < 0 ? 0 : a.ph_lo; ph_ < a.ph_hi; ++ph_) {
        int ph = ph_; asm volatile("" : "+s"(ph));
        int nrep = ph < 2 ? ((PROBE_DUP_MASK >> 8) & 1) + 1 : ((PROBE_DUP_MASK >> ((ph - 2) % 8)) & 1) + 1;
        if (ph == 3 && ((PROBE_DUP_MASK >> 9) & 1)) nrep = 2;
        asm volatile("" : "+s"(nrep));
        for (int rep = 0; rep < nrep; ++rep) {
        asm volatile("" : "+s"(ph));
        int wave = wave0; asm volatile("" : "+s"(wave));
        int lane = (int)__builtin_amdgcn_mbcnt_hi(~0u, __builtin_amdgcn_mbcnt_lo(~0u, 0u)); asm volatile("" : "+v"(lane));
        const int tid = wave * 64 + lane;
        size_t wz = 0; asm volatile("" : "+s"(wz));
        unsigned char* ws = a.ws + wz;
        float* mod = (float*)(ws + WS_MOD);
        unsigned char* ob = (unsigned char*)a.out + wz;
        bf16_t* YC = (bf16_t*)(ob + OUT_YC); bf16_t* ACT = (bf16_t*)(ws + WS_ACT);
        bf16_t* QKVb = (bf16_t*)(ws + WS_QKV); bf16_t* XB = (bf16_t*)(ws + WS_XB);
        bf16_t* O23 = (bf16_t*)(ob + OUT_O23); float* LSE = (float*)(ws + WS_LSE);
        float* SW = (float*)(ws + WS_SW); float* RSS = (float*)(ws + WS_RSS);
        if (ph == 0) { mod_phase(a.in, ws, lds, tid, lane, wave); weights_phase(a.in, ws, lds, tid, lane, wave, (float*)(ws + WS_SW), 0); }
        else if (ph == 1) { weights_phase(a.in, ws, lds, tid, lane, wave, (float*)(ws + WS_SW), 1); }
        else {
            const int q = ph - 2, L = q / 8, k = q % 8;
            unsigned char* lw = ws + WS_W + (size_t)L * LW_BYTES;
            const float* lmod = mod + (size_t)L * NB * MODW;
            if (k == 0 || k == 6) {
                const int f = k == 6, sub = 2 * f;
                pg8::Gemm g{XB, (const bf16_t*)(lw + LW_W1 + (size_t)f * NB * W1_BYTES), M, 2 * FF, DM, W1_BYTES}; pg8::StaticOrder S; S.init(M, 2 * FF, gridDim.x, blockIdx.x);
                pg8::EpiSwiglu E{ACT, FF, RSS + (size_t)(L * 3 + sub) * M, SW + (size_t)(L * 3 + sub) * NB * NSW};
                pg8::gemm_phase<pg8::EpiSwiglu, pg8::StaticOrder, true, true>(lds, tid, g, S, E);
            } else if (k == 1 || k == 7 || k == 5) {
                const int f = k == 7, sub = k == 1 ? 0 : (k == 5 ? 1 : 2);
                const bool last = (L == DEPTH - 1 && k == 7);
                const bf16_t* A = k == 5 ? YC : ACT; const bf16_t* Bt = k == 5 ? (const bf16_t*)(lw + LW_WOUT) : (const bf16_t*)(lw + LW_W2 + f * W2_BYTES);
                pg8::Gemm g{A, Bt, M, DM, k == 5 ? DM : FF, 0}; pg8::StaticOrder S; S.init(M, DM, gridDim.x, blockIdx.x);
                const int nn = L * 3 + sub + 1;
                const bool has = nn < DEPTH * 3; const int ni = has ? nn : 0;
                LAS pg8::EpiResid::P* pp = (LAS pg8::EpiResid::P*)(lds + MISC_OFF + 64);
                if (tid == 0) { pp->xinb = XB; pp->out = a.out; pp->outb = XB; pp->gate = lmod + sub * 3 * DM + 2 * DM; pp->rss = RSS + (size_t)ni * M;
                    pp->gs = k == 5 ? 1.0f : 0.5f; pp->flags = (has ? 1 : 0) | (last ? 4 : 0); }
                __syncthreads();
                pg8::EpiResid E{pp};
                pg8::gemm_phase<pg8::EpiResid, pg8::StaticOrder, true, true>(lds, tid, g, S, E);
            } else if (k == 2) {
                pg8::Gemm g{XB, (const bf16_t*)(lw + LW_WIN), M, INC, DM, WIN_BYTES}; pg8::StaticOrder S; S.init(M, INC, gridDim.x, blockIdx.x);
                pg8::EpiWin E{ACT, 1024, QKVb, a.in.q_g + L * HD, a.in.k_g + L * HD, QSCALE, RSS + (size_t)(L * 3 + 1) * M, SW + (size_t)(L * 3 + 1) * NB * NSW};
                pg8::gemm_phase<pg8::EpiWin, pg8::StaticOrder, true, true>(lds, tid, g, S, E);
            } else if (k == 3) {
                attn_phase<false>(lds, QKVb, O23, LSE, nullptr, tid, lane, wave);
            } else {
                attn_phase<true>(lds, QKVb, O23, LSE, YC, tid, lane, wave);
                conv_phase(ACT, YC, a.in.conv_w + (size_t)L * 3 * AW, a.in.conv_b + (size_t)L * AW, tid);
            }
        }
        __syncthreads(); }
        if (ph_ + 1 < a.ph_hi) { if (a.ph_lo < 0) grid.sync(); else xcd_barrier(bar); }
    }
}

extern "C" void kernel_launch(void* const* d_in, const int* in_sizes, int n_in, void* d_out, int out_size, void* d_ws, size_t ws_size, hipStream_t stream) {
    static int grid_blocks = 0;
    if (grid_blocks == 0) {
        if (n_in != 13 || in_sizes[0] != M * DM || out_size != M * DM || ws_size < WS_END) { fprintf(stderr, "kernel_launch: unexpected shapes (n_in %d, in0 %d, out %d, ws %zu)\n", n_in, n_in > 0 ? in_sizes[0] : -1, out_size, ws_size); grid_blocks = -1; return; }
        int dev = 0, cus = 0, per_cu = 0;
        hipGetDevice(&dev);
        hipDeviceGetAttribute(&cus, hipDeviceAttributeMultiprocessorCount, dev);
        if (hipFuncSetAttribute((const void*)fwd_megakernel, hipFuncAttributeMaxDynamicSharedMemorySize, LDS_BYTES) != hipSuccess) fprintf(stderr, "kernel_launch: hipFuncSetAttribute failed\n");
        if (hipOccupancyMaxActiveBlocksPerMultiprocessor(&per_cu, (const void*)fwd_megakernel, NTHR, LDS_BYTES) != hipSuccess || per_cu < 1) { fprintf(stderr, "kernel_launch: occupancy query says %d\n", per_cu); per_cu = 1; }
        (void)hipGetLastError();
        grid_blocks = cus * per_cu;
    }
    if (grid_blocks < 0) return;
    Args a{};
    const float** ip = (const float**)&a.in;
    for (int i = 0; i < 13; ++i) ip[i] = (const float*)d_in[i];
    a.out = (float*)d_out; a.ws = (unsigned char*)d_ws;
    if (hipMemsetAsync((char*)d_ws + WS_CTL, 0, ZERO_BYTES, stream) != hipSuccess) { fprintf(stderr, "kernel_launch: memset failed\n"); return; }
#if MK_MULTI
    for (int ph = 0; ph < N_PHASES; ++ph) { a.ph_lo = ph; a.ph_hi = ph + 1; hipLaunchKernelGGL(fwd_megakernel, dim3(grid_blocks), dim3(NTHR), LDS_BYTES, stream, a); }
#else
    a.ph_lo = 0; a.ph_hi = N_PHASES;
    void* args[] = {&a};
    hipError_t e = hipLaunchCooperativeKernel((const void*)fwd_megakernel, dim3(grid_blocks), dim3(NTHR), args, LDS_BYTES, stream);
    if (e != hipSuccess) fprintf(stderr, "cooperative launch failed: %s (grid %d)\n", hipGetErrorString(e), grid_blocks);
#endif
}
```
